# Optimizing an MI355X kernel written in HIP

```python
import jax, jax.numpy as jnp
from jax import lax
import numpy as np

D_MODEL = 2048
BATCH = 4
SEQ = 2048
DEPTH = 1
DEC_BATCH = 128
DEC_SEQ = 8
PAST_LEN = 16384
PAGE_SIZE = 128

META_TOKENS = 16
D_INNER = 2 * D_MODEL
SSD_HEAD_DIM = 64
SSD_HEADS = D_INNER // SSD_HEAD_DIM
SSD_STATE = 128
SSD_GROUPS = 8
SSD_CONV_W = 4
SSD_CHUNK = 128
SSD_CONV_DIM = D_INNER + 2 * SSD_GROUPS * SSD_STATE
SC_WIDTH = D_MODEL
SC_CONV_W = 3
PROJ_COLS = D_INNER + SSD_CONV_DIM + SSD_HEADS + 4 * SC_WIDTH + 2 * D_MODEL
EPS = 1e-6

kernel_name = "hybrid_ssd_shortconv_gated_decode_step"


def rms_norm(x, w):
    xf = x.astype(jnp.float32)
    xf = xf * lax.rsqrt(jnp.mean(xf * xf, axis=-1, keepdims=True) + EPS)
    return (xf * w.astype(jnp.float32)).astype(x.dtype)


def gated_group_rms_norm(y, z, w):
    g = y.astype(jnp.float32) * jax.nn.silu(z.astype(jnp.float32))
    shp = g.shape
    g = g.reshape(shp[:-1] + (SSD_GROUPS, shp[-1] // SSD_GROUPS))
    g = g * lax.rsqrt(jnp.mean(g * g, axis=-1, keepdims=True) + EPS)
    return (g.reshape(shp) * w.astype(jnp.float32)).astype(y.dtype)


def causal_dwconv(x, prev, w):
    width = w.shape[0]
    length = x.shape[1]
    xp = jnp.concatenate([prev.astype(x.dtype), x], axis=1)
    out = xp[:, 0:length] * w[0]
    for k in range(1, width):
        out = out + xp[:, k:k + length] * w[k]
    return out, xp[:, length:]


def ssd_chunked(xs, dt, log_a, bm, cm, h0, chunk):
    f32 = jnp.float32
    bsz, length, nh, hp = xs.shape
    ng, ns = bm.shape[2], bm.shape[3]
    hr = nh // ng
    nc = length // chunk
    xc = xs.astype(f32).reshape(bsz, nc, chunk, ng, hr, hp)
    dtc = dt.astype(f32).reshape(bsz, nc, chunk, ng, hr)
    acum = jnp.cumsum(log_a.astype(f32).reshape(bsz, nc, chunk, ng, hr), axis=2)
    bc = bm.astype(f32).reshape(bsz, nc, chunk, ng, ns)
    cc = cm.astype(f32).reshape(bsz, nc, chunk, ng, ns)
    causal = jnp.tril(jnp.ones((chunk, chunk), dtype=bool))[:, :, None, None]
    seg = acum[:, :, :, None] - acum[:, :, None, :]
    decay = jnp.exp(jnp.where(causal, seg, -jnp.inf))
    cb = jnp.einsum('bcign,bcjgn->bcijg', cc, bc)
    wts = cb[..., None] * decay * dtc[:, :, None]
    y_diag = jnp.einsum('bcijgr,bcjgrp->bcigrp', wts, xc)
    to_end = jnp.exp(acum[:, :, -1:] - acum) * dtc
    chunk_states = jnp.einsum('bcjgr,bcjgrp,bcjgn->bcgrpn', to_end, xc, bc)
    chunk_decay = jnp.exp(acum[:, :, -1])

    def step(h, inp):
        dec, st = inp
        return dec[..., None, None] * h + st, h

    h_last, h_in = lax.scan(step, h0.astype(f32).reshape(bsz, ng, hr, hp, ns),
                            (jnp.moveaxis(chunk_decay, 1, 0), jnp.moveaxis(chunk_states, 1, 0)))
    h_in = jnp.moveaxis(h_in, 0, 1)
    y_off = jnp.einsum('bcign,bcgrpn->bcigrp', cc, h_in) * jnp.exp(acum)[..., None]
    y = (y_diag + y_off).reshape(bsz, length, nh, hp).astype(xs.dtype)
    return y, h_last.reshape(bsz, nh, hp, ns).astype(h0.dtype)


def split_proj(proj):
    sizes = [D_INNER, SSD_CONV_DIM, SSD_HEADS, SC_WIDTH, SC_WIDTH, SC_WIDTH, SC_WIDTH, D_MODEL]
    idx = []
    acc = 0
    for s in sizes:
        acc += s
        idx.append(acc)
    return jnp.split(proj, idx, axis=-1)


def mixer_layer(x, conv_prev, ssm_prev, sconv_prev, segments, norm_w, w_in, ssd_conv_w,
                ssd_conv_b, dt_bias, a_log, d_skip, ssd_norm_w, w_ssd_out, sconv_w,
                w_sconv_out, w_o):
    bsz, length = x.shape[0], x.shape[1]
    h = rms_norm(x, norm_w)
    proj = h @ w_in
    z, xbc, dt_raw, sc_b, sc_c, sc_h, sc_z, g_a, g_b = split_proj(proj)

    xbc_c, conv_new = causal_dwconv(xbc, conv_prev, ssd_conv_w)
    xbc = jax.nn.silu(xbc_c + ssd_conv_b)
    xs, bm, cm = jnp.split(xbc, [D_INNER, D_INNER + SSD_GROUPS * SSD_STATE], axis=-1)
    xs = xs.reshape(bsz, length, SSD_HEADS, SSD_HEAD_DIM)
    bm = bm.reshape(bsz, length, SSD_GROUPS, SSD_STATE)
    cm = cm.reshape(bsz, length, SSD_GROUPS, SSD_STATE)
    dt = jax.nn.softplus(dt_raw.astype(jnp.float32) + dt_bias.astype(jnp.float32))
    log_a = dt * (-jnp.exp(a_log.astype(jnp.float32)))
    state = ssm_prev
    ys = []
    start = 0
    for seg_len, chunk in segments:
        sl = slice(start, start + seg_len)
        y_seg, state = ssd_chunked(xs[:, sl], dt[:, sl], log_a[:, sl], bm[:, sl],
                                   cm[:, sl], state, chunk)
        ys.append(y_seg)
        start += seg_len
    y = jnp.concatenate(ys, axis=1) + d_skip[:, None] * xs
    y = gated_group_rms_norm(y.reshape(bsz, length, D_INNER), z, ssd_norm_w)
    y_a = y @ w_ssd_out

    u = sc_c * sc_h
    u_c, sconv_new = causal_dwconv(u, sconv_prev, sconv_w)
    y_b = (sc_b * u_c * jax.nn.silu(sc_z)) @ w_sconv_out

    merged = jax.nn.sigmoid(g_a) * y_a + jax.nn.sigmoid(g_b) * y_b
    return x + merged @ w_o, conv_new, state, sconv_new


def setup_inputs(seed: int = 0) -> dict:
    key = jax.random.key(seed)
    ks = jax.random.split(key, 24)
    f32 = jnp.float32
    nrm = lambda k, shp, s: jax.random.normal(k, shp, f32) * s
    dt0 = jnp.exp(jax.random.uniform(ks[10], (DEPTH, SSD_HEADS), f32,
                                     np.log(1e-3).astype(np.float32), np.log(1e-1).astype(np.float32)))
    dt_bias = dt0 + jnp.log(-jnp.expm1(-dt0))
    return {
        "x_prompt": nrm(ks[0], (BATCH, SEQ, D_MODEL), 1.0),
        "x_sample": nrm(ks[1], (DEC_BATCH, DEC_SEQ, D_MODEL), 1.0),
        "state_ssd_conv": nrm(ks[2], (DEPTH, DEC_BATCH, SSD_CONV_W - 1, SSD_CONV_DIM), 1.0),
        "state_ssm": nrm(ks[3], (DEPTH, DEC_BATCH, SSD_HEADS, SSD_HEAD_DIM, SSD_STATE), 0.5),
        "state_sconv": nrm(ks[4], (DEPTH, DEC_BATCH, SC_CONV_W - 1, SC_WIDTH), 1.0),
        "meta_tokens": nrm(ks[5], (META_TOKENS, D_MODEL), 1.0),
        "norm_w": 1.0 + nrm(ks[6], (DEPTH, D_MODEL), 0.02),
        "w_in": nrm(ks[7], (DEPTH, D_MODEL, PROJ_COLS), D_MODEL ** -0.5),
        "ssd_conv_w": nrm(ks[8], (DEPTH, SSD_CONV_W, SSD_CONV_DIM), SSD_CONV_W ** -0.5),
        "ssd_conv_b": nrm(ks[9], (DEPTH, SSD_CONV_DIM), 0.02),
        "dt_bias": dt_bias,
        "a_log": jnp.log(jax.random.uniform(ks[11], (DEPTH, SSD_HEADS), f32, 1.0, 16.0)),
        "d_skip": 1.0 + nrm(ks[12], (DEPTH, SSD_HEADS), 0.1),
        "ssd_norm_w": 1.0 + nrm(ks[13], (DEPTH, D_INNER), 0.02),
        "w_ssd_out": nrm(ks[14], (DEPTH, D_INNER, D_MODEL), D_INNER ** -0.5),
        "sconv_w": nrm(ks[15], (DEPTH, SC_CONV_W, SC_WIDTH), SC_CONV_W ** -0.5),
        "w_sconv_out": nrm(ks[16], (DEPTH, SC_WIDTH, D_MODEL), SC_WIDTH ** -0.5),
        "w_o": nrm(ks[17], (DEPTH, D_MODEL, D_MODEL), D_MODEL ** -0.5),
        "final_norm_w": 1.0 + nrm(ks[18], (D_MODEL,), 0.02),
    }


def reference(x_prompt, x_sample, state_ssd_conv, state_ssm, state_sconv, meta_tokens, norm_w,
              w_in, ssd_conv_w, ssd_conv_b, dt_bias, a_log, d_skip, ssd_norm_w, w_ssd_out,
              sconv_w, w_sconv_out, w_o, final_norm_w):
    bp, seq = x_prompt.shape[0], x_prompt.shape[1]
    dec_seq = x_sample.shape[1]
    dt_ = x_prompt.dtype
    meta = jnp.broadcast_to(meta_tokens[None].astype(dt_), (bp, META_TOKENS, D_MODEL))
    xp = jnp.concatenate([meta, x_prompt], axis=1)
    xs = x_sample
    prompt_segments = ((META_TOKENS, META_TOKENS), (seq, min(SSD_CHUNK, seq)))
    sample_segments = ((dec_seq, dec_seq),)
    conv0 = jnp.zeros((bp, SSD_CONV_W - 1, SSD_CONV_DIM), dt_)
    ssm0 = jnp.zeros((bp, SSD_HEADS, SSD_HEAD_DIM, SSD_STATE), dt_)
    sconv0 = jnp.zeros((bp, SC_CONV_W - 1, SC_WIDTH), dt_)
    cp_l, sp_l, scp_l, cs_l, ss_l, scs_l = [], [], [], [], [], []
    for layer in range(DEPTH):
        lw = (norm_w[layer], w_in[layer], ssd_conv_w[layer], ssd_conv_b[layer], dt_bias[layer],
              a_log[layer], d_skip[layer], ssd_norm_w[layer], w_ssd_out[layer], sconv_w[layer],
              w_sconv_out[layer], w_o[layer])
        xp, cp, sp, scp = mixer_layer(xp, conv0, ssm0, sconv0, prompt_segments, *lw)
        xs, cs, ss, scs = mixer_layer(xs, state_ssd_conv[layer], state_ssm[layer],
                                      state_sconv[layer], sample_segments, *lw)
        cp_l.append(cp); sp_l.append(sp); scp_l.append(scp)
        cs_l.append(cs); ss_l.append(ss); scs_l.append(scs)
    y_prompt = rms_norm(xp, final_norm_w)[:, META_TOKENS:]
    y_sample = rms_norm(xs, final_norm_w)
    return (y_prompt, y_sample, jnp.stack(cp_l), jnp.stack(sp_l), jnp.stack(scp_l),
            jnp.stack(cs_l), jnp.stack(ss_l), jnp.stack(scs_l))
```

```cpp
#include <hip/hip_runtime.h>
#include <cstdio>
#include <cstdint>

#define LAS __attribute__((address_space(3)))
typedef unsigned short bf16_t;
typedef short bf16x8 __attribute__((ext_vector_type(8)));
typedef float f32x4 __attribute__((ext_vector_type(4)));
typedef float f32x2 __attribute__((ext_vector_type(2)));
typedef unsigned u32x4 __attribute__((ext_vector_type(4)));
typedef unsigned u32x2 __attribute__((ext_vector_type(2)));

constexpr int D = 2048, NB = 4, SEQ = 2048, META = 16, DECB = 128, DECS = 8;
constexpr int DI = 4096, NH = 64, HP = 64, NS = 128, NG = 8, CONVD = 6144, SCW = 2048, PROJ = 22592;
constexpr float EPS = 1e-6f;
constexpr int ROW_S0 = 8192, ROW_M0 = 9216, M_REAL = 9232, MP = 9472, M_OUT = 9216;
constexpr int NP1 = 89 * 256;
constexpr int C_XBC = 4096, C_DT = 10240, C_SC = 10304, C_G = 18496;
constexpr size_t O_YP = 0, O_YS = 16777216, O_NCP = 18874368, O_NSSMP = 18948096, O_NSCP = 21045248, O_NCS = 21061632, O_NSSMS = 23420928, O_NSCS = 90529792;
constexpr size_t SZ_R2K = (size_t)MP * 2048 * 2;
constexpr size_t W_H = 0;
constexpr size_t W_WT1 = W_H + SZ_R2K;
constexpr size_t W_WT2A = W_WT1 + (size_t)NP1 * 2048 * 2;
constexpr size_t W_WT2B = W_WT2A + (size_t)2048 * 4096 * 2;
constexpr size_t W_WT3 = W_WT2B + (size_t)2048 * 2048 * 2;
constexpr size_t W_ZS = W_WT3 + (size_t)2048 * 2048 * 2;
constexpr size_t W_XBC = W_ZS + (size_t)MP * 4096 * 2;
constexpr size_t W_DT = W_XBC + (size_t)MP * 6144 * 2;
constexpr size_t W_U = W_DT + (size_t)MP * 64 * 4;
constexpr size_t W_GB = W_U + SZ_R2K;
constexpr size_t W_SGA = W_GB + SZ_R2K;
constexpr size_t W_SGB = W_SGA + SZ_R2K;
constexpr size_t W_XC = W_SGB + SZ_R2K;
constexpr size_t W_YBIN = W_XC + (size_t)MP * 6144 * 2;
constexpr size_t W_Y = W_YBIN + SZ_R2K;
constexpr size_t W_YN = W_Y + (size_t)MP * 4096 * 2;
constexpr size_t W_MERGED = W_YN + (size_t)MP * 4096 * 2;
constexpr size_t W_END = W_MERGED + SZ_R2K;
constexpr size_t W_YA = W_XC;
constexpr size_t W_OUTP = W_XBC;

constexpr int LDS_BYTES = 147456;

typedef __bf16 bf16x2v __attribute__((ext_vector_type(2)));
__device__ __forceinline__ unsigned cvt_pk_bf16(float lo, float hi) { f32x2 v = {lo, hi}; bf16x2v b = __builtin_convertvector(v, bf16x2v); return __builtin_bit_cast(unsigned, b); }
__device__ __forceinline__ float bf_lo(unsigned w) { return __uint_as_float(w << 16); }
__device__ __forceinline__ float bf_hi(unsigned w) { return __uint_as_float(w & 0xffff0000u); }
__device__ __forceinline__ float fsigmoid(float x) { return __builtin_amdgcn_rcpf(1.0f + __expf(-x)); }
__device__ __forceinline__ float fsilu(float x) { return x * fsigmoid(x); }
__device__ __forceinline__ float wave_sum(float v) {
#pragma unroll
    for (int o = 1; o < 64; o <<= 1) v += __shfl_xor(v, o);
    return v;
}
__device__ __forceinline__ void unpack8(const u32x4 w, float (&f)[8]) {
    f[0] = bf_lo(w.x); f[1] = bf_hi(w.x); f[2] = bf_lo(w.y); f[3] = bf_hi(w.y); f[4] = bf_lo(w.z); f[5] = bf_hi(w.z); f[6] = bf_lo(w.w); f[7] = bf_hi(w.w);
}
__device__ __forceinline__ u32x4 pack8(const float (&f)[8]) {
    u32x4 w; w.x = cvt_pk_bf16(f[0], f[1]); w.y = cvt_pk_bf16(f[2], f[3]); w.z = cvt_pk_bf16(f[4], f[5]); w.w = cvt_pk_bf16(f[6], f[7]); return w;
}
#define LDS_WAIT() asm volatile("s_waitcnt lgkmcnt(0)" ::: "memory")

namespace pg8 {
constexpr int BM = 256, BK = 64, HALF = 128, HTB = HALF * BK * 2, STAGE_BYTES = 8 * HTB, NXCD = 8, WGM = 8;
__host__ __device__ __forceinline__ int lds_byte(int r, int c) { const int st = (r >> 4) * 2 + (c >> 5), rr = r & 15, cc = c & 31, ob = rr * 64 + cc * 2; return st * 1024 + (ob ^ (((ob >> 9) & 1) << 5)); }
__host__ __device__ __forceinline__ void stage_rc(int b, int& R, int& C) { const int st = b / 1024, sb = b % 1024, swz = sb ^ (((sb >> 9) & 1) << 5); R = (st >> 1) * 16 + swz / 64; C = (st & 1) * 32 + (swz % 64) / 2; }
__host__ __device__ __forceinline__ int perm32(int rho) { const int n = rho >> 4, i = rho & 15; return 8 * (i >> 2) + 4 * n + (i & 3); }
struct Unit { int pm, pn; };
struct Gemm { const bf16_t* A; const bf16_t* Bt; int M, N, K; };
struct StaticOrder {
    int nM, nN, nwg, G, c;
    __host__ __device__ void init(int M, int N, int G_, int c_) { nM = M / BM; nN = N / BM; nwg = nM * nN; G = G_; c = c_; }
    __host__ __device__ bool next(int i, Unit& u) const {
        const long L = (long)i * G + c; if (L >= nwg) return false;
        int wgid = (int)L; { const int q = nwg / NXCD, r = nwg % NXCD, xcd = wgid % NXCD, off = wgid / NXCD; wgid = (xcd < r ? xcd * (q + 1) : r * (q + 1) + (xcd - r) * q) + off; }
        const int nig = WGM * nN, gid = wgid / nig, fm = gid * WGM, gsz = (nM - fm) < WGM ? (nM - fm) : WGM;
        u.pm = fm + ((wgid % nig) % gsz); u.pn = (wgid % nig) / gsz; return true;
    }
    __device__ __forceinline__ void a_ready(const Unit&) const {}
    __device__ __forceinline__ void done(const Unit&) const {}
};

template <class Epi, class Sched, bool ALIGN_EPI = false, bool SP2 = false>
__device__ __forceinline__ void gemm_phase(LAS unsigned char* lds, const Gemm g, const Sched& S, const Epi& E) {
    const int tid = threadIdx.x, wid = __builtin_amdgcn_readfirstlane(tid >> 6), lane = tid & 63, wr = wid >> 2, wc = wid & 3, fr = lane & 15, fq = lane >> 4;
    const int K = g.K, nt = K / BK;
    unsigned voffA[2], voffB[2];
#pragma unroll
    for (int i = 0; i < 2; ++i) { int R, C; stage_rc(tid * 16 + i * 8192, R, C); const int Rb = Epi::PERM ? ((R & ~31) + perm32(R & 31)) : R;
        voffA[i] = (unsigned)(R * K + C) * 2u; voffB[i] = (unsigned)(Rb * K + C) * 2u; }
    const size_t kstep = (size_t)(BK * 2);
    const size_t hstep = (size_t)HALF * K * 2;
    const size_t tstep = 2 * hstep;
    const unsigned ldsw = (unsigned)wid * 1024u;
    const int aoff = lds_byte(wr * 64 + fr, fq * 8), boff = lds_byte(wc * 32 + fr, fq * 8);
#define PG8_SA(b, h) (((b) * 2 + (h)) * HTB)
#define PG8_SB(b, h) ((4 + (b) * 2 + (h)) * HTB)
#define PG8_STAGE(bufoff, gbase, voff) do { _Pragma("unroll") for (int _i = 0; _i < 2; ++_i) \
        __builtin_amdgcn_global_load_lds((const unsigned*)((const char*)(gbase) + (voff)[_i]), (LAS unsigned*)(lds + (bufoff) + ldsw + _i * 8192), 16, 0, 0); } while (0)
#define PG8_LDA(dst, b, h) do { _Pragma("unroll") for (int m = 0; m < 4; ++m) _Pragma("unroll") for (int k = 0; k < 2; ++k) dst[m][k] = *(const LAS bf16x8*)(lds + PG8_SA(b, h) + aoff + m * 2048 + k * 1024); } while (0)
#define PG8_LDB(dst, b, h) do { _Pragma("unroll") for (int n = 0; n < 2; ++n) _Pragma("unroll") for (int k = 0; k < 2; ++k) dst[n][k] = *(const LAS bf16x8*)(lds + PG8_SB(b, h) + boff + n * 2048 + k * 1024); } while (0)
#define PG8_MMA(ai, bj, At, Bt) do { __builtin_amdgcn_s_setprio(1); _Pragma("unroll") for (int m = 0; m < 4; ++m) _Pragma("unroll") for (int n = 0; n < 2; ++n) _Pragma("unroll") for (int k = 0; k < 2; ++k) \
        acc[ai][bj][m][n] = __builtin_amdgcn_mfma_f32_16x16x32_bf16(Bt[n][k], At[m][k], acc[ai][bj][m][n], 0, 0, 0); __builtin_amdgcn_s_setprio(0); } while (0)
#define PG8_WAIT_V(n) asm volatile("s_waitcnt vmcnt(" #n ")" ::: "memory")
#define PG8_WAIT_L(n) asm volatile("s_waitcnt lgkmcnt(" #n ")" ::: "memory")
#define PG8_BAR __builtin_amdgcn_s_barrier()
#define PG8_SCHED __builtin_amdgcn_sched_barrier(0)
    Unit cur, nxt; int ui = 0;
    if (!S.next(0, cur)) return;
    f32x4 acc[2][2][4][2];
#pragma unroll
    for (int a = 0; a < 2; ++a)
#pragma unroll
        for (int b = 0; b < 2; ++b)
#pragma unroll
            for (int m = 0; m < 4; ++m)
#pragma unroll
                for (int n = 0; n < 2; ++n) acc[a][b][m][n] = (f32x4){0.f, 0.f, 0.f, 0.f};
    bf16x8 At[4][2], B0[2][2], B1[2][2];
    const char* cA = (const char*)g.A + (size_t)cur.pm * tstep; const char* cB = (const char*)g.Bt + (size_t)cur.pn * tstep;
    S.a_ready(cur);
    if constexpr (SP2) {
        PG8_STAGE(PG8_SB(0, 0), cB, voffB); PG8_STAGE(PG8_SB(0, 1), cB + hstep, voffB); PG8_STAGE(PG8_SA(0, 0), cA, voffA); PG8_STAGE(PG8_SA(0, 1), cA + hstep, voffA);
        if (wr == 1) PG8_BAR;
        PG8_WAIT_V(2); PG8_BAR;
        PG8_STAGE(PG8_SB(1, 0), cB + kstep, voffB); PG8_STAGE(PG8_SA(1, 0), cA + kstep, voffA); PG8_STAGE(PG8_SB(1, 1), cB + hstep + kstep, voffB);
        PG8_WAIT_V(6); PG8_BAR;
    } else {
        PG8_STAGE(PG8_SB(0, 0), cB, voffB); PG8_STAGE(PG8_SA(0, 0), cA, voffA); PG8_STAGE(PG8_SB(0, 1), cB + hstep, voffB); PG8_STAGE(PG8_SA(0, 1), cA + hstep, voffA);
        if (wr == 1) PG8_BAR;
        PG8_WAIT_V(4); PG8_BAR;
        PG8_STAGE(PG8_SB(1, 0), cB + kstep, voffB); PG8_STAGE(PG8_SA(1, 0), cA + kstep, voffA); PG8_STAGE(PG8_SB(1, 1), cB + hstep + kstep, voffB);
        PG8_WAIT_V(6); PG8_BAR;
    }
    for (;;) {
        const bool has_next = S.next(ui + 1, nxt);
        const char* nA = has_next ? (const char*)g.A + (size_t)nxt.pm * tstep : cA; const char* nB = has_next ? (const char*)g.Bt + (size_t)nxt.pn * tstep : cB;
        for (int t = 0; t < nt; t += 2) {
            const bool last = (t == nt - 2);
            const char* a1 = cA + (size_t)(t + 1) * kstep;
            const char* a2 = last ? nA : cA + (size_t)(t + 2) * kstep; const char* b2 = last ? nB : cB + (size_t)(t + 2) * kstep;
            const char* a3 = a2 + kstep; const char* b3 = b2 + kstep;
            if (last && has_next) S.a_ready(nxt);
            if constexpr (SP2) {
            PG8_LDB(B0, 0, 0); PG8_LDB(B1, 0, 1); PG8_SCHED; PG8_LDA(At, 0, 0); PG8_STAGE(PG8_SA(1, 1), a1 + hstep, voffA);
            PG8_WAIT_V(8); PG8_WAIT_L(0); PG8_BAR; PG8_MMA(0, 0, At, B0); PG8_MMA(0, 1, At, B1); PG8_BAR; PG8_SCHED;
            PG8_LDA(At, 0, 1); PG8_STAGE(PG8_SB(0, 0), b2, voffB); PG8_STAGE(PG8_SB(0, 1), b2 + hstep, voffB); PG8_STAGE(PG8_SA(0, 0), a2, voffA);
            PG8_WAIT_V(8); PG8_WAIT_L(0); PG8_BAR; PG8_MMA(1, 0, At, B0); PG8_MMA(1, 1, At, B1); PG8_BAR; PG8_SCHED;
            PG8_LDB(B0, 1, 0); PG8_LDB(B1, 1, 1); PG8_SCHED; PG8_LDA(At, 1, 0); PG8_STAGE(PG8_SA(0, 1), a2 + hstep, voffA);
            PG8_WAIT_V(8); PG8_WAIT_L(0); PG8_BAR; PG8_MMA(0, 0, At, B0); PG8_MMA(0, 1, At, B1); PG8_BAR; PG8_SCHED;
            PG8_LDA(At, 1, 1); PG8_STAGE(PG8_SB(1, 0), b3, voffB); PG8_STAGE(PG8_SB(1, 1), b3 + hstep, voffB); PG8_STAGE(PG8_SA(1, 0), a3, voffA);
            PG8_WAIT_V(8); PG8_WAIT_L(0); PG8_BAR; PG8_MMA(1, 0, At, B0); PG8_MMA(1, 1, At, B1); PG8_BAR; PG8_SCHED;
            } else {
            PG8_LDB(B0, 0, 0); PG8_SCHED; PG8_LDA(At, 0, 0); PG8_STAGE(PG8_SA(1, 1), a1 + hstep, voffA);
            PG8_WAIT_L(8); PG8_BAR; PG8_WAIT_L(0); PG8_MMA(0, 0, At, B0); PG8_BAR; PG8_SCHED;
            PG8_LDB(B1, 0, 1); PG8_STAGE(PG8_SB(0, 0), b2, voffB);
            PG8_BAR; PG8_WAIT_L(0); PG8_MMA(0, 1, At, B1); PG8_BAR;
            PG8_LDA(At, 0, 1); PG8_STAGE(PG8_SA(0, 0), a2, voffA);
            PG8_BAR; PG8_WAIT_L(0); PG8_MMA(1, 0, At, B0); PG8_BAR; PG8_SCHED;
            PG8_STAGE(PG8_SB(0, 1), b2 + hstep, voffB);
            PG8_WAIT_V(6); PG8_BAR; PG8_MMA(1, 1, At, B1); PG8_BAR;
            PG8_LDB(B0, 1, 0); PG8_SCHED; PG8_LDA(At, 1, 0); PG8_STAGE(PG8_SA(0, 1), a2 + hstep, voffA);
            PG8_WAIT_L(8); PG8_BAR; PG8_WAIT_L(0); PG8_MMA(0, 0, At, B0); PG8_BAR; PG8_SCHED;
            PG8_LDB(B1, 1, 1); PG8_STAGE(PG8_SB(1, 0), b3, voffB);
            PG8_BAR; PG8_WAIT_L(0); PG8_MMA(0, 1, At, B1); PG8_BAR;
            PG8_LDA(At, 1, 1); PG8_STAGE(PG8_SA(1, 0), a3, voffA);
            PG8_BAR; PG8_WAIT_L(0); PG8_MMA(1, 0, At, B0); PG8_BAR; PG8_SCHED;
            PG8_STAGE(PG8_SB(1, 1), b3 + hstep, voffB);
            PG8_WAIT_V(6); PG8_BAR; PG8_MMA(1, 1, At, B1); PG8_BAR;
            }
        }
        if constexpr (ALIGN_EPI) { if (wr == 0) PG8_BAR; }
        E(acc, cur, wr, wc, fr, fq); S.done(cur);
        if (!has_next) break;
#pragma unroll
        for (int a = 0; a < 2; ++a)
#pragma unroll
            for (int b = 0; b < 2; ++b)
#pragma unroll
                for (int m = 0; m < 4; ++m)
#pragma unroll
                    for (int n = 0; n < 2; ++n) acc[a][b][m][n] = (f32x4){0.f, 0.f, 0.f, 0.f};
        cur = nxt; cA = nA; cB = nB; ++ui;
        if constexpr (ALIGN_EPI) { if (wr == 1) PG8_BAR; }
    }
    PG8_WAIT_V(0);
    if constexpr (!ALIGN_EPI) { if (wr == 0) PG8_BAR; }
    PG8_BAR;
#undef PG8_SA
#undef PG8_SB
#undef PG8_STAGE
#undef PG8_LDA
#undef PG8_LDB
#undef PG8_MMA
#undef PG8_WAIT_V
#undef PG8_WAIT_L
#undef PG8_BAR
#undef PG8_SCHED
}
}

struct Epi1 {
    static constexpr bool PERM = true;
    bf16_t *ZS, *XBC, *U, *GB, *SGA, *SGB; float* DT; const float* dt_bias; float* out;
    __device__ __forceinline__ void operator()(const f32x4 (&acc)[2][2][4][2], const pg8::Unit& u, int wr, int wc, int fr, int fq) const {
        const int pn = u.pn; const int rbase = u.pm * 256 + wr * 64 + fr;
        if (pn < 16) {
#pragma unroll
            for (int ai = 0; ai < 2; ++ai)
#pragma unroll
                for (int m = 0; m < 4; ++m) { const int row = rbase + ai * 128 + m * 16; bf16_t* rowp = ZS + (size_t)row * DI + pn * 256 + wc * 32 + 8 * fq;
#pragma unroll
                    for (int bj = 0; bj < 2; ++bj) { const f32x4 v0 = acc[ai][bj][m][0], v1 = acc[ai][bj][m][1]; u32x4 w;
                        w.x = cvt_pk_bf16(fsilu(v0[0]), fsilu(v0[1])); w.y = cvt_pk_bf16(fsilu(v0[2]), fsilu(v0[3])); w.z = cvt_pk_bf16(fsilu(v1[0]), fsilu(v1[1])); w.w = cvt_pk_bf16(fsilu(v1[2]), fsilu(v1[3]));
                        *(u32x4*)(rowp + bj * 128) = w; } }
        } else if (pn < 40) {
#pragma unroll
            for (int ai = 0; ai < 2; ++ai)
#pragma unroll
                for (int m = 0; m < 4; ++m) { const int row = rbase + ai * 128 + m * 16; const int col = (pn - 16) * 256 + wc * 32 + 8 * fq; bf16_t* rowp = XBC + (size_t)row * CONVD + col;
                    long oidx = -1;
                    if (row < ROW_S0) { const int t = row & 2047; if (t >= 2045) oidx = (long)O_NCP + (long)((row >> 11) * 3 + (t - 2045)) * CONVD; }
                    else if (row < ROW_M0) { const int t = row & 7; if (t >= 5) oidx = (long)O_NCS + (long)(((row - ROW_S0) >> 3) * 3 + (t - 5)) * CONVD; }
#pragma unroll
                    for (int bj = 0; bj < 2; ++bj) { const f32x4 v0 = acc[ai][bj][m][0], v1 = acc[ai][bj][m][1]; u32x4 w;
                        w.x = cvt_pk_bf16(v0[0], v0[1]); w.y = cvt_pk_bf16(v0[2], v0[3]); w.z = cvt_pk_bf16(v1[0], v1[1]); w.w = cvt_pk_bf16(v1[2], v1[3]);
                        *(u32x4*)(rowp + bj * 128) = w;
                        if (oidx >= 0) { float* o = out + oidx + col + bj * 128; *(f32x4*)o = v0; *(f32x4*)(o + 4) = v1; } } }
        } else if (pn < 72) {
#pragma unroll
            for (int ai = 0; ai < 2; ++ai)
#pragma unroll
                for (int m = 0; m < 4; ++m) { const int row = rbase + ai * 128 + m * 16; const int j0 = (pn - 40) * 64 + wc * 16 + fq * 4;
                    const f32x4 sb = acc[ai][0][m][0], sc = acc[ai][0][m][1], sh = acc[ai][1][m][0], sz = acc[ai][1][m][1];
                    const f32x4 uu = sc * sh; f32x4 gg; gg[0] = sb[0] * fsilu(sz[0]); gg[1] = sb[1] * fsilu(sz[1]); gg[2] = sb[2] * fsilu(sz[2]); gg[3] = sb[3] * fsilu(sz[3]);
                    u32x2 wu, wg; wu.x = cvt_pk_bf16(uu[0], uu[1]); wu.y = cvt_pk_bf16(uu[2], uu[3]); wg.x = cvt_pk_bf16(gg[0], gg[1]); wg.y = cvt_pk_bf16(gg[2], gg[3]);
                    *(u32x2*)(U + (size_t)row * SCW + j0) = wu; *(u32x2*)(GB + (size_t)row * SCW + j0) = wg;
                    long oidx = -1;
                    if (row < ROW_S0) { const int t = row & 2047; if (t >= 2046) oidx = (long)O_NSCP + (long)((row >> 11) * 2 + (t - 2046)) * SCW; }
                    else if (row < ROW_M0) { const int t = row & 7; if (t >= 6) oidx = (long)O_NSCS + (long)(((row - ROW_S0) >> 3) * 2 + (t - 6)) * SCW; }
                    if (oidx >= 0) *(f32x4*)(out + oidx + j0) = uu; }
        } else if (pn < 88) {
#pragma unroll
            for (int ai = 0; ai < 2; ++ai)
#pragma unroll
                for (int m = 0; m < 4; ++m) { const int row = rbase + ai * 128 + m * 16; const int j0 = (pn - 72) * 128 + wc * 32 + 8 * fq;
                    const f32x4 a0 = acc[ai][0][m][0], a1 = acc[ai][0][m][1], b0 = acc[ai][1][m][0], b1 = acc[ai][1][m][1]; u32x4 wa, wb;
                    wa.x = cvt_pk_bf16(fsigmoid(a0[0]), fsigmoid(a0[1])); wa.y = cvt_pk_bf16(fsigmoid(a0[2]), fsigmoid(a0[3])); wa.z = cvt_pk_bf16(fsigmoid(a1[0]), fsigmoid(a1[1])); wa.w = cvt_pk_bf16(fsigmoid(a1[2]), fsigmoid(a1[3]));
                    wb.x = cvt_pk_bf16(fsigmoid(b0[0]), fsigmoid(b0[1])); wb.y = cvt_pk_bf16(fsigmoid(b0[2]), fsigmoid(b0[3])); wb.z = cvt_pk_bf16(fsigmoid(b1[0]), fsigmoid(b1[1])); wb.w = cvt_pk_bf16(fsigmoid(b1[2]), fsigmoid(b1[3]));
                    *(u32x4*)(SGA + (size_t)row * D + j0) = wa; *(u32x4*)(SGB + (size_t)row * D + j0) = wb; }
        } else {
            if (wc < 2) {
                const int c0 = wc * 32 + 8 * fq; const f32x4 bb0 = *(const f32x4*)(dt_bias + c0), bb1 = *(const f32x4*)(dt_bias + c0 + 4);
#pragma unroll
                for (int ai = 0; ai < 2; ++ai)
#pragma unroll
                    for (int m = 0; m < 4; ++m) { const int row = rbase + ai * 128 + m * 16; f32x4 v0 = acc[ai][0][m][0] + bb0, v1 = acc[ai][0][m][1] + bb1;
#pragma unroll
                        for (int e = 0; e < 4; ++e) { v0[e] = v0[e] > 20.f ? v0[e] : log1pf(expf(v0[e])); v1[e] = v1[e] > 20.f ? v1[e] : log1pf(expf(v1[e])); }
                        *(f32x4*)(DT + (size_t)row * 64 + c0) = v0; *(f32x4*)(DT + (size_t)row * 64 + c0 + 4) = v1; }
            }
        }
    }
};
struct EpiYA {
    static constexpr bool PERM = true;
    const bf16_t* SGA; float* YA;
    __device__ __forceinline__ void operator()(const f32x4 (&acc)[2][2][4][2], const pg8::Unit& u, int wr, int wc, int fr, int fq) const {
        const int rbase = u.pm * 256 + wr * 64 + fr;
#pragma unroll
        for (int ai = 0; ai < 2; ++ai)
#pragma unroll
            for (int m = 0; m < 4; ++m) { const int row = rbase + ai * 128 + m * 16;
#pragma unroll
                for (int bj = 0; bj < 2; ++bj) { const size_t off = (size_t)row * D + u.pn * 256 + bj * 128 + wc * 32 + 8 * fq;
                    const u32x4 g = *(const u32x4*)(SGA + off); float gf[8]; unpack8(g, gf);
                    const f32x4 v0 = acc[ai][bj][m][0], v1 = acc[ai][bj][m][1];
                    *(f32x4*)(YA + off) = (f32x4){v0[0] * gf[0], v0[1] * gf[1], v0[2] * gf[2], v0[3] * gf[3]};
                    *(f32x4*)(YA + off + 4) = (f32x4){v1[0] * gf[4], v1[1] * gf[5], v1[2] * gf[6], v1[3] * gf[7]}; }
                asm volatile("" ::: "memory"); }
    }
};
struct EpiMerge {
    static constexpr bool PERM = true;
    const bf16_t* SGB; const float* YA; bf16_t* MG;
    __device__ __forceinline__ void operator()(const f32x4 (&acc)[2][2][4][2], const pg8::Unit& u, int wr, int wc, int fr, int fq) const {
        const int rbase = u.pm * 256 + wr * 64 + fr;
#pragma unroll
        for (int ai = 0; ai < 2; ++ai)
#pragma unroll
            for (int m = 0; m < 4; ++m) { const int row = rbase + ai * 128 + m * 16;
#pragma unroll
                for (int bj = 0; bj < 2; ++bj) { const size_t off = (size_t)row * D + u.pn * 256 + bj * 128 + wc * 32 + 8 * fq;
                    const u32x4 g = *(const u32x4*)(SGB + off); float gf[8]; unpack8(g, gf);
                    const f32x4 y0 = *(const f32x4*)(YA + off), y1 = *(const f32x4*)(YA + off + 4);
                    const f32x4 v0 = acc[ai][bj][m][0], v1 = acc[ai][bj][m][1]; u32x4 w;
                    w.x = cvt_pk_bf16(y0[0] + v0[0] * gf[0], y0[1] + v0[1] * gf[1]); w.y = cvt_pk_bf16(y0[2] + v0[2] * gf[2], y0[3] + v0[3] * gf[3]);
                    w.z = cvt_pk_bf16(y1[0] + v1[0] * gf[4], y1[1] + v1[1] * gf[5]); w.w = cvt_pk_bf16(y1[2] + v1[2] * gf[6], y1[3] + v1[3] * gf[7]);
                    *(u32x4*)(MG + off) = w; }
                asm volatile("" ::: "memory"); }
    }
};
struct EpiOut {
    static constexpr bool PERM = false;
    const float* xp; const float* xs; float* OUTP;
    __device__ __forceinline__ void operator()(const f32x4 (&acc)[2][2][4][2], const pg8::Unit& u, int wr, int wc, int fr, int fq) const {
        const int rbase = u.pm * 256 + wr * 64 + fr;
#pragma unroll
        for (int ai = 0; ai < 2; ++ai)
#pragma unroll
            for (int m = 0; m < 4; ++m) { const int row = rbase + ai * 128 + m * 16;
                const float* xr = row < ROW_S0 ? xp + (size_t)row * D : xs + (size_t)(row - ROW_S0) * D;
#pragma unroll
                for (int bj = 0; bj < 2; ++bj)
#pragma unroll
                    for (int n = 0; n < 2; ++n) { const int col = u.pn * 256 + bj * 128 + wc * 32 + n * 16 + 4 * fq;
                        const f32x4 xv = *(const f32x4*)(xr + col); *(f32x4*)(OUTP + (size_t)row * D + col) = xv + acc[ai][bj][m][n]; }
                asm volatile("" ::: "memory"); }
    }
};

struct Args { const float* in[19]; float* out; unsigned char* ws; int ph_lo, ph_hi; };
enum { I_XP = 0, I_XS, I_SCONV4, I_SSM, I_SSCONV, I_META, I_NORMW, I_WIN, I_CW, I_CB, I_DTB, I_ALOG, I_DSKIP, I_SNW, I_WSSD, I_SCW, I_WSC, I_WO, I_FNW };

__device__ __forceinline__ int wt1_src_col(int np) {
    const int pn = np >> 8, c = np & 255;
    if (pn < 40) return np;
    if (pn < 72) { const int q = 2 * (c >> 7) + ((c >> 2) & 1), jl = 16 * ((c >> 5) & 3) + 4 * ((c >> 3) & 3) + (c & 3); return C_SC + 2048 * q + 64 * (pn - 40) + jl; }
    if (pn < 88) return C_G + 2048 * (c >> 7) + 128 * (pn - 72) + (c & 127);
    return c < 64 ? C_DT + c : -1;
}
__device__ __forceinline__ void transpose_item(const float* W, int ldw, int K, int srccol, const float* kscale, bf16_t* WT, int n0, int k0, LAS float* scr, int lane) {
#pragma unroll 8
    for (int i = 0; i < 32; ++i) { const int kk = 2 * i + (lane >> 5); float v = 0.f; if (srccol >= 0) v = W[(size_t)(k0 + kk) * ldw + srccol]; if (kscale) v *= kscale[k0 + kk]; scr[kk * 33 + (lane & 31)] = v; }
    LDS_WAIT();
    const int c = lane & 7;
#pragma unroll
    for (int j = 0; j < 4; ++j) { const int n = (lane >> 3) + 8 * j; const LAS float* s = scr + (8 * c) * 33 + n;
        u32x4 o; o.x = cvt_pk_bf16(s[0 * 33], s[1 * 33]); o.y = cvt_pk_bf16(s[2 * 33], s[3 * 33]); o.z = cvt_pk_bf16(s[4 * 33], s[5 * 33]); o.w = cvt_pk_bf16(s[6 * 33], s[7 * 33]);
        *(u32x4*)(WT + (size_t)(n0 + n) * K + k0 + 8 * c) = o; }
    LDS_WAIT();
}
__device__ __forceinline__ void phase_prep(const Args& a, LAS unsigned char* lds, int G) {
    const int tid = threadIdx.x, lane = tid & 63, wave = __builtin_amdgcn_readfirstlane(tid >> 6);
    const int gw = blockIdx.x * 8 + wave, NGW = G * 8;
    LAS float* scr = (LAS float*)(lds + wave * 8704);
    bf16_t* WT1 = (bf16_t*)(a.ws + W_WT1); bf16_t* WT2A = (bf16_t*)(a.ws + W_WT2A); bf16_t* WT2B = (bf16_t*)(a.ws + W_WT2B); bf16_t* WT3 = (bf16_t*)(a.ws + W_WT3);
    constexpr int I1 = 32 * (NP1 / 32), I2A = 64 * 64, I2B = 32 * 64, I3 = 32 * 64;
    for (int it = gw; it < I1 + I2A + I2B + I3; it += NGW) {
        int r = it;
        if (r < I1) { const int kb = r / (NP1 / 32), nb = r % (NP1 / 32); const int sc = wt1_src_col(nb * 32 + (lane & 31)); transpose_item(a.in[I_WIN], PROJ, D, sc, nullptr, WT1, nb * 32, kb * 64, scr, lane); continue; } r -= I1;
        if (r < I2A) { const int kb = r / 64, nb = r % 64; transpose_item(a.in[I_WSSD], D, DI, nb * 32 + (lane & 31), a.in[I_SNW], WT2A, nb * 32, kb * 64, scr, lane); continue; } r -= I2A;
        if (r < I2B) { const int kb = r / 64, nb = r % 64; transpose_item(a.in[I_WSC], D, D, nb * 32 + (lane & 31), nullptr, WT2B, nb * 32, kb * 64, scr, lane); continue; } r -= I2B;
        { const int kb = r / 64, nb = r % 64; transpose_item(a.in[I_WO], D, D, nb * 32 + (lane & 31), nullptr, WT3, nb * 32, kb * 64, scr, lane); }
    }
    bf16_t* H = (bf16_t*)(a.ws + W_H); const float* nw = a.in[I_NORMW];
    for (int r = gw; r < MP; r += NGW) {
        const float* src = r < ROW_S0 ? a.in[I_XP] + (size_t)r * D : (r < ROW_M0 ? a.in[I_XS] + (size_t)(r - ROW_S0) * D : (r < M_REAL ? a.in[I_META] + (size_t)(r - ROW_M0) * D : nullptr));
        f32x4 v[8]; float s = 0.f;
#pragma unroll
        for (int j = 0; j < 8; ++j) { v[j] = src ? ((const f32x4*)src)[lane + 64 * j] : (f32x4){0.f, 0.f, 0.f, 0.f}; s += (v[j][0] * v[j][0] + v[j][1] * v[j][1]) + (v[j][2] * v[j][2] + v[j][3] * v[j][3]); }
        const float rs = 1.0f / sqrtf(wave_sum(s) * (1.0f / D) + EPS);
#pragma unroll
        for (int j = 0; j < 8; ++j) { const f32x4 w = ((const f32x4*)nw)[lane + 64 * j]; u32x2 o; o.x = cvt_pk_bf16(v[j][0] * rs * w[0], v[j][1] * rs * w[1]); o.y = cvt_pk_bf16(v[j][2] * rs * w[2], v[j][3] * rs * w[3]);
            ((u32x2*)(H + (size_t)r * D))[lane + 64 * j] = o; }
    }
}

__device__ __forceinline__ void phase_conv(const Args& a, int G) {
    const int tid = threadIdx.x;
    const bf16_t* XBC = (const bf16_t*)(a.ws + W_XBC); const bf16_t* U = (const bf16_t*)(a.ws + W_U); const bf16_t* GBp = (const bf16_t*)(a.ws + W_GB);
    bf16_t* XC = (bf16_t*)(a.ws + W_XC); bf16_t* YBIN = (bf16_t*)(a.ws + W_YBIN);
    for (int item = blockIdx.x; item < 578; item += G) {
        const int hf = item & 1, blk = item >> 1; const int cg = hf * 512 + tid; const bool isx = cg < 768;
        int r0, nseg, segrows, mode;
        if (blk < 256) { const int b = blk >> 6, kb = blk & 63; r0 = b * 2048 + kb * 32; nseg = 1; segrows = 32; mode = kb == 0 ? 1 : 0; }
        else if (blk < 288) { r0 = ROW_S0 + (blk - 256) * 32; nseg = 4; segrows = 8; mode = 2; }
        else { r0 = ROW_M0; nseg = 1; segrows = 16; mode = 3; }
        if (isx) {
            const int c0 = cg * 8; float w[4][8], bias[8];
#pragma unroll
            for (int k = 0; k < 4; ++k) { const f32x4 p = *(const f32x4*)(a.in[I_CW] + k * CONVD + c0), q = *(const f32x4*)(a.in[I_CW] + k * CONVD + c0 + 4);
                w[k][0] = p[0]; w[k][1] = p[1]; w[k][2] = p[2]; w[k][3] = p[3]; w[k][4] = q[0]; w[k][5] = q[1]; w[k][6] = q[2]; w[k][7] = q[3]; }
            { const f32x4 p = *(const f32x4*)(a.in[I_CB] + c0), q = *(const f32x4*)(a.in[I_CB] + c0 + 4); bias[0] = p[0]; bias[1] = p[1]; bias[2] = p[2]; bias[3] = p[3]; bias[4] = q[0]; bias[5] = q[1]; bias[6] = q[2]; bias[7] = q[3]; }
            for (int sg = 0; sg < nseg; ++sg) {
                const int rs = r0 + sg * segrows; float x3[8], x2[8], x1[8];
                if (mode == 0 || mode == 1) { const int pr = mode == 0 ? rs - 3 : M_REAL - 3;
                    unpack8(*(const u32x4*)(XBC + (size_t)pr * CONVD + c0), x3); unpack8(*(const u32x4*)(XBC + (size_t)(pr + 1) * CONVD + c0), x2); unpack8(*(const u32x4*)(XBC + (size_t)(pr + 2) * CONVD + c0), x1); }
                else if (mode == 2) { const float* st = a.in[I_SCONV4] + (size_t)((rs - ROW_S0) >> 3) * 3 * CONVD + c0;
#pragma unroll
                    for (int e = 0; e < 8; ++e) { x3[e] = st[e]; x2[e] = st[CONVD + e]; x1[e] = st[2 * CONVD + e]; } }
                else {
#pragma unroll
                    for (int e = 0; e < 8; ++e) { x3[e] = 0.f; x2[e] = 0.f; x1[e] = 0.f; } }
                for (int i = 0; i < segrows; ++i) { const int r = rs + i; float cur[8], o[8]; unpack8(*(const u32x4*)(XBC + (size_t)r * CONVD + c0), cur);
#pragma unroll
                    for (int e = 0; e < 8; ++e) { const float v = bias[e] + w[0][e] * x3[e] + w[1][e] * x2[e] + w[2][e] * x1[e] + w[3][e] * cur[e]; o[e] = fsilu(v); x3[e] = x2[e]; x2[e] = x1[e]; x1[e] = cur[e]; }
                    *(u32x4*)(XC + (size_t)r * CONVD + c0) = pack8(o); }
            }
        } else {
            const int j0 = (cg - 768) * 8; float w[3][8];
#pragma unroll
            for (int k = 0; k < 3; ++k) { const f32x4 p = *(const f32x4*)(a.in[I_SCW] + k * SCW + j0), q = *(const f32x4*)(a.in[I_SCW] + k * SCW + j0 + 4);
                w[k][0] = p[0]; w[k][1] = p[1]; w[k][2] = p[2]; w[k][3] = p[3]; w[k][4] = q[0]; w[k][5] = q[1]; w[k][6] = q[2]; w[k][7] = q[3]; }
            for (int sg = 0; sg < nseg; ++sg) {
                const int rs = r0 + sg * segrows; float u2[8], u1[8];
                if (mode == 0 || mode == 1) { const int pr = mode == 0 ? rs - 2 : M_REAL - 2;
                    unpack8(*(const u32x4*)(U + (size_t)pr * SCW + j0), u2); unpack8(*(const u32x4*)(U + (size_t)(pr + 1) * SCW + j0), u1); }
                else if (mode == 2) { const float* st = a.in[I_SSCONV] + (size_t)((rs - ROW_S0) >> 3) * 2 * SCW + j0;
#pragma unroll
                    for (int e = 0; e < 8; ++e) { u2[e] = st[e]; u1[e] = st[SCW + e]; } }
                else {
#pragma unroll
                    for (int e = 0; e < 8; ++e) { u2[e] = 0.f; u1[e] = 0.f; } }
                for (int i = 0; i < segrows; ++i) { const int r = rs + i; float cur[8], gt[8], o[8]; unpack8(*(const u32x4*)(U + (size_t)r * SCW + j0), cur); unpack8(*(const u32x4*)(GBp + (size_t)r * SCW + j0), gt);
#pragma unroll
                    for (int e = 0; e < 8; ++e) { const float v = w[0][e] * u2[e] + w[1][e] * u1[e] + w[2][e] * cur[e]; o[e] = gt[e] * v; u2[e] = u1[e]; u1[e] = cur[e]; }
                    *(u32x4*)(YBIN + (size_t)r * SCW + j0) = pack8(o); }
            }
        }
    }
}

__device__ __forceinline__ void ssd_item(const Args& a, LAS unsigned char* lds, int seqkind  , int seq, int head) {
    const int tid = threadIdx.x, p = tid >> 3, nq = tid & 7, g = head >> 3;
    const bf16_t* XC = (const bf16_t*)(a.ws + W_XC); const float* DT = (const float*)(a.ws + W_DT); bf16_t* Y = (bf16_t*)(a.ws + W_Y);
    LAS float* xs = (LAS float*)lds;
    LAS float* Bs = xs + 16 * 64;
    LAS float* Cs = Bs + 16 * 128;
    LAS float* dts = Cs + 16 * 128;
    LAS float* das = dts + 16;
    LAS float* ys = das + 16;
    const float Ah = -expf(a.in[I_ALOG][head]); const float Dh = a.in[I_DSKIP][head];
    float h[16];
    if (seqkind == 1) { const float* s0 = a.in[I_SSM] + ((size_t)(seq * NH + head) * HP + p) * NS + nq * 16;
#pragma unroll
        for (int k = 0; k < 4; ++k) { const f32x4 v = *(const f32x4*)(s0 + 4 * k); h[4 * k] = v[0]; h[4 * k + 1] = v[1]; h[4 * k + 2] = v[2]; h[4 * k + 3] = v[3]; } }
    else {
#pragma unroll
        for (int k = 0; k < 16; ++k) h[k] = 0.f; }
    const int nchunk = seqkind == 0 ? 1 + SEQ / 16 : 1; const int crow = seqkind == 0 ? 16 : 8;
    u32x4 pf0, pf1; float pdt = 0.f;
    auto rowof = [&](int c, int i) -> int { return seqkind == 0 ? (c == 0 ? ROW_M0 + i : seq * 2048 + (c - 1) * 16 + i) : ROW_S0 + seq * 8 + i; };
    auto piece_ptr = [&](int c, int pc) -> const bf16_t* { const int i = pc / 40, q = pc % 40; const int r = rowof(c, i < crow ? i : 0);
        const int col = q < 8 ? head * 64 + q * 8 : (q < 24 ? DI + g * 128 + (q - 8) * 8 : DI + 1024 + g * 128 + (q - 24) * 8); return XC + (size_t)r * CONVD + col; };
    auto prefetch = [&](int c) { pf0 = *(const u32x4*)piece_ptr(c, tid); if (tid < 128) pf1 = *(const u32x4*)piece_ptr(c, 512 + tid); if (tid < crow) pdt = DT[(size_t)rowof(c, tid) * 64 + head]; };
    auto stash_piece = [&](int pc, const u32x4 v) { const int i = pc / 40, q = pc % 40; float f[8]; unpack8(v, f);
        LAS float* dst = q < 8 ? xs + i * 64 + q * 8 : (q < 24 ? Bs + i * 128 + (q - 8) * 8 : Cs + i * 128 + (q - 24) * 8);
        *(LAS f32x4*)dst = (f32x4){f[0], f[1], f[2], f[3]}; *(LAS f32x4*)(dst + 4) = (f32x4){f[4], f[5], f[6], f[7]}; };
    prefetch(0);
    for (int c = 0; c < nchunk; ++c) {
        __syncthreads();
        stash_piece(tid, pf0); if (tid < 128) stash_piece(512 + tid, pf1);
        if (tid < crow) { dts[tid] = pdt; das[tid] = expf(pdt * Ah); }
        __syncthreads();
        if (c + 1 < nchunk) prefetch(c + 1);
        for (int i = 0; i < crow; ++i) {
            const float xv = xs[i * 64 + p], dtv = dts[i], av = das[i]; const float xdt = xv * dtv; float y = 0.f;
#pragma unroll
            for (int k = 0; k < 4; ++k) { const f32x4 b = *(const LAS f32x4*)(Bs + i * 128 + nq * 16 + 4 * k), cc = *(const LAS f32x4*)(Cs + i * 128 + nq * 16 + 4 * k);
#pragma unroll
                for (int e = 0; e < 4; ++e) { h[4 * k + e] = av * h[4 * k + e] + xdt * b[e]; y += cc[e] * h[4 * k + e]; } }
            y += __shfl_xor(y, 1); y += __shfl_xor(y, 2); y += __shfl_xor(y, 4);
            if (nq == 0) ys[i * 64 + p] = y + Dh * xv;
        }
        __syncthreads();
        { const int i = tid >> 5, pp = (tid & 31) * 2; if (i < crow) { const unsigned w = cvt_pk_bf16(ys[i * 64 + pp], ys[i * 64 + pp + 1]); *(unsigned*)(Y + (size_t)rowof(c, i) * DI + head * 64 + pp) = w; } }
    }
    float* so = a.out + (seqkind == 0 ? O_NSSMP : O_NSSMS) + ((size_t)(seq * NH + head) * HP + p) * NS + nq * 16;
#pragma unroll
    for (int k = 0; k < 4; ++k) *(f32x4*)(so + 4 * k) = (f32x4){h[4 * k], h[4 * k + 1], h[4 * k + 2], h[4 * k + 3]};
}
__device__ __forceinline__ void phase_ssd(const Args& a, LAS unsigned char* lds, int G) {
    for (int it = blockIdx.x; it < NB * NH; it += G) ssd_item(a, lds, 0, it >> 6, it & 63);
    for (int it = blockIdx.x; it < DECB * NH; it += G) ssd_item(a, lds, 1, it >> 6, it & 63);
}

__device__ __forceinline__ void phase_gnorm(const Args& a, int G) {
    const int tid = threadIdx.x, lane = tid & 63, wave = tid >> 6; const int gw = blockIdx.x * 8 + wave, NGW = G * 8;
    const bf16_t* Y = (const bf16_t*)(a.ws + W_Y); const bf16_t* ZS = (const bf16_t*)(a.ws + W_ZS); bf16_t* YN = (bf16_t*)(a.ws + W_YN);
    for (int r = gw; r < M_OUT; r += NGW) {
#pragma unroll 2
        for (int g = 0; g < NG; ++g) { const size_t off = (size_t)r * DI + g * 512 + lane * 8; float y[8], z[8], o[8]; unpack8(*(const u32x4*)(Y + off), y); unpack8(*(const u32x4*)(ZS + off), z);
            float s = 0.f;
#pragma unroll
            for (int e = 0; e < 8; ++e) { o[e] = y[e] * z[e]; s += o[e] * o[e]; }
            const float rs = 1.0f / sqrtf(wave_sum(s) * (1.0f / 512.0f) + EPS);
#pragma unroll
            for (int e = 0; e < 8; ++e) o[e] *= rs;
            *(u32x4*)(YN + off) = pack8(o); }
    }
}
__device__ __forceinline__ void phase_final(const Args& a, int G) {
    const int tid = threadIdx.x, lane = tid & 63, wave = tid >> 6; const int gw = blockIdx.x * 8 + wave, NGW = G * 8;
    const float* OUTP = (const float*)(a.ws + W_OUTP); const float* fw = a.in[I_FNW];
    for (int r = gw; r < M_OUT; r += NGW) {
        f32x4 v[8]; float s = 0.f;
#pragma unroll
        for (int j = 0; j < 8; ++j) { v[j] = ((const f32x4*)(OUTP + (size_t)r * D))[lane + 64 * j]; s += (v[j][0] * v[j][0] + v[j][1] * v[j][1]) + (v[j][2] * v[j][2] + v[j][3] * v[j][3]); }
        const float rs = 1.0f / sqrtf(wave_sum(s) * (1.0f / D) + EPS);
#pragma unroll
        for (int j = 0; j < 8; ++j) { const f32x4 w = ((const f32x4*)fw)[lane + 64 * j]; ((f32x4*)(a.out + (size_t)r * D))[lane + 64 * j] = (f32x4){v[j][0] * rs * w[0], v[j][1] * rs * w[1], v[j][2] * rs * w[2], v[j][3] * rs * w[3]}; }
    }
}

constexpr int N_PHASES = 9;
__global__ void __launch_bounds__(512, 2) fwd_kernel(Args a) {
    extern __shared__ __attribute__((aligned(16))) unsigned char lds_raw[];
    LAS unsigned char* lds = (LAS unsigned char*)lds_raw;
    const int G = gridDim.x; const int lo = a.ph_lo, hi = a.ph_hi;
#define IN(k) (lo <= (k) && (k) < hi)
    if (IN(0)) phase_prep(a, lds, G);
    if (IN(1)) {
        pg8::Gemm g{(const bf16_t*)(a.ws + W_H), (const bf16_t*)(a.ws + W_WT1), MP, NP1, D}; pg8::StaticOrder S; S.init(MP, NP1, G, (int)blockIdx.x);
        Epi1 E{(bf16_t*)(a.ws + W_ZS), (bf16_t*)(a.ws + W_XBC), (bf16_t*)(a.ws + W_U), (bf16_t*)(a.ws + W_GB), (bf16_t*)(a.ws + W_SGA), (bf16_t*)(a.ws + W_SGB), (float*)(a.ws + W_DT), a.in[I_DTB], a.out};
        pg8::gemm_phase<Epi1, pg8::StaticOrder, true, true>(lds, g, S, E);
    }
    if (IN(2)) phase_conv(a, G);
    if (IN(3)) phase_ssd(a, lds, G);
    if (IN(4)) phase_gnorm(a, G);
    if (IN(5)) {
        pg8::Gemm g{(const bf16_t*)(a.ws + W_YN), (const bf16_t*)(a.ws + W_WT2A), M_OUT, D, DI}; pg8::StaticOrder S; S.init(M_OUT, D, G, (int)blockIdx.x);
        EpiYA E{(const bf16_t*)(a.ws + W_SGA), (float*)(a.ws + W_YA)};
        pg8::gemm_phase<EpiYA, pg8::StaticOrder, true, true>(lds, g, S, E);
    }
    if (IN(6)) {
        pg8::Gemm g{(const bf16_t*)(a.ws + W_YBIN), (const bf16_t*)(a.ws + W_WT2B), M_OUT, D, D}; pg8::StaticOrder S; S.init(M_OUT, D, G, (int)blockIdx.x);
        EpiMerge E{(const bf16_t*)(a.ws + W_SGB), (const float*)(a.ws + W_YA), (bf16_t*)(a.ws + W_MERGED)};
        pg8::gemm_phase<EpiMerge, pg8::StaticOrder, true, true>(lds, g, S, E);
    }
    if (IN(7)) {
        pg8::Gemm g{(const bf16_t*)(a.ws + W_MERGED), (const bf16_t*)(a.ws + W_WT3), M_OUT, D, D}; pg8::StaticOrder S; S.init(M_OUT, D, G, (int)blockIdx.x);
        EpiOut E{a.in[I_XP], a.in[I_XS], (float*)(a.ws + W_OUTP)};
        pg8::gemm_phase<EpiOut, pg8::StaticOrder, true, true>(lds, g, S, E);
    }
    if (IN(8)) phase_final(a, G);
#undef IN
}

extern "C" void kernel_launch(void* const* d_in, const int* in_sizes, int n_in, void* d_out, int out_size, void* d_ws, size_t ws_size, hipStream_t stream) {
    static int grid = 0;
    if (grid == 0) {
        int dev = 0, cus = 0;
        if (n_in != 19 || ws_size < W_END) { fprintf(stderr, "kernel_launch: unexpected n_in %d or ws_size %zu (< %zu)\n", n_in, ws_size, (size_t)W_END); grid = -1; return; }
        if (hipGetDevice(&dev) != hipSuccess || hipDeviceGetAttribute(&cus, hipDeviceAttributeMultiprocessorCount, dev) != hipSuccess) { grid = -1; return; }
        if (hipFuncSetAttribute((const void*)fwd_kernel, hipFuncAttributeMaxDynamicSharedMemorySize, LDS_BYTES) != hipSuccess) { fprintf(stderr, "kernel_launch: hipFuncSetAttribute failed\n"); grid = -1; return; }
        grid = cus;
    }
    if (grid < 0) return;
    Args a{};
    for (int i = 0; i < 19; ++i) a.in[i] = (const float*)d_in[i];
    a.out = (float*)d_out; a.ws = (unsigned char*)d_ws;
    for (int ph = 0; ph < N_PHASES; ++ph) { a.ph_lo = ph; a.ph_hi = ph + 1; hipLaunchKernelGGL(fwd_kernel, dim3(grid), dim3(512), LDS_BYTES, stream, a); }
}
```

```cpp
#include <hip/hip_runtime.h>
#include <cstdio>
#include <cstdint>

#define LAS __attribute__((address_space(3)))
typedef unsigned short bf16_t;
typedef short bf16x8 __attribute__((ext_vector_type(8)));
typedef float f32x4 __attribute__((ext_vector_type(4)));
typedef float f32x2 __attribute__((ext_vector_type(2)));
typedef unsigned u32x4 __attribute__((ext_vector_type(4)));
typedef unsigned u32x2 __attribute__((ext_vector_type(2)));

constexpr int D = 2048, NB = 4, SEQ = 2048, META = 16, DECB = 128, DECS = 8;
constexpr int DI = 4096, NH = 64, HP = 64, NS = 128, NG = 8, CONVD = 6144, SCW = 2048, PROJ = 22592;
constexpr float EPS = 1e-6f;
constexpr int ROW_S0 = 8192, ROW_M0 = 9216, M_REAL = 9232, MP = 9472, M_OUT = 9216;
constexpr int NP1 = 89 * 256;
constexpr int C_XBC = 4096, C_DT = 10240, C_SC = 10304, C_G = 18496;
constexpr size_t O_YP = 0, O_YS = 16777216, O_NCP = 18874368, O_NSSMP = 18948096, O_NSCP = 21045248, O_NCS = 21061632, O_NSSMS = 23420928, O_NSCS = 90529792;
constexpr size_t SZ_R2K = (size_t)MP * 2048 * 2;
constexpr size_t W_H = 0;
constexpr size_t W_WT1 = W_H + SZ_R2K;
constexpr int K2 = 6144;
constexpr size_t W_WT2 = W_WT1 + (size_t)NP1 * 2048 * 2;
constexpr size_t W_WT3 = W_WT2 + (size_t)2048 * K2 * 2;
constexpr size_t W_ZS = W_WT3 + (size_t)2048 * 2048 * 2;
constexpr size_t W_XBC = W_ZS + (size_t)MP * 4096 * 2;
constexpr size_t W_DT = W_XBC + (size_t)MP * 6144 * 2;
constexpr size_t W_U = W_DT + (size_t)MP * 64 * 4;
constexpr size_t W_GB = W_U + SZ_R2K;
constexpr size_t W_SGA = W_GB + SZ_R2K;
constexpr size_t W_SGR = W_SGA + SZ_R2K;
constexpr size_t W_XC = W_SGR + SZ_R2K;
constexpr size_t W_A2 = W_XC + (size_t)MP * 6144 * 2;
constexpr size_t W_MERGED = W_A2 + (size_t)MP * K2 * 2;
constexpr size_t W_CTL = W_MERGED + SZ_R2K;
constexpr size_t CTL_BYTES = 32768;
constexpr size_t CTL_PANEL = 16384, CTL_PANEL2 = 24576;
constexpr size_t W_SSQ = W_CTL + CTL_BYTES;
constexpr size_t W_PS = W_SSQ + (size_t)MP * 64 * 4;
constexpr size_t W_PS2 = W_PS + (size_t)ROW_S0 * 8 * 4;
constexpr size_t W_END = W_PS2 + (size_t)1024 * 32 * 4;
constexpr size_t W_OUTP = W_XBC;

constexpr int LDS_BYTES = 163840;
constexpr int LDS_MISC = 163840 - 64;

typedef __bf16 bf16x2v __attribute__((ext_vector_type(2)));
__device__ __forceinline__ unsigned cvt_pk_bf16(float lo, float hi) { f32x2 v = {lo, hi}; bf16x2v b = __builtin_convertvector(v, bf16x2v); return __builtin_bit_cast(unsigned, b); }
__device__ __forceinline__ float bf_lo(unsigned w) { return __uint_as_float(w << 16); }
__device__ __forceinline__ float bf_hi(unsigned w) { return __uint_as_float(w & 0xffff0000u); }
__device__ __forceinline__ float fsigmoid(float x) { return __builtin_amdgcn_rcpf(1.0f + __expf(-x)); }
__device__ __forceinline__ float fsilu(float x) { return x * fsigmoid(x); }
__device__ __forceinline__ f32x4 silu4(const f32x4 v) {
    const f32x2 xa = (f32x2){v[0], v[1]}, xb = (f32x2){v[2], v[3]}, cs = (f32x2){-1.44269504088896f, -1.44269504088896f}, one = (f32x2){1.0f, 1.0f};
    const f32x2 ta = xa * cs, tb = xb * cs;
    const float e0 = __builtin_amdgcn_exp2f(ta[0]), e1 = __builtin_amdgcn_exp2f(ta[1]), e2 = __builtin_amdgcn_exp2f(tb[0]), e3 = __builtin_amdgcn_exp2f(tb[1]);
    const f32x2 ua = (f32x2){e0, e1} + one, ub = (f32x2){e2, e3} + one;
    const float r0 = __builtin_amdgcn_rcpf(ua[0]), r1 = __builtin_amdgcn_rcpf(ua[1]), r2 = __builtin_amdgcn_rcpf(ub[0]), r3 = __builtin_amdgcn_rcpf(ub[1]);
    const f32x2 ya = xa * (f32x2){r0, r1}, yb = xb * (f32x2){r2, r3};
    return (f32x4){ya[0], ya[1], yb[0], yb[1]};
}
__device__ __forceinline__ void gate4(const f32x4 ga4, const f32x4 gb4, float* sa, float* rt) {
    const f32x2 cs = (f32x2){-1.44269504088896f, -1.44269504088896f}, one = (f32x2){1.0f, 1.0f};
    f32x2 a0 = (f32x2){fminf(fmaxf(ga4[0], -30.f), 30.f), fminf(fmaxf(ga4[1], -30.f), 30.f)}, a1 = (f32x2){fminf(fmaxf(ga4[2], -30.f), 30.f), fminf(fmaxf(ga4[3], -30.f), 30.f)};
    f32x2 b0 = (f32x2){fminf(fmaxf(gb4[0], -30.f), 30.f), fminf(fmaxf(gb4[1], -30.f), 30.f)}, b1 = (f32x2){fminf(fmaxf(gb4[2], -30.f), 30.f), fminf(fmaxf(gb4[3], -30.f), 30.f)};
    a0 = a0 * cs; a1 = a1 * cs; b0 = b0 * cs; b1 = b1 * cs;
    const f32x2 ea0 = (f32x2){__builtin_amdgcn_exp2f(a0[0]), __builtin_amdgcn_exp2f(a0[1])} + one, ea1 = (f32x2){__builtin_amdgcn_exp2f(a1[0]), __builtin_amdgcn_exp2f(a1[1])} + one;
    const f32x2 eb0 = (f32x2){__builtin_amdgcn_exp2f(b0[0]), __builtin_amdgcn_exp2f(b0[1])} + one, eb1 = (f32x2){__builtin_amdgcn_exp2f(b1[0]), __builtin_amdgcn_exp2f(b1[1])} + one;
    sa[0] = __builtin_amdgcn_rcpf(ea0[0]); sa[1] = __builtin_amdgcn_rcpf(ea0[1]); sa[2] = __builtin_amdgcn_rcpf(ea1[0]); sa[3] = __builtin_amdgcn_rcpf(ea1[1]);
    const f32x2 r0 = ea0 * (f32x2){__builtin_amdgcn_rcpf(eb0[0]), __builtin_amdgcn_rcpf(eb0[1])}, r1 = ea1 * (f32x2){__builtin_amdgcn_rcpf(eb1[0]), __builtin_amdgcn_rcpf(eb1[1])};
    rt[0] = r0[0]; rt[1] = r0[1]; rt[2] = r1[0]; rt[3] = r1[1];
}
__device__ __forceinline__ void silu4_pk_bf16(const f32x4 v, unsigned& lo, unsigned& hi) {
    const f32x2 xa = (f32x2){v[0], v[1]}, xb = (f32x2){v[2], v[3]}, cs = (f32x2){-1.44269504088896f, -1.44269504088896f}, one = (f32x2){1.0f, 1.0f};
    const f32x2 ta = xa * cs, tb = xb * cs;
    const float e0 = __builtin_amdgcn_exp2f(ta[0]), e1 = __builtin_amdgcn_exp2f(ta[1]), e2 = __builtin_amdgcn_exp2f(tb[0]), e3 = __builtin_amdgcn_exp2f(tb[1]);
    const f32x2 ua = (f32x2){e0, e1} + one, ub = (f32x2){e2, e3} + one;
    const float r0 = __builtin_amdgcn_rcpf(ua[0]), r1 = __builtin_amdgcn_rcpf(ua[1]), r2 = __builtin_amdgcn_rcpf(ub[0]), r3 = __builtin_amdgcn_rcpf(ub[1]);
    const f32x2 ya = xa * (f32x2){r0, r1}, yb = xb * (f32x2){r2, r3};
    lo = cvt_pk_bf16(ya[0], ya[1]); hi = cvt_pk_bf16(yb[0], yb[1]);
}
__device__ __forceinline__ float wave_sum(float v) {
#pragma unroll
    for (int o = 1; o < 64; o <<= 1) v += __shfl_xor(v, o);
    return v;
}
__device__ __forceinline__ void unpack8(const u32x4 w, float (&f)[8]) {
    f[0] = bf_lo(w.x); f[1] = bf_hi(w.x); f[2] = bf_lo(w.y); f[3] = bf_hi(w.y); f[4] = bf_lo(w.z); f[5] = bf_hi(w.z); f[6] = bf_lo(w.w); f[7] = bf_hi(w.w);
}
__device__ __forceinline__ u32x4 pack8(const float (&f)[8]) {
    u32x4 w; w.x = cvt_pk_bf16(f[0], f[1]); w.y = cvt_pk_bf16(f[2], f[3]); w.z = cvt_pk_bf16(f[4], f[5]); w.w = cvt_pk_bf16(f[6], f[7]); return w;
}
#define LDS_WAIT() asm volatile("s_waitcnt lgkmcnt(0)" ::: "memory")
#define LDS_BARRIER() do { asm volatile("s_waitcnt lgkmcnt(0)" ::: "memory"); __builtin_amdgcn_s_barrier(); asm volatile("" ::: "memory"); } while (0)

namespace pg8 {
constexpr int BM = 256, BK = 64, HALF = 128, HTB = HALF * BK * 2, STAGE_BYTES = 8 * HTB, NXCD = 8, WGM = 8;
__host__ __device__ __forceinline__ int lds_byte(int r, int c) { const int st = (r >> 4) * 2 + (c >> 5), rr = r & 15, cc = c & 31, ob = rr * 64 + cc * 2; return st * 1024 + (ob ^ (((ob >> 9) & 1) << 5)); }
__host__ __device__ __forceinline__ void stage_rc(int b, int& R, int& C) { const int st = b / 1024, sb = b % 1024, swz = sb ^ (((sb >> 9) & 1) << 5); R = (st >> 1) * 16 + swz / 64; C = (st & 1) * 32 + (swz % 64) / 2; }
__host__ __device__ __forceinline__ int perm32(int rho) { const int n = rho >> 4, i = rho & 15; return 8 * (i >> 2) + 4 * n + (i & 3); }
struct Unit { int pm, pn, seg; };
struct Gemm { const bf16_t* A; const bf16_t* Bt; int ldk; int koff0, nt0; int kseg, ntseg;
    __device__ __forceinline__ int koff(int s) const { return s ? (s - 1) * kseg : koff0; } __device__ __forceinline__ int ntiles(int s) const { return s ? ntseg : nt0; } };
struct StaticOrder {
    int nM, nN, nwg, G, c;
    __host__ __device__ void init(int M, int N, int G_, int c_) { nM = M / BM; nN = N / BM; nwg = nM * nN; G = G_; c = c_; }
    __host__ __device__ bool next(int i, Unit& u) const {
        const long L = (long)i * G + c; if (L >= nwg) return false;
        int wgid = (int)L; { const int q = nwg / NXCD, r = nwg % NXCD, xcd = wgid % NXCD, off = wgid / NXCD; wgid = (xcd < r ? xcd * (q + 1) : r * (q + 1) + (xcd - r) * q) + off; }
        const int nig = WGM * nN, gid = wgid / nig, fm = gid * WGM, gsz = (nM - fm) < WGM ? (nM - fm) : WGM;
        u.pm = fm + ((wgid % nig) % gsz); u.pn = (wgid % nig) / gsz; u.seg = 0; return true;
    }
    __device__ __forceinline__ void a_ready(const Unit&) const {}
    __device__ __forceinline__ void done(const Unit&) const {}
};
template <int NSEG> struct SegOrder : StaticOrder {
    __host__ __device__ bool next(int i, Unit& u) const { if (!StaticOrder::next(i / NSEG, u)) return false; u.seg = i % NSEG; return true; }
};

template <class Epi, class Sched, bool ALIGN_EPI = false, bool SP2 = false>
__device__ __forceinline__ void gemm_phase(LAS unsigned char* lds, const Gemm g, const Sched& S, const Epi& E) {
    const int tid = threadIdx.x, wid = __builtin_amdgcn_readfirstlane(tid >> 6), lane = tid & 63, wr = wid >> 2, wc = wid & 3, fr = lane & 15, fq = lane >> 4;
    const int K = g.ldk;
    unsigned voffA[2], voffB[2];
#pragma unroll
    for (int i = 0; i < 2; ++i) { int R, C; stage_rc(tid * 16 + i * 8192, R, C); const int Rb = Epi::PERM ? ((R & ~31) + perm32(R & 31)) : R;
        voffA[i] = (unsigned)(R * K + C) * 2u; voffB[i] = (unsigned)(Rb * K + C) * 2u; }
    const size_t kstep = (size_t)(BK * 2);
    const size_t hstep = (size_t)HALF * K * 2;
    const size_t tstep = 2 * hstep;
    const unsigned ldsw = (unsigned)wid * 1024u;
    const int aoff = lds_byte(wr * 64 + fr, fq * 8), boff = lds_byte(wc * 32 + fr, fq * 8);
#define PG8_SA(b, h) (((b) * 2 + (h)) * HTB)
#define PG8_SB(b, h) ((4 + (b) * 2 + (h)) * HTB)
#define PG8_STAGE(bufoff, gbase, voff) do { _Pragma("unroll") for (int _i = 0; _i < 2; ++_i) \
        __builtin_amdgcn_global_load_lds((const unsigned*)((const char*)(gbase) + (voff)[_i]), (LAS unsigned*)(lds + (bufoff) + ldsw + _i * 8192), 16, 0, 0); } while (0)
#define PG8_LDA(dst, b, h) do { _Pragma("unroll") for (int m = 0; m < 4; ++m) _Pragma("unroll") for (int k = 0; k < 2; ++k) dst[m][k] = *(const LAS bf16x8*)(lds + PG8_SA(b, h) + aoff + m * 2048 + k * 1024); } while (0)
#define PG8_LDB(dst, b, h) do { _Pragma("unroll") for (int n = 0; n < 2; ++n) _Pragma("unroll") for (int k = 0; k < 2; ++k) dst[n][k] = *(const LAS bf16x8*)(lds + PG8_SB(b, h) + boff + n * 2048 + k * 1024); } while (0)
#define PG8_MMA(ai, bj, At, Bt) do { __builtin_amdgcn_s_setprio(1); _Pragma("unroll") for (int m = 0; m < 4; ++m) _Pragma("unroll") for (int n = 0; n < 2; ++n) _Pragma("unroll") for (int k = 0; k < 2; ++k) \
        acc[ai][bj][m][n] = __builtin_amdgcn_mfma_f32_16x16x32_bf16(Bt[n][k], At[m][k], acc[ai][bj][m][n], 0, 0, 0); __builtin_amdgcn_s_setprio(0); } while (0)
#define PG8_WAIT_V(n) asm volatile("s_waitcnt vmcnt(" #n ")" ::: "memory")
#define PG8_WAIT_L(n) asm volatile("s_waitcnt lgkmcnt(" #n ")" ::: "memory")
#define PG8_WAIT_V8R(rx) asm volatile("s_waitcnt vmcnt(24)\n\ts_cmp_lg_u32 %0, 0\n\ts_cbranch_scc1 1\n\ts_waitcnt vmcnt(8)" :: "s"(__builtin_amdgcn_readfirstlane(rx)) : "scc", "memory")
#define PG8_BAR __builtin_amdgcn_s_barrier()
#define PG8_SCHED __builtin_amdgcn_sched_barrier(0)
    Unit cur, nxt; int ui = 0; int rx = 0;
    if (!S.next(0, cur)) return;
    f32x4 acc[2][2][4][2];
#pragma unroll
    for (int a = 0; a < 2; ++a)
#pragma unroll
        for (int b = 0; b < 2; ++b)
#pragma unroll
            for (int m = 0; m < 4; ++m)
#pragma unroll
                for (int n = 0; n < 2; ++n) acc[a][b][m][n] = (f32x4){0.f, 0.f, 0.f, 0.f};
    bf16x8 At[4][2], B0[2][2], B1[2][2];
    const char* cA = (const char*)g.A + (size_t)cur.pm * tstep + (size_t)g.koff(cur.seg) * 2; const char* cB = (const char*)g.Bt + (size_t)cur.pn * tstep + (size_t)g.koff(cur.seg) * 2;
    S.a_ready(cur);
    if constexpr (SP2) {
        PG8_STAGE(PG8_SB(0, 0), cB, voffB); PG8_STAGE(PG8_SB(0, 1), cB + hstep, voffB); PG8_STAGE(PG8_SA(0, 0), cA, voffA); PG8_STAGE(PG8_SA(0, 1), cA + hstep, voffA);
        if (wr == 1) PG8_BAR;
        PG8_WAIT_V(2); PG8_BAR;
        PG8_STAGE(PG8_SB(1, 0), cB + kstep, voffB); PG8_STAGE(PG8_SA(1, 0), cA + kstep, voffA); PG8_STAGE(PG8_SB(1, 1), cB + hstep + kstep, voffB);
        PG8_WAIT_V(6); PG8_BAR;
    } else {
        PG8_STAGE(PG8_SB(0, 0), cB, voffB); PG8_STAGE(PG8_SA(0, 0), cA, voffA); PG8_STAGE(PG8_SB(0, 1), cB + hstep, voffB); PG8_STAGE(PG8_SA(0, 1), cA + hstep, voffA);
        if (wr == 1) PG8_BAR;
        PG8_WAIT_V(4); PG8_BAR;
        PG8_STAGE(PG8_SB(1, 0), cB + kstep, voffB); PG8_STAGE(PG8_SA(1, 0), cA + kstep, voffA); PG8_STAGE(PG8_SB(1, 1), cB + hstep + kstep, voffB);
        PG8_WAIT_V(6); PG8_BAR;
    }
    for (;;) {
        const bool has_next = S.next(ui + 1, nxt);
        const char* nA = has_next ? (const char*)g.A + (size_t)nxt.pm * tstep + (size_t)g.koff(nxt.seg) * 2 : cA; const char* nB = has_next ? (const char*)g.Bt + (size_t)nxt.pn * tstep + (size_t)g.koff(nxt.seg) * 2 : cB;
        const int nt = g.ntiles(cur.seg);
        for (int t = 0; t < nt; t += 2) {
            const bool last = (t == nt - 2);
            const char* a1 = cA + (size_t)(t + 1) * kstep;
            const char* a2 = last ? nA : cA + (size_t)(t + 2) * kstep; const char* b2 = last ? nB : cB + (size_t)(t + 2) * kstep;
            const char* a3 = a2 + kstep; const char* b3 = b2 + kstep;
            if (last && has_next) S.a_ready(nxt);
            if constexpr (SP2) {
            PG8_LDB(B0, 0, 0); PG8_LDB(B1, 0, 1); PG8_SCHED; PG8_LDA(At, 0, 0); PG8_STAGE(PG8_SA(1, 1), a1 + hstep, voffA);
            PG8_WAIT_V8R(rx); PG8_WAIT_L(0); PG8_BAR; PG8_MMA(0, 0, At, B0); PG8_MMA(0, 1, At, B1); PG8_BAR; PG8_SCHED;
            PG8_LDA(At, 0, 1); PG8_STAGE(PG8_SB(0, 0), b2, voffB); PG8_STAGE(PG8_SB(0, 1), b2 + hstep, voffB); PG8_STAGE(PG8_SA(0, 0), a2, voffA);
            PG8_WAIT_V8R(rx); asm volatile("s_mov_b32 %0, 0" : "=s"(rx)); PG8_WAIT_L(0); PG8_BAR; PG8_MMA(1, 0, At, B0); PG8_MMA(1, 1, At, B1); PG8_BAR; PG8_SCHED;
            PG8_LDB(B0, 1, 0); PG8_LDB(B1, 1, 1); PG8_SCHED; PG8_LDA(At, 1, 0); PG8_STAGE(PG8_SA(0, 1), a2 + hstep, voffA);
            PG8_WAIT_V(8); PG8_WAIT_L(0); PG8_BAR; PG8_MMA(0, 0, At, B0); PG8_MMA(0, 1, At, B1); PG8_BAR; PG8_SCHED;
            PG8_LDA(At, 1, 1); PG8_STAGE(PG8_SB(1, 0), b3, voffB); PG8_STAGE(PG8_SB(1, 1), b3 + hstep, voffB); PG8_STAGE(PG8_SA(1, 0), a3, voffA);
            PG8_WAIT_V(8); PG8_WAIT_L(0); PG8_BAR; PG8_MMA(1, 0, At, B0); PG8_MMA(1, 1, At, B1); PG8_BAR; PG8_SCHED;
            } else {
            PG8_LDB(B0, 0, 0); PG8_SCHED; PG8_LDA(At, 0, 0); PG8_STAGE(PG8_SA(1, 1), a1 + hstep, voffA);
            PG8_WAIT_L(8); PG8_BAR; PG8_WAIT_L(0); PG8_MMA(0, 0, At, B0); PG8_BAR; PG8_SCHED;
            PG8_LDB(B1, 0, 1); PG8_STAGE(PG8_SB(0, 0), b2, voffB);
            PG8_BAR; PG8_WAIT_L(0); PG8_MMA(0, 1, At, B1); PG8_BAR;
            PG8_LDA(At, 0, 1); PG8_STAGE(PG8_SA(0, 0), a2, voffA);
            PG8_BAR; PG8_WAIT_L(0); PG8_MMA(1, 0, At, B0); PG8_BAR; PG8_SCHED;
            PG8_STAGE(PG8_SB(0, 1), b2 + hstep, voffB);
            PG8_WAIT_V(6); PG8_BAR; PG8_MMA(1, 1, At, B1); PG8_BAR;
            PG8_LDB(B0, 1, 0); PG8_SCHED; PG8_LDA(At, 1, 0); PG8_STAGE(PG8_SA(0, 1), a2 + hstep, voffA);
            PG8_WAIT_L(8); PG8_BAR; PG8_WAIT_L(0); PG8_MMA(0, 0, At, B0); PG8_BAR; PG8_SCHED;
            PG8_LDB(B1, 1, 1); PG8_STAGE(PG8_SB(1, 0), b3, voffB);
            PG8_BAR; PG8_WAIT_L(0); PG8_MMA(0, 1, At, B1); PG8_BAR;
            PG8_LDA(At, 1, 1); PG8_STAGE(PG8_SA(1, 0), a3, voffA);
            PG8_BAR; PG8_WAIT_L(0); PG8_MMA(1, 0, At, B0); PG8_BAR; PG8_SCHED;
            PG8_STAGE(PG8_SB(1, 1), b3 + hstep, voffB);
            PG8_WAIT_V(6); PG8_BAR; PG8_MMA(1, 1, At, B1); PG8_BAR;
            }
        }
        if constexpr (ALIGN_EPI) { if (wr == 0) PG8_BAR; }
        if constexpr (!Epi::AFTER_DRAIN) E(acc, cur, wr, wc, fr, fq);
        S.done(cur); rx = Epi::stores16(cur);
        if (!has_next) break;
        if (!Epi::CARRY || cur.seg == Epi::LAST_SEG) {
#pragma unroll
        for (int a = 0; a < 2; ++a)
#pragma unroll
            for (int b = 0; b < 2; ++b)
#pragma unroll
                for (int m = 0; m < 4; ++m)
#pragma unroll
                    for (int n = 0; n < 2; ++n) acc[a][b][m][n] = (f32x4){0.f, 0.f, 0.f, 0.f};
        }
        cur = nxt; cA = nA; cB = nB; ++ui;
        if constexpr (ALIGN_EPI) { if (wr == 1) PG8_BAR; }
    }
    PG8_WAIT_V(0);
    if constexpr (!ALIGN_EPI) { if (wr == 0) PG8_BAR; }
    PG8_BAR;
    if constexpr (Epi::AFTER_DRAIN) E.fused(acc, cur, wr, wc, fr, fq, lds);
#undef PG8_SA
#undef PG8_SB
#undef PG8_STAGE
#undef PG8_LDA
#undef PG8_LDB
#undef PG8_MMA
#undef PG8_WAIT_V
#undef PG8_WAIT_V8R
#undef PG8_WAIT_L
#undef PG8_BAR
#undef PG8_SCHED
}
}

__device__ __forceinline__ float fsoftplus(float v) {
    const float e = __expf(fminf(v, 20.f)), u = 1.0f + e, l = (u == 1.0f) ? e : __logf(u) * (e * __builtin_amdgcn_rcpf(u - 1.0f));
    return v > 20.f ? v : l;
}
struct Epi1 {
    static constexpr bool PERM = true, CARRY = false, AFTER_DRAIN = false; static constexpr int LAST_SEG = 0;
    bf16_t *ZS, *XBC, *U, *GB, *SGA, *SGR; float* DT; const float* dt_bias; float* out;
    static __device__ __forceinline__ int stores16(const pg8::Unit& u) { return u.pn < 88 ? 1 : 0; }
    __device__ __forceinline__ void operator()(f32x4 (&acc)[2][2][4][2], const pg8::Unit& u, int wr, int wc, int fr, int fq) const {
        const int pn = u.pn; const int rbase = u.pm * 256 + wr * 64 + fr;
        const bool has_o = u.pm < 32 ? (u.pm & 7) == 7 : u.pm < 36;
        if (pn < 16) {
#pragma unroll
            for (int ai = 0; ai < 2; ++ai)
#pragma unroll
                for (int m = 0; m < 4; ++m) { const int row = rbase + ai * 128 + m * 16; bf16_t* rowp = ZS + (size_t)row * DI + pn * 256 + wc * 32 + 8 * fq;
#pragma unroll
                    for (int bj = 0; bj < 2; ++bj) { const f32x4 v0 = acc[ai][bj][m][0], v1 = acc[ai][bj][m][1]; u32x4 w;
                        unsigned q0, q1, q2, q3; silu4_pk_bf16(v0, q0, q1); silu4_pk_bf16(v1, q2, q3); w = (u32x4){q0, q1, q2, q3};
                        *(u32x4*)(rowp + bj * 128) = w; } }
        } else if (pn < 40) {
#pragma unroll
            for (int ai = 0; ai < 2; ++ai)
#pragma unroll
                for (int m = 0; m < 4; ++m) { const int row = rbase + ai * 128 + m * 16; const int col = (pn - 16) * 256 + wc * 32 + 8 * fq; bf16_t* rowp = XBC + (size_t)row * CONVD + col;
                    int oidx = -1;
                    if (!has_o) {} else if (row < ROW_S0) { const int t = row & 2047; if (t >= 2045) oidx = (int)O_NCP + ((row >> 11) * 3 + (t - 2045)) * CONVD; }
                    else if (row < ROW_M0) { const int t = row & 7; if (t >= 5) oidx = (int)O_NCS + (((row - ROW_S0) >> 3) * 3 + (t - 5)) * CONVD; }
#pragma unroll
                    for (int bj = 0; bj < 2; ++bj) { const f32x4 v0 = acc[ai][bj][m][0], v1 = acc[ai][bj][m][1]; u32x4 w;
                        w.x = cvt_pk_bf16(v0[0], v0[1]); w.y = cvt_pk_bf16(v0[2], v0[3]); w.z = cvt_pk_bf16(v1[0], v1[1]); w.w = cvt_pk_bf16(v1[2], v1[3]);
                        *(u32x4*)(rowp + bj * 128) = w;
                        if (oidx >= 0) { float* o = out + oidx + col + bj * 128; *(f32x4*)o = v0; *(f32x4*)(o + 4) = v1; } } }
        } else if (pn < 72) {
#pragma unroll
            for (int ai = 0; ai < 2; ++ai)
#pragma unroll
                for (int m = 0; m < 4; ++m) { const int row = rbase + ai * 128 + m * 16; const int j0 = (pn - 40) * 64 + wc * 16 + fq * 4;
                    const f32x4 sb = acc[ai][0][m][0], sc = acc[ai][0][m][1], sh = acc[ai][1][m][0], sz = acc[ai][1][m][1];
                    const f32x4 uu = sc * sh; const f32x4 gg = sb * silu4(sz);
                    u32x2 wu, wg; wu.x = cvt_pk_bf16(uu[0], uu[1]); wu.y = cvt_pk_bf16(uu[2], uu[3]); wg.x = cvt_pk_bf16(gg[0], gg[1]); wg.y = cvt_pk_bf16(gg[2], gg[3]);
                    *(u32x2*)(U + (size_t)row * SCW + j0) = wu; *(u32x2*)(GB + (size_t)row * SCW + j0) = wg;
                    int oidx = -1;
                    if (!has_o) {} else if (row < ROW_S0) { const int t = row & 2047; if (t >= 2046) oidx = (int)O_NSCP + ((row >> 11) * 2 + (t - 2046)) * SCW; }
                    else if (row < ROW_M0) { const int t = row & 7; if (t >= 6) oidx = (int)O_NSCS + (((row - ROW_S0) >> 3) * 2 + (t - 6)) * SCW; }
                    if (oidx >= 0) *(f32x4*)(out + oidx + j0) = uu; }
        } else if (pn < 88) {
#pragma unroll
            for (int ai = 0; ai < 2; ++ai)
#pragma unroll
                for (int m = 0; m < 4; ++m) { const int row = rbase + ai * 128 + m * 16; const int j0 = (pn - 72) * 128 + wc * 32 + 8 * fq; float sa[8], rt[8];
#pragma unroll
                    for (int n = 0; n < 2; ++n) gate4(acc[ai][0][m][n], acc[ai][1][m][n], sa + 4 * n, rt + 4 * n);
                    *(u32x4*)(SGA + (size_t)row * D + j0) = pack8(sa); *(u32x4*)(SGR + (size_t)row * D + j0) = pack8(rt); }
        } else {
            if (wc < 2) {
                const int c0 = wc * 32 + 8 * fq; const f32x4 bb0 = *(const f32x4*)(dt_bias + c0), bb1 = *(const f32x4*)(dt_bias + c0 + 4);
#pragma unroll
                for (int ai = 0; ai < 2; ++ai)
#pragma unroll
                    for (int m = 0; m < 4; ++m) { const int row = rbase + ai * 128 + m * 16; f32x4 v0 = acc[ai][0][m][0] + bb0, v1 = acc[ai][0][m][1] + bb1;
#pragma unroll
                        for (int e = 0; e < 4; ++e) { v0[e] = fsoftplus(v0[e]); v1[e] = fsoftplus(v1[e]); }
                        *(f32x4*)(DT + (size_t)row * 64 + c0) = v0; *(f32x4*)(DT + (size_t)row * 64 + c0 + 4) = v1; }
            }
        }
    }
};
constexpr int LDS_RST = 131072;
__device__ __forceinline__ void build_rs_table(LAS unsigned char* lds, const float* SSQ, int pm) {
    LAS float* T = (LAS float*)(lds + LDS_RST);
    const int tid = threadIdx.x, trow = tid >> 1, half = tid & 1; const float* sp = SSQ + (size_t)(pm * 256 + trow) * 64 + 32 * half; float rs[4];
#pragma unroll
    for (int g = 0; g < 4; ++g) { const f32x4 q0 = *(const f32x4*)(sp + 8 * g), q1 = *(const f32x4*)(sp + 8 * g + 4); const float sm = ((q0[0] + q0[1]) + (q0[2] + q0[3])) + ((q1[0] + q1[1]) + (q1[2] + q1[3])); rs[g] = 1.0f / sqrtf(sm * (1.0f / 512.0f) + EPS); }
    const float rprev = __shfl_xor(rs[3], 1);
    LAS float* tp = T + trow * 12 + 4 * half;
    if (half == 0) { tp[0] = 1.0f / rs[0]; tp[1] = rs[0] / rs[1]; tp[2] = rs[1] / rs[2]; tp[3] = rs[2] / rs[3]; }
    else { tp[0] = rprev / rs[0]; tp[1] = rs[0] / rs[1]; tp[2] = rs[1] / rs[2]; tp[3] = rs[2] / rs[3]; tp[4] = rs[3]; }
}
struct Epi2 {
    static constexpr bool PERM = true, CARRY = true, AFTER_DRAIN = false; static constexpr int LAST_SEG = 8;
    static __device__ __forceinline__ int stores16(const pg8::Unit&) { return 0; }
    const bf16_t* SGA; const bf16_t* SGR; bf16_t* MG; LAS unsigned char* lds;
    __device__ __forceinline__ void operator()(f32x4 (&acc)[2][2][4][2], const pg8::Unit& u, int wr, int wc, int fr, int fq) const {
        const int rbase = u.pm * 256 + wr * 64 + fr; LAS float* T = (LAS float*)(lds + LDS_RST);
        const bool gated = (u.seg == 0) || (u.seg == 8); const bf16_t* gp = u.seg == 0 ? SGR : SGA;
#pragma unroll
        for (int ai = 0; ai < 2; ++ai) { u32x4 g[4][2];
#pragma unroll
            for (int m = 0; m < 4; ++m)
#pragma unroll
                for (int bj = 0; bj < 2; ++bj) g[m][bj] = (u32x4){0x3f803f80u, 0x3f803f80u, 0x3f803f80u, 0x3f803f80u};
            if (gated) {
#pragma unroll
                for (int m = 0; m < 4; ++m)
#pragma unroll
                    for (int bj = 0; bj < 2; ++bj) g[m][bj] = *(const u32x4*)(gp + (size_t)(rbase + ai * 128 + m * 16) * D + u.pn * 256 + bj * 128 + wc * 32 + 8 * fq); }
#pragma unroll
            for (int m = 0; m < 4; ++m) { const float tf = T[(wr * 64 + fr + ai * 128 + m * 16) * 12 + u.seg];
#pragma unroll
                for (int bj = 0; bj < 2; ++bj) { float gf[8]; unpack8(g[m][bj], gf); f32x4& v0 = acc[ai][bj][m][0]; f32x4& v1 = acc[ai][bj][m][1];
                    v0 = (f32x4){v0[0] * gf[0] * tf, v0[1] * gf[1] * tf, v0[2] * gf[2] * tf, v0[3] * gf[3] * tf}; v1 = (f32x4){v1[0] * gf[4] * tf, v1[1] * gf[5] * tf, v1[2] * gf[6] * tf, v1[3] * gf[7] * tf};
                    if (u.seg == 8) { u32x4 w; w.x = cvt_pk_bf16(v0[0], v0[1]); w.y = cvt_pk_bf16(v0[2], v0[3]); w.z = cvt_pk_bf16(v1[0], v1[1]); w.w = cvt_pk_bf16(v1[2], v1[3]);
                        *(u32x4*)(MG + (size_t)(rbase + ai * 128 + m * 16) * D + u.pn * 256 + bj * 128 + wc * 32 + 8 * fq) = w; } } }
            asm volatile("" ::: "memory"); }
    }
};
struct EpiOutNorm {
    static constexpr bool PERM = false, CARRY = false, AFTER_DRAIN = true; static constexpr int LAST_SEG = 0;
    static __device__ __forceinline__ int stores16(const pg8::Unit&) { return 0; }
    const float* xp; const float* fnw; float* out; float* PS; unsigned* cnt;
    __device__ __forceinline__ void operator()(f32x4 (&)[2][2][4][2], const pg8::Unit&, int, int, int, int) const {}
    __device__ __forceinline__ void fused(f32x4 (&acc)[2][2][4][2], const pg8::Unit& u, int wr, int wc, int fr, int fq, LAS unsigned char* lds) const {
        const int tid = threadIdx.x, wid = tid >> 6; const int rbase = u.pm * 256 + wr * 64 + fr;
        LAS float* P = (LAS float*)lds;
        LAS float* Sc = P + 1024;
#pragma unroll
        for (int ai = 0; ai < 2; ++ai)
#pragma unroll
            for (int mp = 0; mp < 2; ++mp) { f32x4 xv[2][2][2];
#pragma unroll
                for (int mm = 0; mm < 2; ++mm) { const float* xr = xp + (size_t)(rbase + ai * 128 + (2 * mp + mm) * 16) * D;
#pragma unroll
                    for (int bj = 0; bj < 2; ++bj)
#pragma unroll
                        for (int n = 0; n < 2; ++n) xv[mm][bj][n] = *(const f32x4*)(xr + u.pn * 256 + bj * 128 + wc * 32 + n * 16 + 4 * fq); }
#pragma unroll
                for (int mm = 0; mm < 2; ++mm) { float sq = 0.f;
#pragma unroll
                    for (int bj = 0; bj < 2; ++bj)
#pragma unroll
                        for (int n = 0; n < 2; ++n) { f32x4& v = acc[ai][bj][2 * mp + mm][n]; v = v + xv[mm][bj][n]; sq += (v[0] * v[0] + v[1] * v[1]) + (v[2] * v[2] + v[3] * v[3]); }
                    sq += __shfl_xor(sq, 16); sq += __shfl_xor(sq, 32);
                    if (fq == 0) P[(wr * 64 + fr + ai * 128 + (2 * mp + mm) * 16) * 4 + wc] = sq; }
                asm volatile("" ::: "memory"); }
        LDS_BARRIER();
        if (tid < 256) { const f32x4 q = *(const LAS f32x4*)(P + tid * 4); __hip_atomic_store(PS + (size_t)(u.pm * 256 + tid) * 8 + u.pn, (q[0] + q[1]) + (q[2] + q[3]), __ATOMIC_RELAXED, __HIP_MEMORY_SCOPE_AGENT); }
        asm volatile("s_waitcnt vmcnt(0)" ::: "memory");
        if (tid < 256 && (tid & 63) == 0) __hip_atomic_fetch_add(cnt + 64 * u.pm, 1u, __ATOMIC_RELAXED, __HIP_MEMORY_SCOPE_AGENT);
        if (wid == 0) { unsigned spins = 0;
            while ((unsigned)__builtin_amdgcn_readfirstlane(__hip_atomic_load(cnt + 64 * u.pm, __ATOMIC_RELAXED, __HIP_MEMORY_SCOPE_AGENT)) < 32u) { __builtin_amdgcn_s_sleep(2); if (++spins > (1u << 22)) break; }
            __builtin_amdgcn_fence(__ATOMIC_ACQUIRE, "agent");
            asm volatile("s_waitcnt vmcnt(0)" ::: "memory"); }
        LDS_BARRIER();
        if (tid < 256) { const float* pp = PS + (size_t)(u.pm * 256 + tid) * 8; float sm = 0.f;
#pragma unroll
            for (int t = 0; t < 8; ++t) sm += __hip_atomic_load(pp + t, __ATOMIC_RELAXED, __HIP_MEMORY_SCOPE_AGENT);
            Sc[tid] = 1.0f / sqrtf(sm * (1.0f / D) + EPS); }
        LDS_BARRIER();
        f32x4 fw[2][2];
#pragma unroll
        for (int bj = 0; bj < 2; ++bj)
#pragma unroll
            for (int n = 0; n < 2; ++n) fw[bj][n] = *(const f32x4*)(fnw + u.pn * 256 + bj * 128 + wc * 32 + n * 16 + 4 * fq);
#pragma unroll
        for (int ai = 0; ai < 2; ++ai)
#pragma unroll
            for (int m = 0; m < 4; ++m) { const int rl = wr * 64 + fr + ai * 128 + m * 16; const float rs = Sc[rl];
#pragma unroll
                for (int bj = 0; bj < 2; ++bj)
#pragma unroll
                    for (int n = 0; n < 2; ++n) *(f32x4*)(out + (size_t)(u.pm * 256 + rl) * D + u.pn * 256 + bj * 128 + wc * 32 + n * 16 + 4 * fq) = acc[ai][bj][m][n] * rs * fw[bj][n]; }
    }
};

#define XB_TMO      128
#define XB_XCNT(j)  (256  + 64 * (j))
#define XB_XSUB(j)  (1280 + 64 * (j))
#define XB_XGEN(j)  (2304 + 64 * (j))
#define XB_TOP      3328
#define XB_TOPGEN   3392
#define XCD_BAR_WORDS 3456
#define XB_SPIN_CAP (1u << 21)
__device__ __forceinline__ unsigned xb_ld(unsigned* p)              { return __hip_atomic_load(p, __ATOMIC_RELAXED, __HIP_MEMORY_SCOPE_AGENT); }
__device__ __forceinline__ unsigned xb_add(unsigned* p, unsigned v) { return __hip_atomic_fetch_add(p, v, __ATOMIC_RELAXED, __HIP_MEMORY_SCOPE_AGENT); }
__device__ __forceinline__ unsigned xb_xcc_id() { return (unsigned)__builtin_amdgcn_s_getreg((3 << 11) | 20) & 0xFu; }
#define XB_SPIN(cond, bar) do { unsigned _sp = 0; while (cond) { __builtin_amdgcn_s_sleep(1); \
    if ((++_sp & 255u) == 0u) { if (xb_ld(&(bar)[XB_TMO])) break; if (_sp > XB_SPIN_CAP) { atomicAdd(&(bar)[XB_TMO], 1u); break; } } } } while (0)
struct XcdBarrier { unsigned* bar; unsigned x; volatile LAS unsigned* st; };
__device__ __forceinline__ XcdBarrier xcd_barrier_post(unsigned* bar, volatile LAS unsigned* st) {
    XcdBarrier b; b.bar = bar; b.x = xb_xcc_id(); b.st = st;
    if (threadIdx.x == 0) (void)xb_add(&bar[XB_XCNT(b.x)], 1u);
    return b;
}
__device__ __forceinline__ void xcd_barrier_complete(unsigned* bar, unsigned x, unsigned& nloc, unsigned& nx) {
    const unsigned G = gridDim.x * gridDim.y * gridDim.z;
    unsigned sum, cnt, mine, sp = 0u;
    for (;;) {
        sum = 0u; cnt = 0u; mine = 0u;
#pragma unroll
        for (unsigned j = 0; j < 16; ++j) { const unsigned c = xb_ld(&bar[XB_XCNT(j)]); sum += c; cnt += (c > 0u) ? 1u : 0u; mine = (j == x) ? c : mine; }
        if (sum == G) break;
        __builtin_amdgcn_s_sleep(1);
        if ((++sp & 255u) == 0u) { if (xb_ld(&bar[XB_TMO])) break; if (sp > XB_SPIN_CAP) { atomicAdd(&bar[XB_TMO], 1u); break; } }
    }
    nloc = mine > 0u ? mine : 1u; nx = cnt > 0u ? cnt : 1u;
}
__device__ __forceinline__ void xcd_barrier(const XcdBarrier& b) {
    asm volatile("s_waitcnt vmcnt(0)" ::: "memory");
    __syncthreads();
    if (threadIdx.x == 0) {
        unsigned* bar = b.bar;
        __builtin_amdgcn_s_waitcnt(0);
        unsigned nloc = b.st[0], nx = b.st[1];
        if (nloc == 0u) { xcd_barrier_complete(bar, b.x, nloc, nx); b.st[0] = nloc; b.st[1] = nx; }
        const unsigned old = xb_add(&bar[XB_XSUB(b.x)], 1u);
        const unsigned gen = old / nloc;
        if (old + 1u == (gen + 1u) * nloc) {
            __builtin_amdgcn_fence(__ATOMIC_RELEASE, "agent");
            asm volatile("s_waitcnt vmcnt(0)" ::: "memory");
            const unsigned og = xb_add(&bar[XB_TOP], 1u);
            const unsigned tg = og / nx;
            if (og + 1u == (tg + 1u) * nx) xb_add(&bar[XB_TOPGEN], 1u);
            else XB_SPIN(xb_ld(&bar[XB_TOPGEN]) == tg, bar);
            __builtin_amdgcn_fence(__ATOMIC_ACQUIRE, "agent");
            xb_add(&bar[XB_XGEN(b.x)], 1u);
            asm volatile("s_waitcnt vmcnt(0)" ::: "memory");
        } else {
            XB_SPIN(xb_ld(&bar[XB_XGEN(b.x)]) == gen, bar);
            __builtin_amdgcn_fence(__ATOMIC_ACQUIRE, "agent");
            asm volatile("s_waitcnt vmcnt(0)" ::: "memory");
        }
    }
    __syncthreads();
}

struct Args { const float* in[19]; float* out; unsigned char* ws; int ph_lo, ph_hi; };
enum { I_XP = 0, I_XS, I_SCONV4, I_SSM, I_SSCONV, I_META, I_NORMW, I_WIN, I_CW, I_CB, I_DTB, I_ALOG, I_DSKIP, I_SNW, I_WSSD, I_SCW, I_WSC, I_WO, I_FNW };

__device__ __forceinline__ int wt1_src_col(int np) {
    const int pn = np >> 8, c = np & 255;
    if (pn < 40) return np;
    if (pn < 72) { const int q = 2 * (c >> 7) + ((c >> 2) & 1), jl = 16 * ((c >> 5) & 3) + 4 * ((c >> 3) & 3) + (c & 3); return C_SC + 2048 * q + 64 * (pn - 40) + jl; }
    if (pn < 88) return C_G + 2048 * (c >> 7) + 128 * (pn - 72) + (c & 127);
    return c < 64 ? C_DT + c : -1;
}
struct TItem { const float* src; const float* ksc; bf16_t* dst; int ldw, pitch; bool valid; };
__device__ __forceinline__ TItem prep_decode(const Args& a, int it, int lane) {
    constexpr int I1 = 32 * (NP1 / 64), I2A = 64 * 32, I2B = 32 * 32, I3 = 32 * 32;
    TItem t; t.valid = it < I1 + I2A + I2B + I3; t.src = nullptr; t.ksc = nullptr; t.dst = nullptr; t.ldw = 0; t.pitch = 0;
    if (!t.valid) return t;
    const int l4 = 4 * (lane & 15), kr = lane >> 4, c8 = 8 * (lane & 7); int r = it;
    if (r < I1) { const int kb = r / (NP1 / 64), nb = r % (NP1 / 64); const int sc = wt1_src_col(nb * 64 + l4); t.ldw = PROJ; t.pitch = D;
        t.src = sc >= 0 ? a.in[I_WIN] + (size_t)(kb * 64 + kr) * PROJ + sc : nullptr; t.dst = (bf16_t*)(a.ws + W_WT1) + (size_t)(nb * 64) * D + kb * 64; return t; } r -= I1;
    if (r < I2A) { const int kb = r / 32, nb = r % 32; t.ldw = D; t.pitch = K2; t.src = a.in[I_WSSD] + (size_t)(kb * 64 + kr) * D + nb * 64 + l4; t.ksc = a.in[I_SNW] + kb * 64 + c8;
        t.dst = (bf16_t*)(a.ws + W_WT2) + (size_t)(nb * 64) * K2 + kb * 64; return t; } r -= I2A;
    if (r < I2B) { const int kb = r / 32, nb = r % 32; t.ldw = D; t.pitch = K2; t.src = a.in[I_WSC] + (size_t)(kb * 64 + kr) * D + nb * 64 + l4; t.dst = (bf16_t*)(a.ws + W_WT2) + (size_t)(nb * 64) * K2 + DI + kb * 64; return t; } r -= I2B;
    { const int kb = r / 32, nb = r % 32; t.ldw = D; t.pitch = D; t.src = a.in[I_WO] + (size_t)(kb * 64 + kr) * D + nb * 64 + l4; t.dst = (bf16_t*)(a.ws + W_WT3) + (size_t)(nb * 64) * D + kb * 64; }
    return t;
}
__device__ __forceinline__ void transpose_range(const Args& a, LAS unsigned char* lds, int first, int stride, int end) {
    const int tid = threadIdx.x, lane = tid & 63, wave = __builtin_amdgcn_readfirstlane(tid >> 6);
    LAS unsigned char* scr = lds + wave * 16384;
    const int kr = lane >> 4, n4 = lane & 15, c = lane & 7, nn = lane >> 3;
    f32x4 buf[16];
    TItem cur = prep_decode(a, first < end ? first : 1 << 30, lane);
    if (cur.valid) {
#pragma unroll
        for (int i = 0; i < 16; ++i) buf[i] = cur.src ? *(const f32x4*)(cur.src + (size_t)(4 * i) * cur.ldw) : (f32x4){0.f, 0.f, 0.f, 0.f}; }
    for (int it = first; cur.valid; it += stride) {
        const TItem nxt = prep_decode(a, it + stride < end ? it + stride : 1 << 30, lane);
#pragma unroll
        for (int i = 0; i < 16; ++i) { const int k = 4 * i + kr; *(LAS f32x4*)(scr + k * 256 + ((n4 ^ (k >> 3)) << 4)) = buf[i]; }
        if (nxt.valid) {
#pragma unroll
            for (int i = 0; i < 16; ++i) buf[i] = nxt.src ? *(const f32x4*)(nxt.src + (size_t)(4 * i) * nxt.ldw) : (f32x4){0.f, 0.f, 0.f, 0.f}; }
        f32x4 k0v = (f32x4){1.f, 1.f, 1.f, 1.f}, k1v = k0v; if (cur.ksc) { k0v = *(const f32x4*)cur.ksc; k1v = *(const f32x4*)(cur.ksc + 4); }
        LDS_WAIT();
#pragma unroll
        for (int j = 0; j < 8; ++j) { const int n = nn + 8 * j; const LAS unsigned char* sp = scr + (8 * c) * 256 + (((n >> 2) ^ c) << 4) + ((n & 3) << 2); float f[8];
#pragma unroll
            for (int e = 0; e < 8; ++e) f[e] = *(const LAS float*)(sp + e * 256) * (e < 4 ? k0v[e & 3] : k1v[e & 3]);
            *(u32x4*)(cur.dst + (size_t)n * cur.pitch + 8 * c) = pack8(f); }
        LDS_WAIT();
        cur = nxt;
    }
}
constexpr int PREP_I1 = 32 * (NP1 / 64), PREP_I23 = 64 * 32 + 32 * 32 + 32 * 32;
__device__ __forceinline__ void phase_prep(const Args& a, LAS unsigned char* lds, int G) {
    const int tid = threadIdx.x, lane = tid & 63, wave = __builtin_amdgcn_readfirstlane(tid >> 6);
    const int gw = blockIdx.x * 8 + wave, NGW = G * 8;
    transpose_range(a, lds, gw, NGW, PREP_I1);
    bf16_t* H = (bf16_t*)(a.ws + W_H); const float* nw = a.in[I_NORMW];
    auto rowsrc = [&](int r) -> const float* { return r < ROW_S0 ? a.in[I_XP] + (size_t)r * D : (r < ROW_M0 ? a.in[I_XS] + (size_t)(r - ROW_S0) * D : (r < M_REAL ? a.in[I_META] + (size_t)(r - ROW_M0) * D : nullptr)); };
    f32x4 pv[8];
    { const float* src = gw < MP ? rowsrc(gw) : nullptr;
#pragma unroll
        for (int j = 0; j < 8; ++j) pv[j] = src ? ((const f32x4*)src)[lane + 64 * j] : (f32x4){0.f, 0.f, 0.f, 0.f}; }
    for (int r = gw; r < MP; r += NGW) {
        f32x4 v[8]; float s = 0.f;
#pragma unroll
        for (int j = 0; j < 8; ++j) { v[j] = pv[j]; s += (v[j][0] * v[j][0] + v[j][1] * v[j][1]) + (v[j][2] * v[j][2] + v[j][3] * v[j][3]); }
        { const float* src = r + NGW < MP ? rowsrc(r + NGW) : nullptr;
#pragma unroll
            for (int j = 0; j < 8; ++j) pv[j] = src ? ((const f32x4*)src)[lane + 64 * j] : (f32x4){0.f, 0.f, 0.f, 0.f}; }
        const float rs = 1.0f / sqrtf(wave_sum(s) * (1.0f / D) + EPS);
#pragma unroll
        for (int j = 0; j < 8; ++j) { const f32x4 w = ((const f32x4*)nw)[lane + 64 * j]; u32x2 o; o.x = cvt_pk_bf16(v[j][0] * rs * w[0], v[j][1] * rs * w[1]); o.y = cvt_pk_bf16(v[j][2] * rs * w[2], v[j][3] * rs * w[3]);
            ((u32x2*)(H + (size_t)r * D))[lane + 64 * j] = o; }
    }
}

__device__ __forceinline__ void phase_conv(const Args& a, int G) {
    const int tid = threadIdx.x;
    const bf16_t* XBC = (const bf16_t*)(a.ws + W_XBC); const bf16_t* U = (const bf16_t*)(a.ws + W_U); const bf16_t* GBp = (const bf16_t*)(a.ws + W_GB);
    bf16_t* XC = (bf16_t*)(a.ws + W_XC); bf16_t* A2 = (bf16_t*)(a.ws + W_A2);
    constexpr int NBLK = 512 + 64 + 1;
    for (int item = blockIdx.x; item < 512 + 2 * (NBLK - 512); item += G) {
        const int hf = item < 512 ? 1 : ((item - 512) & 1), blk = item < 512 ? item : 512 + ((item - 512) >> 1); const int cg = hf * 512 + tid; const bool isx = cg < 768;
        int r0, nseg, segrows, mode;
        if (blk < 512) { r0 = blk * 16; nseg = 1; segrows = 16; mode = (blk & 127) == 0 ? 1 : 0; }
        else if (blk < 576) { r0 = ROW_S0 + (blk - 512) * 16; nseg = 2; segrows = 8; mode = 2; }
        else { r0 = ROW_M0; nseg = 1; segrows = 16; mode = 3; }
        if (isx) {
            const int c0 = cg * 8; float w[4][8], bias[8];
#pragma unroll
            for (int k = 0; k < 4; ++k) { const f32x4 pv = *(const f32x4*)(a.in[I_CW] + k * CONVD + c0), qv = *(const f32x4*)(a.in[I_CW] + k * CONVD + c0 + 4);
                w[k][0] = pv[0]; w[k][1] = pv[1]; w[k][2] = pv[2]; w[k][3] = pv[3]; w[k][4] = qv[0]; w[k][5] = qv[1]; w[k][6] = qv[2]; w[k][7] = qv[3]; }
            { const f32x4 pv = *(const f32x4*)(a.in[I_CB] + c0), qv = *(const f32x4*)(a.in[I_CB] + c0 + 4); bias[0] = pv[0]; bias[1] = pv[1]; bias[2] = pv[2]; bias[3] = pv[3]; bias[4] = qv[0]; bias[5] = qv[1]; bias[6] = qv[2]; bias[7] = qv[3]; }
            for (int sg = 0; sg < nseg; ++sg) {
                const int rs = r0 + sg * segrows; float x3[8], x2[8], x1[8];
                if (mode == 0 || mode == 1) { const int pr = mode == 0 ? rs - 3 : M_REAL - 3;
                    unpack8(*(const u32x4*)(XBC + (size_t)pr * CONVD + c0), x3); unpack8(*(const u32x4*)(XBC + (size_t)(pr + 1) * CONVD + c0), x2); unpack8(*(const u32x4*)(XBC + (size_t)(pr + 2) * CONVD + c0), x1); }
                else if (mode == 2) { const float* st = a.in[I_SCONV4] + (size_t)((rs - ROW_S0) >> 3) * 3 * CONVD + c0;
#pragma unroll
                    for (int e = 0; e < 8; ++e) { x3[e] = st[e]; x2[e] = st[CONVD + e]; x1[e] = st[2 * CONVD + e]; } }
                else {
#pragma unroll
                    for (int e = 0; e < 8; ++e) { x3[e] = 0.f; x2[e] = 0.f; x1[e] = 0.f; } }
                for (int i0 = 0; i0 < segrows; i0 += 8) { u32x4 ld[8];
#pragma unroll
                    for (int j = 0; j < 8; ++j) ld[j] = *(const u32x4*)(XBC + (size_t)(rs + i0 + j) * CONVD + c0);
#pragma unroll
                    for (int j = 0; j < 8; ++j) { float cur[8], o[8]; unpack8(ld[j], cur);
#pragma unroll
                        for (int e = 0; e < 8; ++e) { const float v = bias[e] + w[0][e] * x3[e] + w[1][e] * x2[e] + w[2][e] * x1[e] + w[3][e] * cur[e]; o[e] = fsilu(v); x3[e] = x2[e]; x2[e] = x1[e]; x1[e] = cur[e]; }
                        *(u32x4*)(XC + (size_t)(rs + i0 + j) * CONVD + c0) = pack8(o); } }
            }
        } else {
            const int j0 = (cg - 768) * 8; float w[3][8];
#pragma unroll
            for (int k = 0; k < 3; ++k) { const f32x4 pv = *(const f32x4*)(a.in[I_SCW] + k * SCW + j0), qv = *(const f32x4*)(a.in[I_SCW] + k * SCW + j0 + 4);
                w[k][0] = pv[0]; w[k][1] = pv[1]; w[k][2] = pv[2]; w[k][3] = pv[3]; w[k][4] = qv[0]; w[k][5] = qv[1]; w[k][6] = qv[2]; w[k][7] = qv[3]; }
            for (int sg = 0; sg < nseg; ++sg) {
                const int rs = r0 + sg * segrows; float u2[8], u1[8];
                if (mode == 0 || mode == 1) { const int pr = mode == 0 ? rs - 2 : M_REAL - 2;
                    unpack8(*(const u32x4*)(U + (size_t)pr * SCW + j0), u2); unpack8(*(const u32x4*)(U + (size_t)(pr + 1) * SCW + j0), u1); }
                else if (mode == 2) { const float* st = a.in[I_SSCONV] + (size_t)((rs - ROW_S0) >> 3) * 2 * SCW + j0;
#pragma unroll
                    for (int e = 0; e < 8; ++e) { u2[e] = st[e]; u1[e] = st[SCW + e]; } }
                else {
#pragma unroll
                    for (int e = 0; e < 8; ++e) { u2[e] = 0.f; u1[e] = 0.f; } }
                for (int i0 = 0; i0 < segrows; i0 += 8) { u32x4 ld[8], lg[8];
#pragma unroll
                    for (int j = 0; j < 8; ++j) { ld[j] = *(const u32x4*)(U + (size_t)(rs + i0 + j) * SCW + j0); lg[j] = *(const u32x4*)(GBp + (size_t)(rs + i0 + j) * SCW + j0); }
#pragma unroll
                    for (int j = 0; j < 8; ++j) { float cur[8], gt[8], o[8]; unpack8(ld[j], cur); unpack8(lg[j], gt);
#pragma unroll
                        for (int e = 0; e < 8; ++e) { const float v = w[0][e] * u2[e] + w[1][e] * u1[e] + w[2][e] * cur[e]; o[e] = gt[e] * v; u2[e] = u1[e]; u1[e] = cur[e]; }
                        *(u32x4*)(A2 + (size_t)(rs + i0 + j) * K2 + DI + j0) = pack8(o); } }
            }
        }
    }
}

constexpr int SL_C = 0, SL_B = 32768, SL_W = 65536, SL_XD = 98304, SL_XE = 114688, SL_H = 131072, SL_SM = 147456;
typedef short s16x4 __attribute__((ext_vector_type(4)));
__device__ __forceinline__ int img_off(int row, int col) { return row * 256 + ((((col >> 3) ^ row) & 15) << 4) + ((col & 7) << 1); }
__device__ __forceinline__ int img_off128(int row, int col) { return row * 128 + ((((col >> 3) ^ row) & 7) << 4) + ((col & 7) << 1); }
__device__ __forceinline__ bf16x8 ldfrag(const LAS unsigned char* img, int r0, int ks, int fr, int fq) { return *(const LAS bf16x8*)(img + (r0 + fr) * 256 + ((((4 * ks + fq) ^ fr) & 15) << 4)); }
__device__ __forceinline__ bf16x8 trfrag256(const LAS unsigned char* img, int c0, int ks, int lane) {
    const int i16 = lane & 15, fq = lane >> 4, q = i16 >> 2, p = i16 & 3, krow = 32 * ks + 8 * fq + q, col = c0 + 4 * p;
    const s16x4 lo = __builtin_amdgcn_ds_read_tr16_b64_v4i16((LAS s16x4*)(img + img_off(krow, col))), hi = __builtin_amdgcn_ds_read_tr16_b64_v4i16((LAS s16x4*)(img + img_off(krow + 4, col)));
    return __builtin_shufflevector(lo, hi, 0, 1, 2, 3, 4, 5, 6, 7);
}
__device__ __forceinline__ bf16x8 trfrag128(const LAS unsigned char* img, int c0, int ks, int lane) {
    const int i16 = lane & 15, fq = lane >> 4, q = i16 >> 2, p = i16 & 3, krow = 32 * ks + 8 * fq + q, col = c0 + 4 * p;
    const s16x4 lo = __builtin_amdgcn_ds_read_tr16_b64_v4i16((LAS s16x4*)(img + img_off128(krow, col))), hi = __builtin_amdgcn_ds_read_tr16_b64_v4i16((LAS s16x4*)(img + img_off128(krow + 4, col)));
    return __builtin_shufflevector(lo, hi, 0, 1, 2, 3, 4, 5, 6, 7);
}
#define MFMA16(a, b, c) __builtin_amdgcn_mfma_f32_16x16x32_bf16((a), (b), (c), 0, 0, 0)
__device__ __forceinline__ void ssd_prompt_item(const Args& a, LAS unsigned char* lds, int b, int head) {
    const int tid = threadIdx.x, lane = tid & 63, w = __builtin_amdgcn_readfirstlane(tid >> 6), g = head >> 3;
    const bf16_t* XC = (const bf16_t*)(a.ws + W_XC); const float* DT = (const float*)(a.ws + W_DT); const bf16_t* ZS = (const bf16_t*)(a.ws + W_ZS);
    bf16_t* YG = (bf16_t*)(a.ws + W_A2); float* SSQ = (float*)(a.ws + W_SSQ);
    LAS unsigned char* Ci = lds + SL_C; LAS unsigned char* Bi = lds + SL_B; LAS unsigned char* Wi = lds + SL_W; LAS unsigned char* XDi = lds + SL_XD; LAS unsigned char* XEi = lds + SL_XE; LAS unsigned char* Hi = lds + SL_H;
    LAS float* acum_s = (LAS float*)(lds + SL_SM); LAS float* dt_s = acum_s + 128; LAS float* ea_s = acum_s + 256; LAS float* ee_s = acum_s + 384;
    const float Ah = -expf(a.in[I_ALOG][head]); const float Dh = a.in[I_DSKIP][head];
    f32x4 st[4];
#pragma unroll
    for (int pt = 0; pt < 4; ++pt) st[pt] = (f32x4){0.f, 0.f, 0.f, 0.f};
    u32x4 pc[4], pb[4], pr[2][4]; float pdt0 = 0.f, pdt1 = 0.f;
    const bf16_t* XBCr = (const bf16_t*)(a.ws + W_XBC);
    float cw[4][8], cbias[8];
    { const int c0 = head * 64 + 8 * (tid & 7);
#pragma unroll
      for (int k = 0; k < 4; ++k) { const f32x4 pv = *(const f32x4*)(a.in[I_CW] + k * CONVD + c0), qv = *(const f32x4*)(a.in[I_CW] + k * CONVD + c0 + 4);
          cw[k][0] = pv[0]; cw[k][1] = pv[1]; cw[k][2] = pv[2]; cw[k][3] = pv[3]; cw[k][4] = qv[0]; cw[k][5] = qv[1]; cw[k][6] = qv[2]; cw[k][7] = qv[3]; }
      const f32x4 pv = *(const f32x4*)(a.in[I_CB] + c0), qv = *(const f32x4*)(a.in[I_CB] + c0 + 4);
      cbias[0] = pv[0]; cbias[1] = pv[1]; cbias[2] = pv[2]; cbias[3] = pv[3]; cbias[4] = qv[0]; cbias[5] = qv[1]; cbias[6] = qv[2]; cbias[7] = qv[3]; }
    auto rowg = [&](int c, int i) -> int { return c == 0 ? ROW_M0 + i : b * 2048 + (c - 1) * 128 + i; };
    auto prefetch = [&](int c, int t) {
        const int valid = c == 0 ? META : 128;
#pragma unroll
        for (int k = 0; k < 4; ++k) { const int q = t + 512 * k, row = q >> 4, ch = q & 15;
            if (row < valid) { const bf16_t* base = XC + (size_t)rowg(c, row) * CONVD + g * 128 + ch * 8; pb[k] = *(const u32x4*)(base + DI); pc[k] = *(const u32x4*)(base + DI + 1024); }
            else { pb[k] = (u32x4){0u, 0u, 0u, 0u}; pc[k] = (u32x4){0u, 0u, 0u, 0u}; } }
#pragma unroll
        for (int k = 0; k < 2; ++k) { const int q = t + 512 * k, row = q >> 3, ch = q & 7;
            if (c == 0) { pr[k][0] = row < valid ? *(const u32x4*)(XC + (size_t)rowg(0, row) * CONVD + head * 64 + ch * 8) : (u32x4){0u, 0u, 0u, 0u}; }
            else {
#pragma unroll
                for (int d = 0; d < 4; ++d) { const int t = (c - 1) * 128 + row - d;
                    pr[k][d] = *(const u32x4*)(XBCr + (size_t)(t >= 0 ? b * 2048 + t : ROW_M0 + 16 + t) * CONVD + head * 64 + ch * 8); } } }
        if (w == 0) { const int r0 = 2 * (t & 63); pdt0 = r0 < valid ? DT[(size_t)rowg(c, r0) * 64 + head] : 0.f; pdt1 = r0 + 1 < valid ? DT[(size_t)rowg(c, r0 + 1) * 64 + head] : 0.f; }
    };
    prefetch(0, tid);
    for (int c = 0; c < 17; ++c) {
        int tq = tid; asm volatile("" : "+v"(tq));
        const int lq = tq & 63, fr = lq & 15, fq = lq >> 4;
        LDS_BARRIER();
        if (w == 0) {
            const float l0 = pdt0 * Ah, l1 = pdt1 * Ah; float sc = l0 + l1;
#pragma unroll
            for (int o = 1; o < 64; o <<= 1) { const float t = __shfl_up(sc, o); if (lane >= o) sc += t; }
            const float a1 = sc, a0 = sc - l1, alast = __shfl(sc, 63);
            acum_s[2 * lane] = a0; acum_s[2 * lane + 1] = a1; dt_s[2 * lane] = pdt0; dt_s[2 * lane + 1] = pdt1;
            ea_s[2 * lane] = __expf(a0); ea_s[2 * lane + 1] = __expf(a1); ee_s[2 * lane] = __expf(alast - a0); ee_s[2 * lane + 1] = __expf(alast - a1);
        }
#pragma unroll
        for (int k = 0; k < 4; ++k) { const int q = tq + 512 * k, row = q >> 4, ch = q & 15; const int o = row * 256 + (((ch ^ row) & 15) << 4);
            *(LAS u32x4*)(Ci + o) = pc[k]; *(LAS u32x4*)(Bi + o) = pb[k]; }
#pragma unroll
        for (int pt = 0; pt < 4; ++pt) { u32x2 hv; hv.x = cvt_pk_bf16(st[pt][0], st[pt][1]); hv.y = cvt_pk_bf16(st[pt][2], st[pt][3]); *(LAS u32x2*)(Hi + img_off(16 * pt + fr, 16 * w + 4 * fq)) = hv; }
        LDS_BARRIER();
#pragma unroll
        for (int k = 0; k < 2; ++k) { const int q = tq + 512 * k, row = q >> 3, ch = q & 7; float f[8], fd[8], fe[8]; const float dtj = dt_s[row], ej = ee_s[row] * dtj;
            if (c == 0) unpack8(pr[k][0], f);
            else { float x0[8], x1[8], x2[8], x3[8]; unpack8(pr[k][0], x0); unpack8(pr[k][1], x1); unpack8(pr[k][2], x2); unpack8(pr[k][3], x3);
#pragma unroll
                for (int e = 0; e < 8; ++e) f[e] = fsilu(cbias[e] + cw[0][e] * x3[e] + cw[1][e] * x2[e] + cw[2][e] * x1[e] + cw[3][e] * x0[e]); }
#pragma unroll
            for (int e = 0; e < 8; ++e) { fd[e] = f[e] * dtj; fe[e] = f[e] * ej; }
            const int o = row * 128 + (((ch ^ row) & 7) << 4);
            *(LAS u32x4*)(XDi + o) = pack8(fd); *(LAS u32x4*)(XEi + o) = pack8(fe); }
        LDS_BARRIER();
        if (c + 1 < 17) prefetch(c + 1, tq);
        const float dA = ea_s[127];
#pragma unroll
        for (int pt = 0; pt < 4; ++pt) st[pt] = st[pt] * dA;
#pragma unroll
        for (int kh = 0; kh < 2; ++kh) { bf16x8 bt[2], xe[2][4];
#pragma unroll
            for (int k2 = 0; k2 < 2; ++k2) { bt[k2] = trfrag256(Bi, 16 * w, 2 * kh + k2, lq);
#pragma unroll
                for (int pt = 0; pt < 4; ++pt) xe[k2][pt] = trfrag128(XEi, 16 * pt, 2 * kh + k2, lq); }
            __builtin_amdgcn_sched_barrier(0); LDS_WAIT(); __builtin_amdgcn_sched_barrier(0);
#pragma unroll
            for (int k2 = 0; k2 < 2; ++k2)
#pragma unroll
                for (int pt = 0; pt < 4; ++pt) st[pt] = MFMA16(bt[k2], xe[k2][pt], st[pt]);
            __builtin_amdgcn_sched_barrier(0); }
        if (c >= 1) {
        bf16x8 ca[4];
#pragma unroll
        for (int ks = 0; ks < 4; ++ks) ca[ks] = ldfrag(Ci, 16 * w, ks, fr, fq);
        const int irow = 16 * w + fr; const float aci = acum_s[irow];
#pragma unroll
        for (int j2 = 0; j2 < 4; ++j2) if (j2 <= (w >> 1)) { bf16x8 bf[2][4]; f32x4 acj[2];
#pragma unroll
            for (int h = 0; h < 2; ++h) {
#pragma unroll
                for (int ks = 0; ks < 4; ++ks) bf[h][ks] = ldfrag(Bi, 16 * (2 * j2 + h), ks, fr, fq);
                acj[h] = *(const LAS f32x4*)(acum_s + 16 * (2 * j2 + h) + 4 * fq); }
            __builtin_amdgcn_sched_barrier(0); LDS_WAIT(); __builtin_amdgcn_sched_barrier(0);
#pragma unroll
            for (int h = 0; h < 2; ++h) { const int jt = 2 * j2 + h; f32x4 G = (f32x4){0.f, 0.f, 0.f, 0.f};
#pragma unroll
                for (int ks = 0; ks < 4; ++ks) G = MFMA16(bf[h][ks], ca[ks], G);
                const int j0 = 16 * jt + 4 * fq; float wv[4];
#pragma unroll
                for (int r = 0; r < 4; ++r) wv[r] = (j0 + r <= irow) ? G[r] * __expf(aci - acj[h][r]) : 0.f;
                u32x2 o; o.x = cvt_pk_bf16(wv[0], wv[1]); o.y = cvt_pk_bf16(wv[2], wv[3]); *(LAS u32x2*)(Wi + img_off(irow, j0)) = o; }
            __builtin_amdgcn_sched_barrier(0); }
        u32x2 xo[4], zo[4]; const int rg = rowg(c, irow);
        {
#pragma unroll
            for (int pt = 0; pt < 4; ++pt) zo[pt] = *(const u32x2*)(ZS + (size_t)rg * DI + head * 64 + 16 * pt + 4 * fq); }
        f32x4 y[4];
#pragma unroll
        for (int pt = 0; pt < 4; ++pt) y[pt] = (f32x4){0.f, 0.f, 0.f, 0.f};
#pragma unroll
        for (int kh = 0; kh < 2; ++kh) { bf16x8 hb[2][4];
#pragma unroll
            for (int k2 = 0; k2 < 2; ++k2)
#pragma unroll
                for (int pt = 0; pt < 4; ++pt) hb[k2][pt] = ldfrag(Hi, 16 * pt, 2 * kh + k2, fr, fq);
            __builtin_amdgcn_sched_barrier(0); LDS_WAIT(); __builtin_amdgcn_sched_barrier(0);
#pragma unroll
            for (int k2 = 0; k2 < 2; ++k2)
#pragma unroll
                for (int pt = 0; pt < 4; ++pt) y[pt] = MFMA16(hb[k2][pt], ca[2 * kh + k2], y[pt]);
            __builtin_amdgcn_sched_barrier(0); }
        const float eai = ea_s[irow];
#pragma unroll
        for (int pt = 0; pt < 4; ++pt) y[pt] = y[pt] * eai;
        LDS_WAIT();
#pragma unroll
        for (int kh = 0; kh < 2; ++kh) if (2 * kh <= (w >> 1)) { bf16x8 wa[2], xb[2][4];
#pragma unroll
            for (int k2 = 0; k2 < 2; ++k2) { wa[k2] = ldfrag(Wi, 16 * w, 2 * kh + k2, fr, fq);
#pragma unroll
                for (int pt = 0; pt < 4; ++pt) xb[k2][pt] = trfrag128(XDi, 16 * pt, 2 * kh + k2, lq); }
            __builtin_amdgcn_sched_barrier(0); LDS_WAIT(); __builtin_amdgcn_sched_barrier(0);
#pragma unroll
            for (int k2 = 0; k2 < 2; ++k2) if (2 * kh + k2 <= (w >> 1))
#pragma unroll
                for (int pt = 0; pt < 4; ++pt) y[pt] = MFMA16(xb[k2][pt], wa[k2], y[pt]);
            __builtin_amdgcn_sched_barrier(0); }
        { float ssq = 0.f; const float dti = dt_s[irow], rdt = dti > 0.f ? 1.0f / dti : 0.f;
#pragma unroll
            for (int pt = 0; pt < 4; ++pt) xo[pt] = *(const LAS u32x2*)(XDi + irow * 128 + ((((2 * pt + (fq >> 1)) ^ irow) & 7) << 4) + ((fq & 1) << 3));
#pragma unroll
            for (int pt = 0; pt < 4; ++pt) { const float x4[4] = {bf_lo(xo[pt].x) * rdt, bf_hi(xo[pt].x) * rdt, bf_lo(xo[pt].y) * rdt, bf_hi(xo[pt].y) * rdt}, z4[4] = {bf_lo(zo[pt].x), bf_hi(zo[pt].x), bf_lo(zo[pt].y), bf_hi(zo[pt].y)}; float gv[4];
#pragma unroll
                for (int r = 0; r < 4; ++r) { gv[r] = (y[pt][r] + Dh * x4[r]) * z4[r]; ssq += gv[r] * gv[r]; }
                u32x2 o; o.x = cvt_pk_bf16(gv[0], gv[1]); o.y = cvt_pk_bf16(gv[2], gv[3]); *(u32x2*)(YG + (size_t)rg * K2 + head * 64 + 16 * pt + 4 * fq) = o; }
            ssq += __shfl_xor(ssq, 16); ssq += __shfl_xor(ssq, 32);
            if (fq == 0) SSQ[(size_t)rg * 64 + head] = ssq; }
        }
    }
    { const int fr = lane & 15, fq = lane >> 4; float* so = a.out + O_NSSMP + (size_t)(b * NH + head) * HP * NS;
#pragma unroll
    for (int pt = 0; pt < 4; ++pt) *(f32x4*)(so + (size_t)(16 * pt + fr) * NS + 16 * w + 4 * fq) = st[pt]; }
}

__device__ __forceinline__ void phase_ssd_sample(const Args& a, LAS unsigned char* lds, int G) {
    const int tid = threadIdx.x, u = tid >> 8, tt = tid & 255, pq = tt >> 3, nq = tid & 7, p0 = 2 * pq;
    const bf16_t* XC = (const bf16_t*)(a.ws + W_XC); const float* DT = (const float*)(a.ws + W_DT); bf16_t* Y = (bf16_t*)(a.ws + W_A2);
    const bf16_t* ZSp = (const bf16_t*)(a.ws + W_ZS); float* SSQp = (float*)(a.ws + W_SSQ);
    constexpr int BCR = 160;
    constexpr int BUF = 8 * 64 + 2 * 8 * BCR + 16 + 8 * 64;
    const int nit = (DECB * NH - (int)blockIdx.x + G - 1) / G;
    const float dsk_l = a.in[I_DSKIP][tid & 63], al_l = a.in[I_ALOG][tid & 63];
    const int pcA = tid, pcB = 512 + (tid & 127);
    f32x4 hs[8]; u32x4 pfA, pfB; float pdt; unsigned pzz;
    auto item_of = [&](int kk) -> int { return blockIdx.x + (kk < nit ? kk : nit - 1) * G; };
    auto piece_ptr = [&](int k, int pc) -> const bf16_t* { const int it = item_of(k + pc / 320), seq = it >> 6, head = it & 63, g = head >> 3, r = pc % 320, pi = r / 40, pq40 = r % 40;
        const int col = pq40 < 8 ? head * 64 + pq40 * 8 : (pq40 < 24 ? DI + g * 128 + (pq40 - 8) * 8 : DI + 1024 + g * 128 + (pq40 - 24) * 8); return XC + (size_t)(ROW_S0 + seq * 8 + pi) * CONVD + col; };
    auto issue = [&](int k) { const int it = item_of(k + u), seq = it >> 6, head = it & 63;
        const float* s0 = a.in[I_SSM] + ((size_t)it * HP + p0) * NS + nq * 16;
#pragma unroll
        for (int j = 0; j < 4; ++j) { hs[j] = *(const f32x4*)(s0 + 4 * j); hs[4 + j] = *(const f32x4*)(s0 + NS + 4 * j); }
        pfA = *(const u32x4*)piece_ptr(k, pcA); pfB = *(const u32x4*)piece_ptr(k, pcB);
        pdt = DT[(size_t)(ROW_S0 + seq * 8 + (tid & 7)) * 64 + head];
        pzz = *(const unsigned*)(ZSp + (size_t)(ROW_S0 + seq * 8 + ((tt >> 5) & 7)) * DI + head * 64 + (tt & 31) * 2); };
    auto stash = [&](int pc, const u32x4 v) { const int uu = pc / 320, r = pc % 320, pi = r / 40, q = r % 40; float f[8]; unpack8(v, f);
        LAS float* xs = (LAS float*)lds + uu * BUF; const int hb = q < 24 ? q - 8 : q - 24;
        LAS float* dst = q < 8 ? xs + pi * 64 + q * 8 : (q < 24 ? xs + 512 + pi * BCR + (hb >> 1) * 20 + (hb & 1) * 8 : xs + 512 + 8 * BCR + pi * BCR + (hb >> 1) * 20 + (hb & 1) * 8);
        *(LAS f32x4*)dst = (f32x4){f[0], f[1], f[2], f[3]}; *(LAS f32x4*)(dst + 4) = (f32x4){f[4], f[5], f[6], f[7]}; };
    issue(0);
    for (int k = 0; k < nit; k += 2) {
        const int it = item_of(k + u), seq = it >> 6, head = it & 63; const bool live = k + u < nit;
        LAS float* xs = (LAS float*)lds + u * BUF; LAS float* Bs = xs + 512; LAS float* Cs = Bs + 8 * BCR; LAS float* dts = Cs + 8 * BCR; LAS float* das = dts + 8; LAS float* ys = das + 8;
        f32x2 h2[2][8];
#pragma unroll
        for (int r = 0; r < 2; ++r)
#pragma unroll
            for (int j = 0; j < 4; ++j) { h2[r][2 * j] = (f32x2){hs[4 * r + j][0], hs[4 * r + j][1]}; h2[r][2 * j + 1] = (f32x2){hs[4 * r + j][2], hs[4 * r + j][3]}; }
        stash(pcA, pfA); if (tid < 128) stash(pcB, pfB);
        const float Dh = __shfl(dsk_l, head), alh = __shfl(al_l, head); const unsigned zz = pzz;
        if ((tid & 255) < 8) { dts[tid & 7] = pdt; das[tid & 7] = __expf(-pdt * __expf(alh)); }
        LDS_BARRIER();
        issue(k + 2);
        float ya[2][8];
#pragma unroll
        for (int i = 0; i < 8; ++i) {
            const f32x2 xv = *(const LAS f32x2*)(xs + i * 64 + p0); const float dtv = dts[i], av = das[i]; const float xd0 = xv[0] * dtv, xd1 = xv[1] * dtv; f32x2 y0 = (f32x2){0.f, 0.f}, y1 = y0;
#pragma unroll
            for (int j = 0; j < 4; ++j) { const f32x4 bb = *(const LAS f32x4*)(Bs + i * BCR + nq * 20 + 4 * j), cc = *(const LAS f32x4*)(Cs + i * BCR + nq * 20 + 4 * j);
                const f32x2 bl = (f32x2){bb[0], bb[1]}, bh = (f32x2){bb[2], bb[3]}, cl = (f32x2){cc[0], cc[1]}, ch = (f32x2){cc[2], cc[3]};
                h2[0][2 * j] = h2[0][2 * j] * av + bl * xd0; h2[0][2 * j + 1] = h2[0][2 * j + 1] * av + bh * xd0; y0 = y0 + cl * h2[0][2 * j]; y0 = y0 + ch * h2[0][2 * j + 1];
                h2[1][2 * j] = h2[1][2 * j] * av + bl * xd1; h2[1][2 * j + 1] = h2[1][2 * j + 1] * av + bh * xd1; y1 = y1 + cl * h2[1][2 * j]; y1 = y1 + ch * h2[1][2 * j + 1]; }
            ya[0][i] = y0[0] + y0[1]; ya[1][i] = y1[0] + y1[1];
        }
#pragma unroll
        for (int r = 0; r < 2; ++r) { float t4[4], t2[2], t1;
#pragma unroll
            for (int i = 0; i < 4; ++i) { const float keep = (nq & 4) ? ya[r][i + 4] : ya[r][i], send = (nq & 4) ? ya[r][i] : ya[r][i + 4]; t4[i] = keep + __shfl_xor(send, 4); }
#pragma unroll
            for (int i = 0; i < 2; ++i) { const float keep = (nq & 2) ? t4[i + 2] : t4[i], send = (nq & 2) ? t4[i] : t4[i + 2]; t2[i] = keep + __shfl_xor(send, 2); }
            { const float keep = (nq & 1) ? t2[1] : t2[0], send = (nq & 1) ? t2[0] : t2[1]; t1 = keep + __shfl_xor(send, 1); }
            ys[nq * 64 + p0 + r] = t1 + Dh * xs[nq * 64 + p0 + r]; }
        if (live) { float* so = a.out + O_NSSMS + ((size_t)it * HP + p0) * NS + nq * 16;
#pragma unroll
            for (int r = 0; r < 2; ++r)
#pragma unroll
                for (int j = 0; j < 4; ++j) *(f32x4*)(so + r * NS + 4 * j) = (f32x4){h2[r][2 * j][0], h2[r][2 * j][1], h2[r][2 * j + 1][0], h2[r][2 * j + 1][1]}; }
        LDS_BARRIER();
        if (live) { const int i = tt >> 5, pp = (tt & 31) * 2; const size_t ro = (size_t)(ROW_S0 + seq * 8 + i);
            const float g0 = ys[i * 64 + pp] * bf_lo(zz), g1 = ys[i * 64 + pp + 1] * bf_hi(zz); float sq = g0 * g0 + g1 * g1;
            *(unsigned*)(Y + ro * K2 + head * 64 + pp) = cvt_pk_bf16(g0, g1);
            sq += __shfl_xor(sq, 1); sq += __shfl_xor(sq, 2); sq += __shfl_xor(sq, 4); sq += __shfl_xor(sq, 8); sq += __shfl_xor(sq, 16);
            if ((tt & 31) == 0) SSQp[ro * 64 + head] = sq; }
        LDS_BARRIER();
    }
}
__device__ __forceinline__ void phase_ssd(const Args& a, LAS unsigned char* lds, int G) {
    for (int it = blockIdx.x; it < NB * NH; it += G) { const int v = (G == 256) ? (it & 7) * 32 + (it >> 3) : it; ssd_prompt_item(a, lds, v >> 6, v & 63); }
    __syncthreads();
    phase_ssd_sample(a, lds, G);
}

struct SmallAcc { f32x4 v[2][2]; };
template <class Off, class Hook, class Pre>
__device__ __forceinline__ void small_gemm_kloop(LAS unsigned char* lds, const bf16_t* A, const bf16_t* Bt, int ld, int nks, SmallAcc& acc, Off koff, Hook hook, Pre pre) {
    const int tid = threadIdx.x, lane = tid & 63, w = __builtin_amdgcn_readfirstlane(tid >> 6), wm = w >> 1, wn = w & 1, fr = lane & 15, fq = lane >> 4;
    constexpr int ABYTES = 128 * 256, BUFB = ABYTES + 64 * 256;
    const int lr = lane >> 4, lc = (lane & 15) ^ ((4 * w + lr) & 15);
    const bf16_t* ga = A + (size_t)(4 * w + lr) * ld + lc * 8; const bf16_t* gb = Bt + (size_t)(4 * w + lr) * ld + lc * 8; const size_t r32 = (size_t)32 * ld;
    const unsigned lw = (unsigned)w * 1024u;
#define SG_ISSUE(kt, bufi) do { const int _kt = (kt) < nks ? (kt) : nks - 1; LAS unsigned char* _b = lds + (bufi) * BUFB + lw; const int _ko = koff(_kt); \
        _Pragma("unroll") for (int _i = 0; _i < 4; ++_i) __builtin_amdgcn_global_load_lds((const unsigned*)(ga + _i * r32 + _ko), (LAS unsigned*)(_b + _i * 8192), 16, 0, 0); \
        _Pragma("unroll") for (int _i = 0; _i < 2; ++_i) __builtin_amdgcn_global_load_lds((const unsigned*)(gb + _i * r32 + _ko), (LAS unsigned*)(_b + ABYTES + _i * 8192), 16, 0, 0); } while (0)
    SG_ISSUE(0, 0); SG_ISSUE(1, 1);
    pre();
    int bi = 0;
    for (int k = 0; k < nks; ++k) {
        asm volatile("s_waitcnt vmcnt(6)" ::: "memory");
        __builtin_amdgcn_s_barrier();
        asm volatile("" ::: "memory");
        const int bn = bi == 0 ? 2 : bi - 1;
        SG_ISSUE(k + 2, bn);
        const LAS unsigned char* cur = lds + bi * BUFB;
        bf16x8 af[2][2][2], bfm[2][2][2];
#pragma unroll
        for (int hk = 0; hk < 2; ++hk) {
#pragma unroll
            for (int ks = 0; ks < 2; ++ks)
#pragma unroll
                for (int i = 0; i < 2; ++i) { const int ra = 32 * wm + 16 * i + fr, rbw = 32 * wn + 16 * i + fr, ch = 8 * hk + 4 * ks + fq;
                    af[hk][ks][i] = *(const LAS bf16x8*)(cur + ra * 256 + (((ch ^ ra) & 15) << 4)); bfm[hk][ks][i] = *(const LAS bf16x8*)(cur + ABYTES + rbw * 256 + (((ch ^ rbw) & 15) << 4)); }
            __builtin_amdgcn_sched_barrier(0);
        }
        asm volatile("s_waitcnt lgkmcnt(8)" ::: "memory");
        __builtin_amdgcn_sched_barrier(0);
#pragma unroll
        for (int ks = 0; ks < 2; ++ks)
#pragma unroll
            for (int mb = 0; mb < 2; ++mb)
#pragma unroll
                for (int nb = 0; nb < 2; ++nb) acc.v[mb][nb] = __builtin_amdgcn_mfma_f32_16x16x32_bf16(bfm[0][ks][nb], af[0][ks][mb], acc.v[mb][nb], 0, 0, 0);
        __builtin_amdgcn_sched_barrier(0);
        asm volatile("s_waitcnt lgkmcnt(0)" ::: "memory");
        __builtin_amdgcn_sched_barrier(0);
#pragma unroll
        for (int ks = 0; ks < 2; ++ks)
#pragma unroll
            for (int mb = 0; mb < 2; ++mb)
#pragma unroll
                for (int nb = 0; nb < 2; ++nb) acc.v[mb][nb] = __builtin_amdgcn_mfma_f32_16x16x32_bf16(bfm[1][ks][nb], af[1][ks][mb], acc.v[mb][nb], 0, 0, 0);
        hook(k, acc);
        bi = bi == 2 ? 0 : bi + 1;
    }
    asm volatile("s_waitcnt vmcnt(0)" ::: "memory");
    __builtin_amdgcn_s_barrier();
    asm volatile("" ::: "memory");
#undef SG_ISSUE
}
__device__ __forceinline__ void small_gemm2_tile(const Args& a, LAS unsigned char* lds, int tm, int tn) {
    const int tid = threadIdx.x, lane = tid & 63, w = __builtin_amdgcn_readfirstlane(tid >> 6), wm = w >> 1, wn = w & 1, fr = lane & 15, fq = lane >> 4;
    const bf16_t* A2 = (const bf16_t*)(a.ws + W_A2) + (size_t)(ROW_S0 + 128 * tm) * K2; const bf16_t* WT2 = (const bf16_t*)(a.ws + W_WT2) + (size_t)(64 * tn) * K2;
    const bf16_t* SGA = (const bf16_t*)(a.ws + W_SGA); const bf16_t* SGR = (const bf16_t*)(a.ws + W_SGR); bf16_t* MG = (bf16_t*)(a.ws + W_MERGED); const float* SSQ = (const float*)(a.ws + W_SSQ);
    float rs[2][8];
    u32x2 rr[2][2];
    SmallAcc acc;
#pragma unroll
    for (int mb = 0; mb < 2; ++mb)
#pragma unroll
        for (int nb = 0; nb < 2; ++nb) acc.v[mb][nb] = (f32x4){0.f, 0.f, 0.f, 0.f};
    small_gemm_kloop(lds, A2, WT2, K2, 48, acc,
        [](int k) { return k < 16 ? DI + 128 * k : 128 * (k - 16); },
        [&](int k, SmallAcc& ac) {
            if (k == 15) {
#pragma unroll
                for (int mb = 0; mb < 2; ++mb) { const float t0 = 1.0f / rs[mb][0];
#pragma unroll
                    for (int nb = 0; nb < 2; ++nb) { f32x4& v = ac.v[mb][nb]; const u32x2 r = rr[mb][nb]; v = (f32x4){v[0] * bf_lo(r.x) * t0, v[1] * bf_hi(r.x) * t0, v[2] * bf_lo(r.y) * t0, v[3] * bf_hi(r.y) * t0}; } } }
            else if (k >= 19 && k < 47 && ((k - 19) & 3) == 0) { const int g = (k - 19) >> 2;
#pragma unroll
                for (int mb = 0; mb < 2; ++mb) { float tf = 0.f;
#pragma unroll
                    for (int gg = 0; gg < 7; ++gg) tf = (g == gg) ? rs[mb][gg] / rs[mb][gg + 1] : tf;
#pragma unroll
                    for (int nb = 0; nb < 2; ++nb) ac.v[mb][nb] = ac.v[mb][nb] * tf; } } },
        [&]() {
#pragma unroll
    for (int mb = 0; mb < 2; ++mb) { const float* sp = SSQ + (size_t)(ROW_S0 + 128 * tm + 32 * wm + 16 * mb + fr) * 64;
#pragma unroll
        for (int g = 0; g < 8; ++g) { const f32x4 q0 = *(const f32x4*)(sp + 8 * g), q1 = *(const f32x4*)(sp + 8 * g + 4); const float sm = ((q0[0] + q0[1]) + (q0[2] + q0[3])) + ((q1[0] + q1[1]) + (q1[2] + q1[3])); rs[mb][g] = 1.0f / sqrtf(sm * (1.0f / 512.0f) + EPS); } }
#pragma unroll
    for (int mb = 0; mb < 2; ++mb)
#pragma unroll
        for (int nb = 0; nb < 2; ++nb) rr[mb][nb] = *(const u32x2*)(SGR + (size_t)(ROW_S0 + 128 * tm + 32 * wm + 16 * mb + fr) * D + 64 * tn + 32 * wn + 16 * nb + 4 * fq);
#pragma unroll
        for (int mb = 0; mb < 2; ++mb)
#pragma unroll
            for (int nb = 0; nb < 2; ++nb) asm volatile("" : "+v"(rr[mb][nb].x), "+v"(rr[mb][nb].y));
        });
#pragma unroll
    for (int mb = 0; mb < 2; ++mb)
#pragma unroll
        for (int nb = 0; nb < 2; ++nb) { const size_t off = (size_t)(ROW_S0 + 128 * tm + 32 * wm + 16 * mb + fr) * D + 64 * tn + 32 * wn + 16 * nb + 4 * fq; const u32x2 g = *(const u32x2*)(SGA + off); const float t8 = rs[mb][7];
            const f32x4 v = acc.v[mb][nb]; u32x2 o; o.x = cvt_pk_bf16(v[0] * bf_lo(g.x) * t8, v[1] * bf_hi(g.x) * t8); o.y = cvt_pk_bf16(v[2] * bf_lo(g.y) * t8, v[3] * bf_hi(g.y) * t8); *(u32x2*)(MG + off) = o; }
}
__device__ __forceinline__ void small_gemm3_tile(const Args& a, LAS unsigned char* lds, int tm, int tn) {
    const int tid = threadIdx.x, lane = tid & 63, w = __builtin_amdgcn_readfirstlane(tid >> 6), wm = w >> 1, wn = w & 1, fr = lane & 15, fq = lane >> 4;
    const bf16_t* MG = (const bf16_t*)(a.ws + W_MERGED) + (size_t)(ROW_S0 + 128 * tm) * D; const bf16_t* WT3 = (const bf16_t*)(a.ws + W_WT3) + (size_t)(64 * tn) * D;
    float* PS2 = (float*)(a.ws + W_PS2); unsigned* cnt = (unsigned*)(a.ws + W_CTL + CTL_PANEL2) + 64 * tm;
    LDS_BARRIER();
    SmallAcc acc;
#pragma unroll
    for (int mb = 0; mb < 2; ++mb)
#pragma unroll
        for (int nb = 0; nb < 2; ++nb) acc.v[mb][nb] = (f32x4){0.f, 0.f, 0.f, 0.f};
    f32x4 xv[2][2], fw[2];
#pragma unroll
    for (int mb = 0; mb < 2; ++mb)
#pragma unroll
        for (int nb = 0; nb < 2; ++nb) xv[mb][nb] = *(const f32x4*)(a.in[I_XS] + (size_t)(128 * tm + 32 * wm + 16 * mb + fr) * D + 64 * tn + 32 * wn + 16 * nb + 4 * fq);
#pragma unroll
    for (int nb = 0; nb < 2; ++nb) fw[nb] = *(const f32x4*)(a.in[I_FNW] + 64 * tn + 32 * wn + 16 * nb + 4 * fq);
    small_gemm_kloop(lds, MG, WT3, D, D / 128, acc, [](int k) { return 128 * k; }, [](int, SmallAcc&) {}, []() {});
    LAS float* P = (LAS float*)lds;
    LAS float* Sc = P + 256;
#pragma unroll
    for (int mb = 0; mb < 2; ++mb) { const int rl = 32 * wm + 16 * mb + fr; float sq = 0.f;
#pragma unroll
        for (int nb = 0; nb < 2; ++nb) { f32x4& v = acc.v[mb][nb]; v = v + xv[mb][nb]; sq += (v[0] * v[0] + v[1] * v[1]) + (v[2] * v[2] + v[3] * v[3]); }
        sq += __shfl_xor(sq, 16); sq += __shfl_xor(sq, 32);
        if (fq == 0) P[rl * 2 + wn] = sq; }
    LDS_BARRIER();
    if (tid < 128) __hip_atomic_store(PS2 + (size_t)(128 * tm + tid) * 32 + tn, P[tid * 2] + P[tid * 2 + 1], __ATOMIC_RELAXED, __HIP_MEMORY_SCOPE_AGENT);
    asm volatile("s_waitcnt vmcnt(0)" ::: "memory");
    if (tid < 128 && (tid & 63) == 0) __hip_atomic_fetch_add(cnt, 1u, __ATOMIC_RELAXED, __HIP_MEMORY_SCOPE_AGENT);
    if (w == 0) { unsigned spins = 0;
        while ((unsigned)__builtin_amdgcn_readfirstlane(__hip_atomic_load(cnt, __ATOMIC_RELAXED, __HIP_MEMORY_SCOPE_AGENT)) < 64u) { __builtin_amdgcn_s_sleep(2); if (++spins > (1u << 22)) break; }
        __builtin_amdgcn_fence(__ATOMIC_ACQUIRE, "agent");
        asm volatile("s_waitcnt vmcnt(0)" ::: "memory"); }
    LDS_BARRIER();
    if (tid < 128) { const float* pp = PS2 + (size_t)(128 * tm + tid) * 32; float sm = 0.f;
#pragma unroll
        for (int t = 0; t < 32; ++t) sm += __hip_atomic_load(pp + t, __ATOMIC_RELAXED, __HIP_MEMORY_SCOPE_AGENT);
        Sc[tid] = 1.0f / sqrtf(sm * (1.0f / D) + EPS); }
    LDS_BARRIER();
#pragma unroll
    for (int mb = 0; mb < 2; ++mb) { const int rl = 32 * wm + 16 * mb + fr; const float rs = Sc[rl];
#pragma unroll
        for (int nb = 0; nb < 2; ++nb) { const int col = 64 * tn + 32 * wn + 16 * nb + 4 * fq;
            *(f32x4*)(a.out + O_YS + (size_t)(128 * tm + rl) * D + col) = acc.v[mb][nb] * rs * fw[nb]; } }
    LDS_BARRIER();
}

constexpr int N_PHASES = 6;
__global__ void __launch_bounds__(512, 2) fwd_kernel(Args a) {
    extern __shared__ __attribute__((aligned(16))) unsigned char lds_raw[];
    LAS unsigned char* lds = (LAS unsigned char*)lds_raw;
    const int G = gridDim.x; const int lo = a.ph_lo, hi = a.ph_hi;
#define IN(k) (lo <= (k) && (k) < hi)
    volatile LAS unsigned* misc = (volatile LAS unsigned*)(lds + LDS_MISC);
    if (threadIdx.x < 16) misc[threadIdx.x] = 0u;
    __syncthreads();
    XcdBarrier bar; bar.bar = (unsigned*)(a.ws + W_CTL); bar.x = 0; bar.st = misc;
    if (hi - lo > 1) bar = xcd_barrier_post((unsigned*)(a.ws + W_CTL), misc);
#define SEAM(k) do { if (IN(k) && IN((k) + 1)) xcd_barrier(bar); } while (0)
    if (IN(0)) phase_prep(a, lds, G);
    SEAM(0);
    if (IN(1)) {
        if (G == 256) { const int x = blockIdx.x & 7, j = blockIdx.x >> 3, wv = __builtin_amdgcn_readfirstlane(threadIdx.x >> 6); constexpr int PX = PREP_I23 / 8;
            const int off = (PX * (j * (j - 1) / 2)) / 496, nj = (PX * (j * (j + 1) / 2)) / 496 - off;
            transpose_range(a, lds, PREP_I1 + x * PX + off + wv, 8, PREP_I1 + x * PX + off + nj); }
        else if ((G & 7) == 0) { const int x = blockIdx.x & 7, wpx = (G >> 3) * 8, wi = (blockIdx.x >> 3) * 8 + __builtin_amdgcn_readfirstlane(threadIdx.x >> 6);
            const int off = (PREP_I23 * (x * (x - 1) / 2)) / 28, nx = (PREP_I23 * (x * (x + 1) / 2)) / 28 - off;
            transpose_range(a, lds, PREP_I1 + off + wi, wpx, PREP_I1 + off + nx); }
        else transpose_range(a, lds, PREP_I1 + blockIdx.x * 8 + __builtin_amdgcn_readfirstlane(threadIdx.x >> 6), G * 8, PREP_I1 + PREP_I23);
        asm volatile("s_waitcnt vmcnt(0)" ::: "memory"); __syncthreads();
        pg8::Gemm g{(const bf16_t*)(a.ws + W_H), (const bf16_t*)(a.ws + W_WT1), D, 0, D / 64, 0, 0}; pg8::StaticOrder S; S.init(MP, NP1, G, (int)blockIdx.x);
        Epi1 E{(bf16_t*)(a.ws + W_ZS), (bf16_t*)(a.ws + W_XBC), (bf16_t*)(a.ws + W_U), (bf16_t*)(a.ws + W_GB), (bf16_t*)(a.ws + W_SGA), (bf16_t*)(a.ws + W_SGR), (float*)(a.ws + W_DT), a.in[I_DTB], a.out};
        pg8::gemm_phase<Epi1, pg8::StaticOrder, true, true>(lds, g, S, E);
    }
    SEAM(1);
    if (IN(2)) phase_conv(a, G);
    SEAM(2);
    if (IN(3)) phase_ssd(a, lds, G);
    SEAM(3);
    if (IN(4)) {
        pg8::Gemm g{(const bf16_t*)(a.ws + W_A2), (const bf16_t*)(a.ws + W_WT2), K2, DI, D / 64, 512, 8}; pg8::SegOrder<9> S; S.init(ROW_S0, D, G, (int)blockIdx.x);
        Epi2 E{(const bf16_t*)(a.ws + W_SGA), (const bf16_t*)(a.ws + W_SGR), (bf16_t*)(a.ws + W_MERGED), lds};
        const int small_first = (G == 256) ? (int)((blockIdx.x >> 3) & 1) : 0;
        for (int stp = 0; stp < 2; ++stp) {
            if ((stp ^ small_first) == 0) {
                { pg8::Unit u0; if (S.next(0, u0)) build_rs_table(lds, (const float*)(a.ws + W_SSQ), u0.pm); }
                __syncthreads();
                pg8::gemm_phase<Epi2, pg8::SegOrder<9>, true, true>(lds, g, S, E);
            } else {
                for (int t = blockIdx.x; t < 256; t += G) small_gemm2_tile(a, lds, t >> 5, t & 31);
            }
        }
    }
    SEAM(4);
    if (IN(5)) {
        pg8::Gemm g{(const bf16_t*)(a.ws + W_MERGED), (const bf16_t*)(a.ws + W_WT3), D, 0, D / 64, 0, 0}; pg8::StaticOrder S; S.init(ROW_S0, D, G, (int)blockIdx.x);
        EpiOutNorm E{a.in[I_XP], a.in[I_FNW], a.out, (float*)(a.ws + W_PS), (unsigned*)(a.ws + W_CTL + CTL_PANEL)};
        pg8::gemm_phase<EpiOutNorm, pg8::StaticOrder, true, true>(lds, g, S, E);
        for (int t = blockIdx.x; t < 256; t += G) small_gemm3_tile(a, lds, t >> 5, t & 31);
    }
#undef IN
}

extern "C" void kernel_launch(void* const* d_in, const int* in_sizes, int n_in, void* d_out, int out_size, void* d_ws, size_t ws_size, hipStream_t stream) {
    static int grid = 0;
    if (grid == 0) {
        int dev = 0, cus = 0;
        if (n_in != 19 || ws_size < W_END) { fprintf(stderr, "kernel_launch: unexpected n_in %d or ws_size %zu (< %zu)\n", n_in, ws_size, (size_t)W_END); grid = -1; return; }
        if (hipGetDevice(&dev) != hipSuccess || hipDeviceGetAttribute(&cus, hipDeviceAttributeMultiprocessorCount, dev) != hipSuccess) { grid = -1; return; }
        if (hipFuncSetAttribute((const void*)fwd_kernel, hipFuncAttributeMaxDynamicSharedMemorySize, LDS_BYTES) != hipSuccess) { fprintf(stderr, "kernel_launch: hipFuncSetAttribute failed\n"); grid = -1; return; }
        int per_cu = 0; (void)hipOccupancyMaxActiveBlocksPerMultiprocessor(&per_cu, (const void*)fwd_kernel, 512, LDS_BYTES); (void)hipGetLastError();
        if (per_cu < 1) fprintf(stderr, "kernel_launch: occupancy query says %d blocks per CU\n", per_cu);
        grid = cus;
    }
    if (grid < 0) return;
    Args a{};
    for (int i = 0; i < 19; ++i) a.in[i] = (const float*)d_in[i];
    a.out = (float*)d_out; a.ws = (unsigned char*)d_ws;
    a.ph_lo = 0; a.ph_hi = N_PHASES;
    (void)hipMemsetAsync((unsigned char*)d_ws + W_CTL, 0, CTL_BYTES, stream);
    hipLaunchKernelGGL(fwd_kernel, dim3(grid), dim3(512), LDS_BYTES, stream, a);
}
```

```cpp
#include <hip/hip_runtime.h>
#include <cstdio>
#include <cstdint>

#define LAS __attribute__((address_space(3)))
typedef unsigned short bf16_t;
typedef short bf16x8 __attribute__((ext_vector_type(8)));
typedef float f32x4 __attribute__((ext_vector_type(4)));
typedef float f32x2 __attribute__((ext_vector_type(2)));
typedef unsigned u32x4 __attribute__((ext_vector_type(4)));
typedef unsigned u32x2 __attribute__((ext_vector_type(2)));

constexpr int D = 2048, NB = 4, SEQ = 2048, META = 16, DECB = 128, DECS = 8;
constexpr int DI = 4096, NH = 64, HP = 64, NS = 128, NG = 8, CONVD = 6144, SCW = 2048, PROJ = 22592;
constexpr float EPS = 1e-6f;
constexpr int ROW_S0 = 8192, ROW_M0 = 9216, M_REAL = 9232, MP = 9472, M_OUT = 9216;
constexpr int NP1 = 89 * 256;
constexpr int C_XBC = 4096, C_DT = 10240, C_SC = 10304, C_G = 18496;
constexpr size_t O_YP = 0, O_YS = 16777216, O_NCP = 18874368, O_NSSMP = 18948096, O_NSCP = 21045248, O_NCS = 21061632, O_NSSMS = 23420928, O_NSCS = 90529792;
constexpr size_t SZ_R2K = (size_t)MP * 2048 * 2;
constexpr size_t W_H = 0;
constexpr size_t W_WT1 = W_H + SZ_R2K;
constexpr int K2 = 6144;
constexpr size_t W_WT2 = W_WT1 + (size_t)NP1 * 2048 * 2;
constexpr size_t W_WT3 = W_WT2 + (size_t)2048 * K2 * 2;
constexpr size_t W_ZS = W_WT3 + (size_t)2048 * 2048 * 2;
constexpr size_t W_XBC = W_ZS + (size_t)MP * 4096 * 2;
constexpr size_t W_DT = W_XBC + (size_t)MP * 6144 * 2;
constexpr size_t W_U = W_DT + (size_t)MP * 64 * 4;
constexpr size_t W_GB = W_U + SZ_R2K;
constexpr size_t W_SGA = W_GB + SZ_R2K;
constexpr size_t W_SGR = W_SGA + SZ_R2K;
constexpr size_t W_XC = W_SGR + SZ_R2K;
constexpr size_t W_A2 = W_XC + (size_t)MP * 6144 * 2;
constexpr size_t W_MERGED = W_A2 + (size_t)MP * K2 * 2;
constexpr size_t W_CTL = W_MERGED + SZ_R2K;
constexpr size_t CTL_BYTES = 32768;
constexpr size_t CTL_PANEL = 16384, CTL_PANEL2 = 24576;
constexpr size_t W_SSQ = W_CTL + CTL_BYTES;
constexpr size_t W_PS = W_SSQ + (size_t)MP * 64 * 4;
constexpr size_t W_PS2 = W_PS + (size_t)ROW_S0 * 8 * 4;
constexpr size_t W_END = W_PS2 + (size_t)1024 * 32 * 4;
constexpr size_t W_OUTP = W_XBC;

constexpr int LDS_BYTES = 163840;
constexpr int LDS_MISC = 163840 - 64;

typedef __bf16 bf16x2v __attribute__((ext_vector_type(2)));
__device__ __forceinline__ unsigned cvt_pk_bf16(float lo, float hi) { f32x2 v = {lo, hi}; bf16x2v b = __builtin_convertvector(v, bf16x2v); return __builtin_bit_cast(unsigned, b); }
__device__ __forceinline__ float bf_lo(unsigned w) { return __uint_as_float(w << 16); }
__device__ __forceinline__ float bf_hi(unsigned w) { return __uint_as_float(w & 0xffff0000u); }
__device__ __forceinline__ float fsigmoid(float x) { return __builtin_amdgcn_rcpf(1.0f + __expf(-x)); }
__device__ __forceinline__ float fsilu(float x) { return x * fsigmoid(x); }
__device__ __forceinline__ f32x4 silu4(const f32x4 v) {
    const f32x2 xa = (f32x2){v[0], v[1]}, xb = (f32x2){v[2], v[3]}, cs = (f32x2){-1.44269504088896f, -1.44269504088896f}, one = (f32x2){1.0f, 1.0f};
    const f32x2 ta = xa * cs, tb = xb * cs;
    const float e0 = __builtin_amdgcn_exp2f(ta[0]), e1 = __builtin_amdgcn_exp2f(ta[1]), e2 = __builtin_amdgcn_exp2f(tb[0]), e3 = __builtin_amdgcn_exp2f(tb[1]);
    const f32x2 ua = (f32x2){e0, e1} + one, ub = (f32x2){e2, e3} + one;
    const float r0 = __builtin_amdgcn_rcpf(ua[0]), r1 = __builtin_amdgcn_rcpf(ua[1]), r2 = __builtin_amdgcn_rcpf(ub[0]), r3 = __builtin_amdgcn_rcpf(ub[1]);
    const f32x2 ya = xa * (f32x2){r0, r1}, yb = xb * (f32x2){r2, r3};
    return (f32x4){ya[0], ya[1], yb[0], yb[1]};
}
__device__ __forceinline__ void gate4(const f32x4 ga4, const f32x4 gb4, float* sa, float* rt) {
    const f32x2 cs = (f32x2){-1.44269504088896f, -1.44269504088896f}, one = (f32x2){1.0f, 1.0f};
    f32x2 a0 = (f32x2){fminf(fmaxf(ga4[0], -30.f), 30.f), fminf(fmaxf(ga4[1], -30.f), 30.f)}, a1 = (f32x2){fminf(fmaxf(ga4[2], -30.f), 30.f), fminf(fmaxf(ga4[3], -30.f), 30.f)};
    f32x2 b0 = (f32x2){fminf(fmaxf(gb4[0], -30.f), 30.f), fminf(fmaxf(gb4[1], -30.f), 30.f)}, b1 = (f32x2){fminf(fmaxf(gb4[2], -30.f), 30.f), fminf(fmaxf(gb4[3], -30.f), 30.f)};
    a0 = a0 * cs; a1 = a1 * cs; b0 = b0 * cs; b1 = b1 * cs;
    const f32x2 ea0 = (f32x2){__builtin_amdgcn_exp2f(a0[0]), __builtin_amdgcn_exp2f(a0[1])} + one, ea1 = (f32x2){__builtin_amdgcn_exp2f(a1[0]), __builtin_amdgcn_exp2f(a1[1])} + one;
    const f32x2 eb0 = (f32x2){__builtin_amdgcn_exp2f(b0[0]), __builtin_amdgcn_exp2f(b0[1])} + one, eb1 = (f32x2){__builtin_amdgcn_exp2f(b1[0]), __builtin_amdgcn_exp2f(b1[1])} + one;
    sa[0] = __builtin_amdgcn_rcpf(ea0[0]); sa[1] = __builtin_amdgcn_rcpf(ea0[1]); sa[2] = __builtin_amdgcn_rcpf(ea1[0]); sa[3] = __builtin_amdgcn_rcpf(ea1[1]);
    const f32x2 r0 = ea0 * (f32x2){__builtin_amdgcn_rcpf(eb0[0]), __builtin_amdgcn_rcpf(eb0[1])}, r1 = ea1 * (f32x2){__builtin_amdgcn_rcpf(eb1[0]), __builtin_amdgcn_rcpf(eb1[1])};
    rt[0] = r0[0]; rt[1] = r0[1]; rt[2] = r1[0]; rt[3] = r1[1];
}
__device__ __forceinline__ void silu4_pk_bf16(const f32x4 v, unsigned& lo, unsigned& hi) {
    const f32x2 xa = (f32x2){v[0], v[1]}, xb = (f32x2){v[2], v[3]}, cs = (f32x2){-1.44269504088896f, -1.44269504088896f}, one = (f32x2){1.0f, 1.0f};
    const f32x2 ta = xa * cs, tb = xb * cs;
    const float e0 = __builtin_amdgcn_exp2f(ta[0]), e1 = __builtin_amdgcn_exp2f(ta[1]), e2 = __builtin_amdgcn_exp2f(tb[0]), e3 = __builtin_amdgcn_exp2f(tb[1]);
    const f32x2 ua = (f32x2){e0, e1} + one, ub = (f32x2){e2, e3} + one;
    const float r0 = __builtin_amdgcn_rcpf(ua[0]), r1 = __builtin_amdgcn_rcpf(ua[1]), r2 = __builtin_amdgcn_rcpf(ub[0]), r3 = __builtin_amdgcn_rcpf(ub[1]);
    const f32x2 ya = xa * (f32x2){r0, r1}, yb = xb * (f32x2){r2, r3};
    lo = cvt_pk_bf16(ya[0], ya[1]); hi = cvt_pk_bf16(yb[0], yb[1]);
}
__device__ __forceinline__ float wave_sum(float v) {
#pragma unroll
    for (int o = 1; o < 64; o <<= 1) v += __shfl_xor(v, o);
    return v;
}
__device__ __forceinline__ void unpack8(const u32x4 w, float (&f)[8]) {
    f[0] = bf_lo(w.x); f[1] = bf_hi(w.x); f[2] = bf_lo(w.y); f[3] = bf_hi(w.y); f[4] = bf_lo(w.z); f[5] = bf_hi(w.z); f[6] = bf_lo(w.w); f[7] = bf_hi(w.w);
}
__device__ __forceinline__ u32x4 pack8(const float (&f)[8]) {
    u32x4 w; w.x = cvt_pk_bf16(f[0], f[1]); w.y = cvt_pk_bf16(f[2], f[3]); w.z = cvt_pk_bf16(f[4], f[5]); w.w = cvt_pk_bf16(f[6], f[7]); return w;
}
#define LDS_WAIT() asm volatile("s_waitcnt lgkmcnt(0)" ::: "memory")
#define LDS_BARRIER() do { asm volatile("s_waitcnt lgkmcnt(0)" ::: "memory"); __builtin_amdgcn_s_barrier(); asm volatile("" ::: "memory"); } while (0)

namespace pg8 {
constexpr int BM = 256, BK = 64, HALF = 128, HTB = HALF * BK * 2, STAGE_BYTES = 8 * HTB, NXCD = 8, WGM = 8;
__host__ __device__ __forceinline__ int lds_byte(int r, int c) { const int st = (r >> 4) * 2 + (c >> 5), rr = r & 15, cc = c & 31, ob = rr * 64 + cc * 2; return st * 1024 + (ob ^ (((ob >> 9) & 1) << 5)); }
__host__ __device__ __forceinline__ void stage_rc(int b, int& R, int& C) { const int st = b / 1024, sb = b % 1024, swz = sb ^ (((sb >> 9) & 1) << 5); R = (st >> 1) * 16 + swz / 64; C = (st & 1) * 32 + (swz % 64) / 2; }
__host__ __device__ __forceinline__ int perm32(int rho) { const int n = rho >> 4, i = rho & 15; return 8 * (i >> 2) + 4 * n + (i & 3); }
struct Unit { int pm, pn, seg; };
struct Gemm { const bf16_t* A; const bf16_t* Bt; int ldk; int koff0, nt0; int kseg, ntseg;
    __device__ __forceinline__ int koff(int s) const { return s ? (s - 1) * kseg : koff0; } __device__ __forceinline__ int ntiles(int s) const { return s ? ntseg : nt0; } };
struct StaticOrder {
    int nM, nN, nwg, G, c;
    __host__ __device__ __forceinline__ void init(int M, int N, int G_, int c_) { nM = M / BM; nN = N / BM; nwg = nM * nN; G = G_; c = c_; }
    __host__ __device__ __forceinline__ bool next(int i, Unit& u) const {
        const long L = (long)i * G + c; if (L >= nwg) return false;
        int wgid = (int)L; { const int q = nwg / NXCD, r = nwg % NXCD, xcd = wgid % NXCD, off = wgid / NXCD; wgid = (xcd < r ? xcd * (q + 1) : r * (q + 1) + (xcd - r) * q) + off; }
        const int nig = WGM * nN, gid = wgid / nig, fm = gid * WGM, gsz = (nM - fm) < WGM ? (nM - fm) : WGM;
        u.pm = fm + ((wgid % nig) % gsz); u.pn = (wgid % nig) / gsz; u.seg = 0; return true;
    }
    __device__ __forceinline__ void a_ready(const Unit&) const {}
    __device__ __forceinline__ void done(const Unit&) const {}
};
template <int NSEG> struct SegOrder : StaticOrder {
    __host__ __device__ __forceinline__ bool next(int i, Unit& u) const { if (!StaticOrder::next(i / NSEG, u)) return false; u.seg = i % NSEG; return true; }
};

template <class Epi, class Sched, bool ALIGN_EPI = false, bool SP2 = false>
__device__ __forceinline__ void gemm_phase(LAS unsigned char* lds, const Gemm g, const Sched& S, const Epi& E) {
    const int tid = threadIdx.x, wid = __builtin_amdgcn_readfirstlane(tid >> 6), lane = tid & 63, wr = wid >> 2, wc = wid & 3, fr = lane & 15, fq = lane >> 4;
    const int K = g.ldk;
    unsigned voffA[2], voffB[2];
#pragma unroll
    for (int i = 0; i < 2; ++i) { int R, C; stage_rc(tid * 16 + i * 8192, R, C); const int Rb = Epi::PERM ? ((R & ~31) + perm32(R & 31)) : R;
        voffA[i] = (unsigned)(R * K + C) * 2u; voffB[i] = (unsigned)(Rb * K + C) * 2u; }
    const size_t kstep = (size_t)(BK * 2);
    const size_t hstep = (size_t)HALF * K * 2;
    const size_t tstep = 2 * hstep;
    const unsigned ldsw = (unsigned)wid * 1024u;
    const int aoff = lds_byte(wr * 64 + fr, fq * 8), boff = lds_byte(wc * 32 + fr, fq * 8);
#define PG8_SA(b, h) (((b) * 2 + (h)) * HTB)
#define PG8_SB(b, h) ((4 + (b) * 2 + (h)) * HTB)
#define PG8_STAGE(bufoff, gbase, voff) do { _Pragma("unroll") for (int _i = 0; _i < 2; ++_i) \
        __builtin_amdgcn_global_load_lds((const unsigned*)((const char*)(gbase) + (voff)[_i]), (LAS unsigned*)(lds + (bufoff) + ldsw + _i * 8192), 16, 0, 0); } while (0)
#define PG8_LDA(dst, b, h) do { _Pragma("unroll") for (int m = 0; m < 4; ++m) _Pragma("unroll") for (int k = 0; k < 2; ++k) dst[m][k] = *(const LAS bf16x8*)(lds + PG8_SA(b, h) + aoff + m * 2048 + k * 1024); } while (0)
#define PG8_LDB(dst, b, h) do { _Pragma("unroll") for (int n = 0; n < 2; ++n) _Pragma("unroll") for (int k = 0; k < 2; ++k) dst[n][k] = *(const LAS bf16x8*)(lds + PG8_SB(b, h) + boff + n * 2048 + k * 1024); } while (0)
#define PG8_MMA(ai, bj, At, Bt) do { __builtin_amdgcn_s_setprio(1); _Pragma("unroll") for (int m = 0; m < 4; ++m) _Pragma("unroll") for (int n = 0; n < 2; ++n) _Pragma("unroll") for (int k = 0; k < 2; ++k) \
        acc[ai][bj][m][n] = __builtin_amdgcn_mfma_f32_16x16x32_bf16(Bt[n][k], At[m][k], acc[ai][bj][m][n], 0, 0, 0); __builtin_amdgcn_s_setprio(0); } while (0)
#define PG8_WAIT_V(n) asm volatile("s_waitcnt vmcnt(" #n ")" ::: "memory")
#define PG8_WAIT_L(n) asm volatile("s_waitcnt lgkmcnt(" #n ")" ::: "memory")
#define PG8_WAIT_V8R(rx) asm volatile("s_waitcnt vmcnt(24)\n\ts_cmp_lg_u32 %0, 0\n\ts_cbranch_scc1 1\n\ts_waitcnt vmcnt(8)" :: "s"(__builtin_amdgcn_readfirstlane(rx)) : "scc", "memory")
#define PG8_BAR __builtin_amdgcn_s_barrier()
#define PG8_SCHED __builtin_amdgcn_sched_barrier(0)
    Unit cur, nxt; int ui = 0; int rx = 0;
    if (!S.next(0, cur)) return;
    f32x4 acc[2][2][4][2];
#pragma unroll
    for (int a = 0; a < 2; ++a)
#pragma unroll
        for (int b = 0; b < 2; ++b)
#pragma unroll
            for (int m = 0; m < 4; ++m)
#pragma unroll
                for (int n = 0; n < 2; ++n) acc[a][b][m][n] = (f32x4){0.f, 0.f, 0.f, 0.f};
    bf16x8 At[4][2], B0[2][2], B1[2][2];
    const char* cA = (const char*)g.A + (size_t)cur.pm * tstep + (size_t)g.koff(cur.seg) * 2; const char* cB = (const char*)g.Bt + (size_t)cur.pn * tstep + (size_t)g.koff(cur.seg) * 2;
    S.a_ready(cur);
    if constexpr (SP2) {
        PG8_STAGE(PG8_SB(0, 0), cB, voffB); PG8_STAGE(PG8_SB(0, 1), cB + hstep, voffB); PG8_STAGE(PG8_SA(0, 0), cA, voffA); PG8_STAGE(PG8_SA(0, 1), cA + hstep, voffA);
        if (wr == 1) PG8_BAR;
        PG8_WAIT_V(2); PG8_BAR;
        PG8_STAGE(PG8_SB(1, 0), cB + kstep, voffB); PG8_STAGE(PG8_SA(1, 0), cA + kstep, voffA); PG8_STAGE(PG8_SB(1, 1), cB + hstep + kstep, voffB);
        PG8_WAIT_V(6); PG8_BAR;
    } else {
        PG8_STAGE(PG8_SB(0, 0), cB, voffB); PG8_STAGE(PG8_SA(0, 0), cA, voffA); PG8_STAGE(PG8_SB(0, 1), cB + hstep, voffB); PG8_STAGE(PG8_SA(0, 1), cA + hstep, voffA);
        if (wr == 1) PG8_BAR;
        PG8_WAIT_V(4); PG8_BAR;
        PG8_STAGE(PG8_SB(1, 0), cB + kstep, voffB); PG8_STAGE(PG8_SA(1, 0), cA + kstep, voffA); PG8_STAGE(PG8_SB(1, 1), cB + hstep + kstep, voffB);
        PG8_WAIT_V(6); PG8_BAR;
    }
    for (;;) {
        const bool has_next = S.next(ui + 1, nxt);
        const char* nA = has_next ? (const char*)g.A + (size_t)nxt.pm * tstep + (size_t)g.koff(nxt.seg) * 2 : cA; const char* nB = has_next ? (const char*)g.Bt + (size_t)nxt.pn * tstep + (size_t)g.koff(nxt.seg) * 2 : cB;
        const int nt = g.ntiles(cur.seg);
        for (int t = 0; t < nt; t += 2) {
            const bool last = (t == nt - 2);
            const char* a1 = cA + (size_t)(t + 1) * kstep;
            const char* a2 = last ? nA : cA + (size_t)(t + 2) * kstep; const char* b2 = last ? nB : cB + (size_t)(t + 2) * kstep;
            const char* a3 = a2 + kstep; const char* b3 = b2 + kstep;
            if (last && has_next) S.a_ready(nxt);
            if constexpr (SP2) {
            PG8_LDB(B0, 0, 0); PG8_LDB(B1, 0, 1); PG8_SCHED; PG8_LDA(At, 0, 0); PG8_STAGE(PG8_SA(1, 1), a1 + hstep, voffA);
            PG8_WAIT_V8R(rx); PG8_WAIT_L(0); PG8_BAR; PG8_MMA(0, 0, At, B0); PG8_MMA(0, 1, At, B1); PG8_BAR; PG8_SCHED;
            PG8_LDA(At, 0, 1); PG8_STAGE(PG8_SB(0, 0), b2, voffB); PG8_STAGE(PG8_SB(0, 1), b2 + hstep, voffB); PG8_STAGE(PG8_SA(0, 0), a2, voffA);
            PG8_WAIT_V8R(rx); asm volatile("s_mov_b32 %0, 0" : "=s"(rx)); PG8_WAIT_L(0); PG8_BAR; PG8_MMA(1, 0, At, B0); PG8_MMA(1, 1, At, B1); PG8_BAR; PG8_SCHED;
            PG8_LDB(B0, 1, 0); PG8_LDB(B1, 1, 1); PG8_SCHED; PG8_LDA(At, 1, 0); PG8_STAGE(PG8_SA(0, 1), a2 + hstep, voffA);
            PG8_WAIT_V(8); PG8_WAIT_L(0); PG8_BAR; PG8_MMA(0, 0, At, B0); PG8_MMA(0, 1, At, B1); PG8_BAR; PG8_SCHED;
            PG8_LDA(At, 1, 1); PG8_STAGE(PG8_SB(1, 0), b3, voffB); PG8_STAGE(PG8_SB(1, 1), b3 + hstep, voffB); PG8_STAGE(PG8_SA(1, 0), a3, voffA);
            PG8_WAIT_V(8); PG8_WAIT_L(0); PG8_BAR; PG8_MMA(1, 0, At, B0); PG8_MMA(1, 1, At, B1); PG8_BAR; PG8_SCHED;
            } else {
            PG8_LDB(B0, 0, 0); PG8_SCHED; PG8_LDA(At, 0, 0); PG8_STAGE(PG8_SA(1, 1), a1 + hstep, voffA);
            PG8_WAIT_L(8); PG8_BAR; PG8_WAIT_L(0); PG8_MMA(0, 0, At, B0); PG8_BAR; PG8_SCHED;
            PG8_LDB(B1, 0, 1); PG8_STAGE(PG8_SB(0, 0), b2, voffB);
            PG8_BAR; PG8_WAIT_L(0); PG8_MMA(0, 1, At, B1); PG8_BAR;
            PG8_LDA(At, 0, 1); PG8_STAGE(PG8_SA(0, 0), a2, voffA);
            PG8_BAR; PG8_WAIT_L(0); PG8_MMA(1, 0, At, B0); PG8_BAR; PG8_SCHED;
            PG8_STAGE(PG8_SB(0, 1), b2 + hstep, voffB);
            PG8_WAIT_V(6); PG8_BAR; PG8_MMA(1, 1, At, B1); PG8_BAR;
            PG8_LDB(B0, 1, 0); PG8_SCHED; PG8_LDA(At, 1, 0); PG8_STAGE(PG8_SA(0, 1), a2 + hstep, voffA);
            PG8_WAIT_L(8); PG8_BAR; PG8_WAIT_L(0); PG8_MMA(0, 0, At, B0); PG8_BAR; PG8_SCHED;
            PG8_LDB(B1, 1, 1); PG8_STAGE(PG8_SB(1, 0), b3, voffB);
            PG8_BAR; PG8_WAIT_L(0); PG8_MMA(0, 1, At, B1); PG8_BAR;
            PG8_LDA(At, 1, 1); PG8_STAGE(PG8_SA(1, 0), a3, voffA);
            PG8_BAR; PG8_WAIT_L(0); PG8_MMA(1, 0, At, B0); PG8_BAR; PG8_SCHED;
            PG8_STAGE(PG8_SB(1, 1), b3 + hstep, voffB);
            PG8_WAIT_V(6); PG8_BAR; PG8_MMA(1, 1, At, B1); PG8_BAR;
            }
        }
        if constexpr (ALIGN_EPI) { if (wr == 0) PG8_BAR; }
        if constexpr (!Epi::AFTER_DRAIN) E(acc, cur, wr, wc, fr, fq);
        S.done(cur); rx = Epi::stores16(cur);
        if (!has_next) break;
        if (!Epi::CARRY || cur.seg == Epi::LAST_SEG) {
#pragma unroll
        for (int a = 0; a < 2; ++a)
#pragma unroll
            for (int b = 0; b < 2; ++b)
#pragma unroll
                for (int m = 0; m < 4; ++m)
#pragma unroll
                    for (int n = 0; n < 2; ++n) acc[a][b][m][n] = (f32x4){0.f, 0.f, 0.f, 0.f};
        }
        cur = nxt; cA = nA; cB = nB; ++ui;
        if constexpr (ALIGN_EPI) { if (wr == 1) PG8_BAR; }
    }
    PG8_WAIT_V(0);
    if constexpr (!ALIGN_EPI) { if (wr == 0) PG8_BAR; }
    PG8_BAR;
    if constexpr (Epi::AFTER_DRAIN) E.fused(acc, cur, wr, wc, fr, fq, lds);
#undef PG8_SA
#undef PG8_SB
#undef PG8_STAGE
#undef PG8_LDA
#undef PG8_LDB
#undef PG8_MMA
#undef PG8_WAIT_V
#undef PG8_WAIT_V8R
#undef PG8_WAIT_L
#undef PG8_BAR
#undef PG8_SCHED
}
}

__device__ __forceinline__ float fsoftplus(float v) {
    const float e = __expf(fminf(v, 20.f)), u = 1.0f + e, l = (u == 1.0f) ? e : __logf(u) * (e * __builtin_amdgcn_rcpf(u - 1.0f));
    return v > 20.f ? v : l;
}
struct Epi1 {
    static constexpr bool PERM = true, CARRY = false, AFTER_DRAIN = false; static constexpr int LAST_SEG = 0;
    bf16_t *ZS, *XBC, *U, *GB, *SGA, *SGR; float* DT; const float* dt_bias; float* out;
    static __device__ __forceinline__ int stores16(const pg8::Unit& u) { return u.pn < 88 ? 1 : 0; }
    __device__ __forceinline__ void operator()(f32x4 (&acc)[2][2][4][2], const pg8::Unit& u, int wr, int wc, int fr, int fq) const {
        const int pn = u.pn; const int rbase = u.pm * 256 + wr * 64 + fr;
        const bool has_o = u.pm < 32 ? (u.pm & 7) == 7 : u.pm < 36;
        if (pn < 16) {
#pragma unroll
            for (int ai = 0; ai < 2; ++ai)
#pragma unroll
                for (int m = 0; m < 4; ++m) { const int row = rbase + ai * 128 + m * 16; bf16_t* rowp = ZS + (size_t)row * DI + pn * 256 + wc * 32 + 8 * fq;
#pragma unroll
                    for (int bj = 0; bj < 2; ++bj) { const f32x4 v0 = acc[ai][bj][m][0], v1 = acc[ai][bj][m][1]; u32x4 w;
                        unsigned q0, q1, q2, q3; silu4_pk_bf16(v0, q0, q1); silu4_pk_bf16(v1, q2, q3); w = (u32x4){q0, q1, q2, q3};
                        *(u32x4*)(rowp + bj * 128) = w; } }
        } else if (pn < 40) {
#pragma unroll
            for (int ai = 0; ai < 2; ++ai)
#pragma unroll
                for (int m = 0; m < 4; ++m) { const int row = rbase + ai * 128 + m * 16; const int col = (pn - 16) * 256 + wc * 32 + 8 * fq; bf16_t* rowp = XBC + (size_t)row * CONVD + col;
                    int oidx = -1;
                    if (!has_o) {} else if (row < ROW_S0) { const int t = row & 2047; if (t >= 2045) oidx = (int)O_NCP + ((row >> 11) * 3 + (t - 2045)) * CONVD; }
                    else if (row < ROW_M0) { const int t = row & 7; if (t >= 5) oidx = (int)O_NCS + (((row - ROW_S0) >> 3) * 3 + (t - 5)) * CONVD; }
#pragma unroll
                    for (int bj = 0; bj < 2; ++bj) { const f32x4 v0 = acc[ai][bj][m][0], v1 = acc[ai][bj][m][1]; u32x4 w;
                        w.x = cvt_pk_bf16(v0[0], v0[1]); w.y = cvt_pk_bf16(v0[2], v0[3]); w.z = cvt_pk_bf16(v1[0], v1[1]); w.w = cvt_pk_bf16(v1[2], v1[3]);
                        *(u32x4*)(rowp + bj * 128) = w;
                        if (oidx >= 0) { float* o = out + oidx + col + bj * 128; *(f32x4*)o = v0; *(f32x4*)(o + 4) = v1; } } }
        } else if (pn < 72) {
#pragma unroll
            for (int ai = 0; ai < 2; ++ai)
#pragma unroll
                for (int m = 0; m < 4; ++m) { const int row = rbase + ai * 128 + m * 16; const int j0 = (pn - 40) * 64 + wc * 16 + fq * 4;
                    const f32x4 sb = acc[ai][0][m][0], sc = acc[ai][0][m][1], sh = acc[ai][1][m][0], sz = acc[ai][1][m][1];
                    const f32x4 uu = sc * sh; const f32x4 gg = sb * silu4(sz);
                    u32x2 wu, wg; wu.x = cvt_pk_bf16(uu[0], uu[1]); wu.y = cvt_pk_bf16(uu[2], uu[3]); wg.x = cvt_pk_bf16(gg[0], gg[1]); wg.y = cvt_pk_bf16(gg[2], gg[3]);
                    *(u32x2*)(U + (size_t)row * SCW + j0) = wu; *(u32x2*)(GB + (size_t)row * SCW + j0) = wg;
                    int oidx = -1;
                    if (!has_o) {} else if (row < ROW_S0) { const int t = row & 2047; if (t >= 2046) oidx = (int)O_NSCP + ((row >> 11) * 2 + (t - 2046)) * SCW; }
                    else if (row < ROW_M0) { const int t = row & 7; if (t >= 6) oidx = (int)O_NSCS + (((row - ROW_S0) >> 3) * 2 + (t - 6)) * SCW; }
                    if (oidx >= 0) *(f32x4*)(out + oidx + j0) = uu; }
        } else if (pn < 88) {
#pragma unroll
            for (int ai = 0; ai < 2; ++ai)
#pragma unroll
                for (int m = 0; m < 4; ++m) { const int row = rbase + ai * 128 + m * 16; const int j0 = (pn - 72) * 128 + wc * 32 + 8 * fq; float sa[8], rt[8];
#pragma unroll
                    for (int n = 0; n < 2; ++n) gate4(acc[ai][0][m][n], acc[ai][1][m][n], sa + 4 * n, rt + 4 * n);
                    *(u32x4*)(SGA + (size_t)row * D + j0) = pack8(sa); *(u32x4*)(SGR + (size_t)row * D + j0) = pack8(rt); }
        } else {
            if (wc < 2) {
                const int c0 = wc * 32 + 8 * fq; const f32x4 bb0 = *(const f32x4*)(dt_bias + c0), bb1 = *(const f32x4*)(dt_bias + c0 + 4);
#pragma unroll
                for (int ai = 0; ai < 2; ++ai)
#pragma unroll
                    for (int m = 0; m < 4; ++m) { const int row = rbase + ai * 128 + m * 16; f32x4 v0 = acc[ai][0][m][0] + bb0, v1 = acc[ai][0][m][1] + bb1;
#pragma unroll
                        for (int e = 0; e < 4; ++e) { v0[e] = fsoftplus(v0[e]); v1[e] = fsoftplus(v1[e]); }
                        *(f32x4*)(DT + (size_t)row * 64 + c0) = v0; *(f32x4*)(DT + (size_t)row * 64 + c0 + 4) = v1; }
            }
        }
    }
};
constexpr int LDS_RST = 131072;
__device__ __forceinline__ void build_rs_table(LAS unsigned char* lds, const float* SSQ, int pm) {
    LAS float* T = (LAS float*)(lds + LDS_RST);
    const int tid = threadIdx.x, trow = tid >> 1, half = tid & 1; const float* sp = SSQ + (size_t)(pm * 256 + trow) * 64 + 32 * half; float rs[4];
#pragma unroll
    for (int g = 0; g < 4; ++g) { const f32x4 q0 = *(const f32x4*)(sp + 8 * g), q1 = *(const f32x4*)(sp + 8 * g + 4); const float sm = ((q0[0] + q0[1]) + (q0[2] + q0[3])) + ((q1[0] + q1[1]) + (q1[2] + q1[3])); rs[g] = 1.0f / sqrtf(sm * (1.0f / 512.0f) + EPS); }
    const float rprev = __shfl_xor(rs[3], 1);
    LAS float* tp = T + trow * 12 + 4 * half;
    if (half == 0) { tp[0] = 1.0f / rs[0]; tp[1] = rs[0] / rs[1]; tp[2] = rs[1] / rs[2]; tp[3] = rs[2] / rs[3]; }
    else { tp[0] = rprev / rs[0]; tp[1] = rs[0] / rs[1]; tp[2] = rs[1] / rs[2]; tp[3] = rs[2] / rs[3]; tp[4] = rs[3]; }
}
struct Epi2 {
    static constexpr bool PERM = true, CARRY = true, AFTER_DRAIN = false; static constexpr int LAST_SEG = 8;
    static __device__ __forceinline__ int stores16(const pg8::Unit&) { return 0; }
    const bf16_t* SGA; const bf16_t* SGR; bf16_t* MG; LAS unsigned char* lds;
    __device__ __forceinline__ void operator()(f32x4 (&acc)[2][2][4][2], const pg8::Unit& u, int wr, int wc, int fr, int fq) const {
        const int rbase = u.pm * 256 + wr * 64 + fr; LAS float* T = (LAS float*)(lds + LDS_RST);
        const bool gated = (u.seg == 0) || (u.seg == 8); const bf16_t* gp = u.seg == 0 ? SGR : SGA;
#pragma unroll
        for (int ai = 0; ai < 2; ++ai) { u32x4 g[4][2];
#pragma unroll
            for (int m = 0; m < 4; ++m)
#pragma unroll
                for (int bj = 0; bj < 2; ++bj) g[m][bj] = (u32x4){0x3f803f80u, 0x3f803f80u, 0x3f803f80u, 0x3f803f80u};
            if (gated) {
#pragma unroll
                for (int m = 0; m < 4; ++m)
#pragma unroll
                    for (int bj = 0; bj < 2; ++bj) g[m][bj] = *(const u32x4*)(gp + (size_t)(rbase + ai * 128 + m * 16) * D + u.pn * 256 + bj * 128 + wc * 32 + 8 * fq); }
#pragma unroll
            for (int m = 0; m < 4; ++m) { const float tf = T[(wr * 64 + fr + ai * 128 + m * 16) * 12 + u.seg];
#pragma unroll
                for (int bj = 0; bj < 2; ++bj) { float gf[8]; unpack8(g[m][bj], gf); f32x4& v0 = acc[ai][bj][m][0]; f32x4& v1 = acc[ai][bj][m][1];
                    v0 = (f32x4){v0[0] * gf[0] * tf, v0[1] * gf[1] * tf, v0[2] * gf[2] * tf, v0[3] * gf[3] * tf}; v1 = (f32x4){v1[0] * gf[4] * tf, v1[1] * gf[5] * tf, v1[2] * gf[6] * tf, v1[3] * gf[7] * tf};
                    if (u.seg == 8) { u32x4 w; w.x = cvt_pk_bf16(v0[0], v0[1]); w.y = cvt_pk_bf16(v0[2], v0[3]); w.z = cvt_pk_bf16(v1[0], v1[1]); w.w = cvt_pk_bf16(v1[2], v1[3]);
                        *(u32x4*)(MG + (size_t)(rbase + ai * 128 + m * 16) * D + u.pn * 256 + bj * 128 + wc * 32 + 8 * fq) = w; } } }
            asm volatile("" ::: "memory"); }
    }
};
struct EpiOutNorm {
    static constexpr bool PERM = false, CARRY = false, AFTER_DRAIN = true; static constexpr int LAST_SEG = 0;
    static __device__ __forceinline__ int stores16(const pg8::Unit&) { return 0; }
    const float* xp; const float* fnw; float* out; float* PS; unsigned* cnt;
    __device__ __forceinline__ void operator()(f32x4 (&)[2][2][4][2], const pg8::Unit&, int, int, int, int) const {}
    __device__ __forceinline__ void fused(f32x4 (&acc)[2][2][4][2], const pg8::Unit& u, int wr, int wc, int fr, int fq, LAS unsigned char* lds) const {
        const int tid = threadIdx.x, wid = tid >> 6; const int rbase = u.pm * 256 + wr * 64 + fr;
        LAS float* P = (LAS float*)lds;
        LAS float* Sc = P + 1024;
#pragma unroll
        for (int ai = 0; ai < 2; ++ai)
#pragma unroll
            for (int mp = 0; mp < 2; ++mp) { f32x4 xv[2][2][2];
#pragma unroll
                for (int mm = 0; mm < 2; ++mm) { const float* xr = xp + (size_t)(rbase + ai * 128 + (2 * mp + mm) * 16) * D;
#pragma unroll
                    for (int bj = 0; bj < 2; ++bj)
#pragma unroll
                        for (int n = 0; n < 2; ++n) xv[mm][bj][n] = *(const f32x4*)(xr + u.pn * 256 + bj * 128 + wc * 32 + n * 16 + 4 * fq); }
#pragma unroll
                for (int mm = 0; mm < 2; ++mm) { float sq = 0.f;
#pragma unroll
                    for (int bj = 0; bj < 2; ++bj)
#pragma unroll
                        for (int n = 0; n < 2; ++n) { f32x4& v = acc[ai][bj][2 * mp + mm][n]; v = v + xv[mm][bj][n]; sq += (v[0] * v[0] + v[1] * v[1]) + (v[2] * v[2] + v[3] * v[3]); }
                    sq += __shfl_xor(sq, 16); sq += __shfl_xor(sq, 32);
                    if (fq == 0) P[(wr * 64 + fr + ai * 128 + (2 * mp + mm) * 16) * 4 + wc] = sq; }
                asm volatile("" ::: "memory"); }
        LDS_BARRIER();
        if (tid < 256) { const f32x4 q = *(const LAS f32x4*)(P + tid * 4); __hip_atomic_store(PS + (size_t)(u.pm * 256 + tid) * 8 + u.pn, (q[0] + q[1]) + (q[2] + q[3]), __ATOMIC_RELAXED, __HIP_MEMORY_SCOPE_AGENT); }
        asm volatile("s_waitcnt vmcnt(0)" ::: "memory");
        if (tid < 256 && (tid & 63) == 0) __hip_atomic_fetch_add(cnt + 64 * u.pm, 1u, __ATOMIC_RELAXED, __HIP_MEMORY_SCOPE_AGENT);
        if (wid == 0) { unsigned spins = 0;
            while ((unsigned)__builtin_amdgcn_readfirstlane(__hip_atomic_load(cnt + 64 * u.pm, __ATOMIC_RELAXED, __HIP_MEMORY_SCOPE_AGENT)) < 32u) { __builtin_amdgcn_s_sleep(2); if (++spins > (1u << 22)) break; }
            __builtin_amdgcn_fence(__ATOMIC_ACQUIRE, "agent");
            asm volatile("s_waitcnt vmcnt(0)" ::: "memory"); }
        LDS_BARRIER();
        if (tid < 256) { const float* pp = PS + (size_t)(u.pm * 256 + tid) * 8; float sm = 0.f;
#pragma unroll
            for (int t = 0; t < 8; ++t) sm += __hip_atomic_load(pp + t, __ATOMIC_RELAXED, __HIP_MEMORY_SCOPE_AGENT);
            Sc[tid] = 1.0f / sqrtf(sm * (1.0f / D) + EPS); }
        LDS_BARRIER();
        f32x4 fw[2][2];
#pragma unroll
        for (int bj = 0; bj < 2; ++bj)
#pragma unroll
            for (int n = 0; n < 2; ++n) fw[bj][n] = *(const f32x4*)(fnw + u.pn * 256 + bj * 128 + wc * 32 + n * 16 + 4 * fq);
#pragma unroll
        for (int ai = 0; ai < 2; ++ai)
#pragma unroll
            for (int m = 0; m < 4; ++m) { const int rl = wr * 64 + fr + ai * 128 + m * 16; const float rs = Sc[rl];
#pragma unroll
                for (int bj = 0; bj < 2; ++bj)
#pragma unroll
                    for (int n = 0; n < 2; ++n) *(f32x4*)(out + (size_t)(u.pm * 256 + rl) * D + u.pn * 256 + bj * 128 + wc * 32 + n * 16 + 4 * fq) = acc[ai][bj][m][n] * rs * fw[bj][n]; }
    }
};

#define XB_TMO      128
#define XB_XCNT(j)  (256  + 64 * (j))
#define XB_XSUB(j)  (1280 + 64 * (j))
#define XB_XGEN(j)  (2304 + 64 * (j))
#define XB_TOP      3328
#define XB_TOPGEN   3392
#define XCD_BAR_WORDS 3456
#define XB_SPIN_CAP (1u << 21)
__device__ __forceinline__ unsigned xb_ld(unsigned* p)              { return __hip_atomic_load(p, __ATOMIC_RELAXED, __HIP_MEMORY_SCOPE_AGENT); }
__device__ __forceinline__ unsigned xb_add(unsigned* p, unsigned v) { return __hip_atomic_fetch_add(p, v, __ATOMIC_RELAXED, __HIP_MEMORY_SCOPE_AGENT); }
__device__ __forceinline__ unsigned xb_xcc_id() { return (unsigned)__builtin_amdgcn_s_getreg((3 << 11) | 20) & 0xFu; }
#define XB_SPIN(cond, bar) do { unsigned _sp = 0; while (cond) { __builtin_amdgcn_s_sleep(1); \
    if ((++_sp & 255u) == 0u) { if (xb_ld(&(bar)[XB_TMO])) break; if (_sp > XB_SPIN_CAP) { atomicAdd(&(bar)[XB_TMO], 1u); break; } } } } while (0)
struct XcdBarrier { unsigned* bar; unsigned x; volatile LAS unsigned* st; };
__device__ __forceinline__ XcdBarrier xcd_barrier_post(unsigned* bar, volatile LAS unsigned* st) {
    XcdBarrier b; b.bar = bar; b.x = xb_xcc_id(); b.st = st;
    if (threadIdx.x == 0) (void)xb_add(&bar[XB_XCNT(b.x)], 1u);
    return b;
}
__device__ __forceinline__ void xcd_barrier_complete(unsigned* bar, unsigned x, unsigned& nloc, unsigned& nx) {
    const unsigned G = gridDim.x * gridDim.y * gridDim.z;
    unsigned sum, cnt, mine, sp = 0u;
    for (;;) {
        sum = 0u; cnt = 0u; mine = 0u;
#pragma unroll
        for (unsigned j = 0; j < 16; ++j) { const unsigned c = xb_ld(&bar[XB_XCNT(j)]); sum += c; cnt += (c > 0u) ? 1u : 0u; mine = (j == x) ? c : mine; }
        if (sum == G) break;
        __builtin_amdgcn_s_sleep(1);
        if ((++sp & 255u) == 0u) { if (xb_ld(&bar[XB_TMO])) break; if (sp > XB_SPIN_CAP) { atomicAdd(&bar[XB_TMO], 1u); break; } }
    }
    nloc = mine > 0u ? mine : 1u; nx = cnt > 0u ? cnt : 1u;
}
__device__ __forceinline__ void xcd_barrier(const XcdBarrier& b) {
    asm volatile("s_waitcnt vmcnt(0)" ::: "memory");
    __syncthreads();
    if (threadIdx.x == 0) {
        unsigned* bar = b.bar;
        __builtin_amdgcn_s_waitcnt(0);
        unsigned nloc = b.st[0], nx = b.st[1];
        if (nloc == 0u) { xcd_barrier_complete(bar, b.x, nloc, nx); b.st[0] = nloc; b.st[1] = nx; }
        const unsigned old = xb_add(&bar[XB_XSUB(b.x)], 1u);
        const unsigned gen = old / nloc;
        if (old + 1u == (gen + 1u) * nloc) {
            __builtin_amdgcn_fence(__ATOMIC_RELEASE, "agent");
            asm volatile("s_waitcnt vmcnt(0)" ::: "memory");
            const unsigned og = xb_add(&bar[XB_TOP], 1u);
            const unsigned tg = og / nx;
            if (og + 1u == (tg + 1u) * nx) xb_add(&bar[XB_TOPGEN], 1u);
            else XB_SPIN(xb_ld(&bar[XB_TOPGEN]) == tg, bar);
            __builtin_amdgcn_fence(__ATOMIC_ACQUIRE, "agent");
            xb_add(&bar[XB_XGEN(b.x)], 1u);
            asm volatile("s_waitcnt vmcnt(0)" ::: "memory");
        } else {
            XB_SPIN(xb_ld(&bar[XB_XGEN(b.x)]) == gen, bar);
            __builtin_amdgcn_fence(__ATOMIC_ACQUIRE, "agent");
            asm volatile("s_waitcnt vmcnt(0)" ::: "memory");
        }
    }
    __syncthreads();
}

struct Args { const float* in[19]; float* out; unsigned char* ws; int ph_lo, ph_hi; };
enum { I_XP = 0, I_XS, I_SCONV4, I_SSM, I_SSCONV, I_META, I_NORMW, I_WIN, I_CW, I_CB, I_DTB, I_ALOG, I_DSKIP, I_SNW, I_WSSD, I_SCW, I_WSC, I_WO, I_FNW };

__device__ __forceinline__ int wt1_src_col(int np) {
    const int pn = np >> 8, c = np & 255;
    if (pn < 40) return np;
    if (pn < 72) { const int q = 2 * (c >> 7) + ((c >> 2) & 1), jl = 16 * ((c >> 5) & 3) + 4 * ((c >> 3) & 3) + (c & 3); return C_SC + 2048 * q + 64 * (pn - 40) + jl; }
    if (pn < 88) return C_G + 2048 * (c >> 7) + 128 * (pn - 72) + (c & 127);
    return c < 64 ? C_DT + c : -1;
}
struct TItem { const float* src; const float* ksc; bf16_t* dst; int ldw, pitch; bool valid; };
__device__ __forceinline__ TItem prep_decode(const Args& a, int it, int lane) {
    constexpr int I1 = 32 * (NP1 / 64), I2A = 64 * 32, I2B = 32 * 32, I3 = 32 * 32;
    TItem t; t.valid = it < I1 + I2A + I2B + I3; t.src = nullptr; t.ksc = nullptr; t.dst = nullptr; t.ldw = 0; t.pitch = 0;
    if (!t.valid) return t;
    const int l4 = 4 * (lane & 15), kr = lane >> 4, c8 = 8 * (lane & 7); int r = it;
    if (r < I1) { const int kb = r / (NP1 / 64), nb = r % (NP1 / 64); const int sc = wt1_src_col(nb * 64 + l4); t.ldw = PROJ; t.pitch = D;
        t.src = sc >= 0 ? a.in[I_WIN] + (size_t)(kb * 64 + kr) * PROJ + sc : nullptr; t.dst = (bf16_t*)(a.ws + W_WT1) + (size_t)(nb * 64) * D + kb * 64; return t; } r -= I1;
    if (r < I2A) { const int kb = r / 32, nb = r % 32; t.ldw = D; t.pitch = K2; t.src = a.in[I_WSSD] + (size_t)(kb * 64 + kr) * D + nb * 64 + l4; t.ksc = a.in[I_SNW] + kb * 64 + c8;
        t.dst = (bf16_t*)(a.ws + W_WT2) + (size_t)(nb * 64) * K2 + kb * 64; return t; } r -= I2A;
    if (r < I2B) { const int kb = r / 32, nb = r % 32; t.ldw = D; t.pitch = K2; t.src = a.in[I_WSC] + (size_t)(kb * 64 + kr) * D + nb * 64 + l4; t.dst = (bf16_t*)(a.ws + W_WT2) + (size_t)(nb * 64) * K2 + DI + kb * 64; return t; } r -= I2B;
    { const int kb = r / 32, nb = r % 32; t.ldw = D; t.pitch = D; t.src = a.in[I_WO] + (size_t)(kb * 64 + kr) * D + nb * 64 + l4; t.dst = (bf16_t*)(a.ws + W_WT3) + (size_t)(nb * 64) * D + kb * 64; }
    return t;
}
__device__ __forceinline__ void transpose_range(const Args& a, LAS unsigned char* lds, int first, int stride, int end) {
    const int tid = threadIdx.x, lane = tid & 63, wave = __builtin_amdgcn_readfirstlane(tid >> 6);
    LAS unsigned char* scr = lds + wave * 16384;
    const int kr = lane >> 4, n4 = lane & 15, c = lane & 7, nn = lane >> 3;
    f32x4 bufA[16], bufB[16];
#define TR_LOAD(buf, itm) do { if ((itm).valid) { _Pragma("unroll") for (int i = 0; i < 16; ++i) buf[i] = (itm).src ? *(const f32x4*)((itm).src + (size_t)(4 * i) * (itm).ldw) : (f32x4){0.f, 0.f, 0.f, 0.f}; } } while (0)
#define TR_ITEM(buf, cur, nx2) do { \
        _Pragma("unroll") for (int i = 0; i < 16; ++i) { const int k = 4 * i + kr; *(LAS f32x4*)(scr + k * 256 + ((n4 ^ (k >> 3)) << 4)) = buf[i]; } \
        TR_LOAD(buf, nx2); \
        f32x4 k0v = (f32x4){1.f, 1.f, 1.f, 1.f}, k1v = k0v; if ((cur).ksc) { k0v = *(const f32x4*)(cur).ksc; k1v = *(const f32x4*)((cur).ksc + 4); } \
        LDS_WAIT(); \
        _Pragma("unroll") for (int j = 0; j < 8; ++j) { const int n = nn + 8 * j; const LAS unsigned char* sp = scr + (8 * c) * 256 + (((n >> 2) ^ c) << 4) + ((n & 3) << 2); float f[8]; \
            _Pragma("unroll") for (int e = 0; e < 8; ++e) f[e] = *(const LAS float*)(sp + e * 256) * (e < 4 ? k0v[e & 3] : k1v[e & 3]); \
            *(u32x4*)((cur).dst + (size_t)n * (cur).pitch + 8 * c) = pack8(f); } \
        LDS_WAIT(); } while (0)
    TItem c0 = prep_decode(a, first < end ? first : 1 << 30, lane), c1 = prep_decode(a, first + stride < end ? first + stride : 1 << 30, lane);
    TR_LOAD(bufA, c0); TR_LOAD(bufB, c1);
    for (int it = first; c0.valid; it += 2 * stride) {
        const TItem c2 = prep_decode(a, it + 2 * stride < end ? it + 2 * stride : 1 << 30, lane), c3 = prep_decode(a, it + 3 * stride < end ? it + 3 * stride : 1 << 30, lane);
        TR_ITEM(bufA, c0, c2);
        if (c1.valid) TR_ITEM(bufB, c1, c3);
        c0 = c2; c1 = c3;
    }
#undef TR_ITEM
#undef TR_LOAD
}
constexpr int PREP_I1 = 32 * (NP1 / 64), PREP_I23 = 64 * 32 + 32 * 32 + 32 * 32;
__device__ __forceinline__ void phase_prep(const Args& a, LAS unsigned char* lds, int G) {
    const int tid = threadIdx.x, lane = tid & 63, wave = __builtin_amdgcn_readfirstlane(tid >> 6);
    const int gw = blockIdx.x * 8 + wave, NGW = G * 8;
    transpose_range(a, lds, gw, NGW, PREP_I1);
    bf16_t* H = (bf16_t*)(a.ws + W_H); const float* nw = a.in[I_NORMW];
    auto rowsrc = [&](int r) -> const float* { return r < ROW_S0 ? a.in[I_XP] + (size_t)r * D : (r < ROW_M0 ? a.in[I_XS] + (size_t)(r - ROW_S0) * D : (r < M_REAL ? a.in[I_META] + (size_t)(r - ROW_M0) * D : nullptr)); };
    f32x4 pv[8];
    { const float* src = gw < MP ? rowsrc(gw) : nullptr;
#pragma unroll
        for (int j = 0; j < 8; ++j) pv[j] = src ? ((const f32x4*)src)[lane + 64 * j] : (f32x4){0.f, 0.f, 0.f, 0.f}; }
    for (int r = gw; r < MP; r += NGW) {
        f32x4 v[8]; float s = 0.f;
#pragma unroll
        for (int j = 0; j < 8; ++j) { v[j] = pv[j]; s += (v[j][0] * v[j][0] + v[j][1] * v[j][1]) + (v[j][2] * v[j][2] + v[j][3] * v[j][3]); }
        { const float* src = r + NGW < MP ? rowsrc(r + NGW) : nullptr;
#pragma unroll
            for (int j = 0; j < 8; ++j) pv[j] = src ? ((const f32x4*)src)[lane + 64 * j] : (f32x4){0.f, 0.f, 0.f, 0.f}; }
        const float rs = 1.0f / sqrtf(wave_sum(s) * (1.0f / D) + EPS);
#pragma unroll
        for (int j = 0; j < 8; ++j) { const f32x4 w = ((const f32x4*)nw)[lane + 64 * j]; u32x2 o; o.x = cvt_pk_bf16(v[j][0] * rs * w[0], v[j][1] * rs * w[1]); o.y = cvt_pk_bf16(v[j][2] * rs * w[2], v[j][3] * rs * w[3]);
            ((u32x2*)(H + (size_t)r * D))[lane + 64 * j] = o; }
    }
}

__device__ __forceinline__ void phase_conv(const Args& a, int G) {
    const int tid = threadIdx.x;
    const bf16_t* XBC = (const bf16_t*)(a.ws + W_XBC); const bf16_t* U = (const bf16_t*)(a.ws + W_U); const bf16_t* GBp = (const bf16_t*)(a.ws + W_GB);
    bf16_t* XC = (bf16_t*)(a.ws + W_XC); bf16_t* A2 = (bf16_t*)(a.ws + W_A2);
    constexpr int NBLK = 512 + 64 + 1;
    for (int item = blockIdx.x; item < 512 + 2 * (NBLK - 512); item += G) {
        const int hf = item < 512 ? 1 : ((item - 512) & 1), blk = item < 512 ? item : 512 + ((item - 512) >> 1); const int cg = hf * 512 + tid; const bool isx = cg < 768;
        int r0, nseg, segrows, mode;
        if (blk < 512) { r0 = blk * 16; nseg = 1; segrows = 16; mode = (blk & 127) == 0 ? 1 : 0; }
        else if (blk < 576) { r0 = ROW_S0 + (blk - 512) * 16; nseg = 2; segrows = 8; mode = 2; }
        else { r0 = ROW_M0; nseg = 1; segrows = 16; mode = 3; }
        if (isx) {
            const int c0 = cg * 8; float w[4][8], bias[8];
#pragma unroll
            for (int k = 0; k < 4; ++k) { const f32x4 pv = *(const f32x4*)(a.in[I_CW] + k * CONVD + c0), qv = *(const f32x4*)(a.in[I_CW] + k * CONVD + c0 + 4);
                w[k][0] = pv[0]; w[k][1] = pv[1]; w[k][2] = pv[2]; w[k][3] = pv[3]; w[k][4] = qv[0]; w[k][5] = qv[1]; w[k][6] = qv[2]; w[k][7] = qv[3]; }
            { const f32x4 pv = *(const f32x4*)(a.in[I_CB] + c0), qv = *(const f32x4*)(a.in[I_CB] + c0 + 4); bias[0] = pv[0]; bias[1] = pv[1]; bias[2] = pv[2]; bias[3] = pv[3]; bias[4] = qv[0]; bias[5] = qv[1]; bias[6] = qv[2]; bias[7] = qv[3]; }
            for (int sg = 0; sg < nseg; ++sg) {
                const int rs = r0 + sg * segrows; float x3[8], x2[8], x1[8];
                if (mode == 0 || mode == 1) { const int pr = mode == 0 ? rs - 3 : M_REAL - 3;
                    unpack8(*(const u32x4*)(XBC + (size_t)pr * CONVD + c0), x3); unpack8(*(const u32x4*)(XBC + (size_t)(pr + 1) * CONVD + c0), x2); unpack8(*(const u32x4*)(XBC + (size_t)(pr + 2) * CONVD + c0), x1); }
                else if (mode == 2) { const float* st = a.in[I_SCONV4] + (size_t)((rs - ROW_S0) >> 3) * 3 * CONVD + c0;
#pragma unroll
                    for (int e = 0; e < 8; ++e) { x3[e] = st[e]; x2[e] = st[CONVD + e]; x1[e] = st[2 * CONVD + e]; } }
                else {
#pragma unroll
                    for (int e = 0; e < 8; ++e) { x3[e] = 0.f; x2[e] = 0.f; x1[e] = 0.f; } }
                for (int i0 = 0; i0 < segrows; i0 += 8) { u32x4 ld[8];
#pragma unroll
                    for (int j = 0; j < 8; ++j) ld[j] = *(const u32x4*)(XBC + (size_t)(rs + i0 + j) * CONVD + c0);
#pragma unroll
                    for (int j = 0; j < 8; ++j) { float cur[8], o[8]; unpack8(ld[j], cur);
#pragma unroll
                        for (int e = 0; e < 8; ++e) { const float v = bias[e] + w[0][e] * x3[e] + w[1][e] * x2[e] + w[2][e] * x1[e] + w[3][e] * cur[e]; o[e] = fsilu(v); x3[e] = x2[e]; x2[e] = x1[e]; x1[e] = cur[e]; }
                        *(u32x4*)(XC + (size_t)(rs + i0 + j) * CONVD + c0) = pack8(o); } }
            }
        } else {
            const int j0 = (cg - 768) * 8; float w[3][8];
#pragma unroll
            for (int k = 0; k < 3; ++k) { const f32x4 pv = *(const f32x4*)(a.in[I_SCW] + k * SCW + j0), qv = *(const f32x4*)(a.in[I_SCW] + k * SCW + j0 + 4);
                w[k][0] = pv[0]; w[k][1] = pv[1]; w[k][2] = pv[2]; w[k][3] = pv[3]; w[k][4] = qv[0]; w[k][5] = qv[1]; w[k][6] = qv[2]; w[k][7] = qv[3]; }
            for (int sg = 0; sg < nseg; ++sg) {
                const int rs = r0 + sg * segrows; float u2[8], u1[8];
                if (mode == 0 || mode == 1) { const int pr = mode == 0 ? rs - 2 : M_REAL - 2;
                    unpack8(*(const u32x4*)(U + (size_t)pr * SCW + j0), u2); unpack8(*(const u32x4*)(U + (size_t)(pr + 1) * SCW + j0), u1); }
                else if (mode == 2) { const float* st = a.in[I_SSCONV] + (size_t)((rs - ROW_S0) >> 3) * 2 * SCW + j0;
#pragma unroll
                    for (int e = 0; e < 8; ++e) { u2[e] = st[e]; u1[e] = st[SCW + e]; } }
                else {
#pragma unroll
                    for (int e = 0; e < 8; ++e) { u2[e] = 0.f; u1[e] = 0.f; } }
                for (int i0 = 0; i0 < segrows; i0 += 8) { u32x4 ld[8], lg[8];
#pragma unroll
                    for (int j = 0; j < 8; ++j) { ld[j] = *(const u32x4*)(U + (size_t)(rs + i0 + j) * SCW + j0); lg[j] = *(const u32x4*)(GBp + (size_t)(rs + i0 + j) * SCW + j0); }
#pragma unroll
                    for (int j = 0; j < 8; ++j) { float cur[8], gt[8], o[8]; unpack8(ld[j], cur); unpack8(lg[j], gt);
#pragma unroll
                        for (int e = 0; e < 8; ++e) { const float v = w[0][e] * u2[e] + w[1][e] * u1[e] + w[2][e] * cur[e]; o[e] = gt[e] * v; u2[e] = u1[e]; u1[e] = cur[e]; }
                        *(u32x4*)(A2 + (size_t)(rs + i0 + j) * K2 + DI + j0) = pack8(o); } }
            }
        }
    }
}

constexpr int SL_C = 0, SL_B = 32768, SL_W = 65536, SL_XD = 98304, SL_XE = 114688, SL_H = 131072, SL_SM = 147456;
typedef short s16x4 __attribute__((ext_vector_type(4)));
__device__ __forceinline__ int img_off(int row, int col) { return row * 256 + ((((col >> 3) ^ row) & 15) << 4) + ((col & 7) << 1); }
__device__ __forceinline__ int img_off128(int row, int col) { return row * 128 + ((((col >> 3) ^ row) & 7) << 4) + ((col & 7) << 1); }
__device__ __forceinline__ bf16x8 ldfrag(const LAS unsigned char* img, int r0, int ks, int fr, int fq) { return *(const LAS bf16x8*)(img + (r0 + fr) * 256 + ((((4 * ks + fq) ^ fr) & 15) << 4)); }
__device__ __forceinline__ bf16x8 trfrag256(const LAS unsigned char* img, int c0, int ks, int lane) {
    const int i16 = lane & 15, fq = lane >> 4, q = i16 >> 2, p = i16 & 3, krow = 32 * ks + 8 * fq + q, col = c0 + 4 * p;
    const s16x4 lo = __builtin_amdgcn_ds_read_tr16_b64_v4i16((LAS s16x4*)(img + img_off(krow, col))), hi = __builtin_amdgcn_ds_read_tr16_b64_v4i16((LAS s16x4*)(img + img_off(krow + 4, col)));
    return __builtin_shufflevector(lo, hi, 0, 1, 2, 3, 4, 5, 6, 7);
}
__device__ __forceinline__ bf16x8 trfrag128(const LAS unsigned char* img, int c0, int ks, int lane) {
    const int i16 = lane & 15, fq = lane >> 4, q = i16 >> 2, p = i16 & 3, krow = 32 * ks + 8 * fq + q, col = c0 + 4 * p;
    const s16x4 lo = __builtin_amdgcn_ds_read_tr16_b64_v4i16((LAS s16x4*)(img + img_off128(krow, col))), hi = __builtin_amdgcn_ds_read_tr16_b64_v4i16((LAS s16x4*)(img + img_off128(krow + 4, col)));
    return __builtin_shufflevector(lo, hi, 0, 1, 2, 3, 4, 5, 6, 7);
}
#define MFMA16(a, b, c) __builtin_amdgcn_mfma_f32_16x16x32_bf16((a), (b), (c), 0, 0, 0)
__device__ __forceinline__ void ssd_prompt_item(const Args& a, LAS unsigned char* lds, int b, int head) {
    const int tid = threadIdx.x, lane = tid & 63, w = __builtin_amdgcn_readfirstlane(tid >> 6), g = head >> 3;
    const bf16_t* XC = (const bf16_t*)(a.ws + W_XC); const float* DT = (const float*)(a.ws + W_DT); const bf16_t* ZS = (const bf16_t*)(a.ws + W_ZS);
    bf16_t* YG = (bf16_t*)(a.ws + W_A2); float* SSQ = (float*)(a.ws + W_SSQ);
    LAS unsigned char* Ci = lds + SL_C; LAS unsigned char* Bi = lds + SL_B; LAS unsigned char* Wi = lds + SL_W; LAS unsigned char* XDi = lds + SL_XD; LAS unsigned char* XEi = lds + SL_XE; LAS unsigned char* Hi = lds + SL_H;
    LAS float* acum_s = (LAS float*)(lds + SL_SM); LAS float* dt_s = acum_s + 128; LAS float* ea_s = acum_s + 256; LAS float* ee_s = acum_s + 384;
    const float Ah = -expf(a.in[I_ALOG][head]); const float Dh = a.in[I_DSKIP][head];
    f32x4 st[4];
#pragma unroll
    for (int pt = 0; pt < 4; ++pt) st[pt] = (f32x4){0.f, 0.f, 0.f, 0.f};
    u32x4 pc[4], pb[4], pr[2][4]; float pdt0 = 0.f, pdt1 = 0.f;
    const bf16_t* XBCr = (const bf16_t*)(a.ws + W_XBC);
    float cw[4][8], cbias[8];
    { const int c0 = head * 64 + 8 * (tid & 7);
#pragma unroll
      for (int k = 0; k < 4; ++k) { const f32x4 pv = *(const f32x4*)(a.in[I_CW] + k * CONVD + c0), qv = *(const f32x4*)(a.in[I_CW] + k * CONVD + c0 + 4);
          cw[k][0] = pv[0]; cw[k][1] = pv[1]; cw[k][2] = pv[2]; cw[k][3] = pv[3]; cw[k][4] = qv[0]; cw[k][5] = qv[1]; cw[k][6] = qv[2]; cw[k][7] = qv[3]; }
      const f32x4 pv = *(const f32x4*)(a.in[I_CB] + c0), qv = *(const f32x4*)(a.in[I_CB] + c0 + 4);
      cbias[0] = pv[0]; cbias[1] = pv[1]; cbias[2] = pv[2]; cbias[3] = pv[3]; cbias[4] = qv[0]; cbias[5] = qv[1]; cbias[6] = qv[2]; cbias[7] = qv[3]; }
    auto rowg = [&](int c, int i) -> int { return c == 0 ? ROW_M0 + i : b * 2048 + (c - 1) * 128 + i; };
    auto prefetch = [&](int c, int t) {
        const int valid = c == 0 ? META : 128;
#pragma unroll
        for (int k = 0; k < 4; ++k) { const int q = t + 512 * k, row = q >> 4, ch = q & 15;
            if (row < valid) { const bf16_t* base = XC + (size_t)rowg(c, row) * CONVD + g * 128 + ch * 8; pb[k] = *(const u32x4*)(base + DI); pc[k] = *(const u32x4*)(base + DI + 1024); }
            else { pb[k] = (u32x4){0u, 0u, 0u, 0u}; pc[k] = (u32x4){0u, 0u, 0u, 0u}; } }
#pragma unroll
        for (int k = 0; k < 2; ++k) { const int q = t + 512 * k, row = q >> 3, ch = q & 7;
            if (c == 0) { pr[k][0] = row < valid ? *(const u32x4*)(XC + (size_t)rowg(0, row) * CONVD + head * 64 + ch * 8) : (u32x4){0u, 0u, 0u, 0u}; }
            else {
#pragma unroll
                for (int d = 0; d < 4; ++d) { const int t = (c - 1) * 128 + row - d;
                    pr[k][d] = *(const u32x4*)(XBCr + (size_t)(t >= 0 ? b * 2048 + t : ROW_M0 + 16 + t) * CONVD + head * 64 + ch * 8); } } }
        if (w == 0) { const int r0 = 2 * (t & 63); pdt0 = r0 < valid ? DT[(size_t)rowg(c, r0) * 64 + head] : 0.f; pdt1 = r0 + 1 < valid ? DT[(size_t)rowg(c, r0 + 1) * 64 + head] : 0.f; }
    };
    prefetch(0, tid);
    for (int c = 0; c < 17; ++c) {
        int tq = tid; asm volatile("" : "+v"(tq));
        const int lq = tq & 63, fr = lq & 15, fq = lq >> 4;
        LDS_BARRIER();
        if (w == 0) {
            const float l0 = pdt0 * Ah, l1 = pdt1 * Ah; float sc = l0 + l1;
#pragma unroll
            for (int o = 1; o < 64; o <<= 1) { const float t = __shfl_up(sc, o); if (lane >= o) sc += t; }
            const float a1 = sc, a0 = sc - l1, alast = __shfl(sc, 63);
            acum_s[2 * lane] = a0; acum_s[2 * lane + 1] = a1; dt_s[2 * lane] = pdt0; dt_s[2 * lane + 1] = pdt1;
            ea_s[2 * lane] = __expf(a0); ea_s[2 * lane + 1] = __expf(a1); ee_s[2 * lane] = __expf(alast - a0); ee_s[2 * lane + 1] = __expf(alast - a1);
        }
#pragma unroll
        for (int k = 0; k < 4; ++k) { const int q = tq + 512 * k, row = q >> 4, ch = q & 15; const int o = row * 256 + (((ch ^ row) & 15) << 4);
            *(LAS u32x4*)(Ci + o) = pc[k]; *(LAS u32x4*)(Bi + o) = pb[k]; }
#pragma unroll
        for (int pt = 0; pt < 4; ++pt) { u32x2 hv; hv.x = cvt_pk_bf16(st[pt][0], st[pt][1]); hv.y = cvt_pk_bf16(st[pt][2], st[pt][3]); *(LAS u32x2*)(Hi + img_off(16 * pt + fr, 16 * w + 4 * fq)) = hv; }
        LDS_BARRIER();
#pragma unroll
        for (int k = 0; k < 2; ++k) { const int q = tq + 512 * k, row = q >> 3, ch = q & 7; float f[8], fd[8], fe[8]; const float dtj = dt_s[row], ej = ee_s[row] * dtj;
            if (c == 0) unpack8(pr[k][0], f);
            else { float x0[8], x1[8], x2[8], x3[8]; unpack8(pr[k][0], x0); unpack8(pr[k][1], x1); unpack8(pr[k][2], x2); unpack8(pr[k][3], x3);
#pragma unroll
                for (int e = 0; e < 8; ++e) f[e] = fsilu(cbias[e] + cw[0][e] * x3[e] + cw[1][e] * x2[e] + cw[2][e] * x1[e] + cw[3][e] * x0[e]); }
#pragma unroll
            for (int e = 0; e < 8; ++e) { fd[e] = f[e] * dtj; fe[e] = f[e] * ej; }
            const int o = row * 128 + (((ch ^ row) & 7) << 4);
            *(LAS u32x4*)(XDi + o) = pack8(fd); *(LAS u32x4*)(XEi + o) = pack8(fe); }
        LDS_BARRIER();
        if (c + 1 < 17) prefetch(c + 1, tq);
        const float dA = ea_s[127];
#pragma unroll
        for (int pt = 0; pt < 4; ++pt) st[pt] = st[pt] * dA;
#pragma unroll
        for (int kh = 0; kh < 2; ++kh) { bf16x8 bt[2], xe[2][4];
#pragma unroll
            for (int k2 = 0; k2 < 2; ++k2) { bt[k2] = trfrag256(Bi, 16 * w, 2 * kh + k2, lq);
#pragma unroll
                for (int pt = 0; pt < 4; ++pt) xe[k2][pt] = trfrag128(XEi, 16 * pt, 2 * kh + k2, lq); }
            __builtin_amdgcn_sched_barrier(0); LDS_WAIT(); __builtin_amdgcn_sched_barrier(0);
#pragma unroll
            for (int k2 = 0; k2 < 2; ++k2)
#pragma unroll
                for (int pt = 0; pt < 4; ++pt) st[pt] = MFMA16(bt[k2], xe[k2][pt], st[pt]);
            __builtin_amdgcn_sched_barrier(0); }
        if (c >= 1) {
        bf16x8 ca[4];
#pragma unroll
        for (int ks = 0; ks < 4; ++ks) ca[ks] = ldfrag(Ci, 16 * w, ks, fr, fq);
        const int irow = 16 * w + fr; const float aci = acum_s[irow];
#pragma unroll
        for (int j2 = 0; j2 < 4; ++j2) if (j2 <= (w >> 1)) { bf16x8 bf[2][4]; f32x4 acj[2];
#pragma unroll
            for (int h = 0; h < 2; ++h) {
#pragma unroll
                for (int ks = 0; ks < 4; ++ks) bf[h][ks] = ldfrag(Bi, 16 * (2 * j2 + h), ks, fr, fq);
                acj[h] = *(const LAS f32x4*)(acum_s + 16 * (2 * j2 + h) + 4 * fq); }
            __builtin_amdgcn_sched_barrier(0); LDS_WAIT(); __builtin_amdgcn_sched_barrier(0);
#pragma unroll
            for (int h = 0; h < 2; ++h) { const int jt = 2 * j2 + h; f32x4 G = (f32x4){0.f, 0.f, 0.f, 0.f};
#pragma unroll
                for (int ks = 0; ks < 4; ++ks) G = MFMA16(bf[h][ks], ca[ks], G);
                const int j0 = 16 * jt + 4 * fq; float wv[4];
#pragma unroll
                for (int r = 0; r < 4; ++r) wv[r] = (j0 + r <= irow) ? G[r] * __expf(aci - acj[h][r]) : 0.f;
                u32x2 o; o.x = cvt_pk_bf16(wv[0], wv[1]); o.y = cvt_pk_bf16(wv[2], wv[3]); *(LAS u32x2*)(Wi + img_off(irow, j0)) = o; }
            __builtin_amdgcn_sched_barrier(0); }
        u32x2 xo[4], zo[4]; const int rg = rowg(c, irow);
        {
#pragma unroll
            for (int pt = 0; pt < 4; ++pt) zo[pt] = *(const u32x2*)(ZS + (size_t)rg * DI + head * 64 + 16 * pt + 4 * fq); }
        f32x4 y[4];
#pragma unroll
        for (int pt = 0; pt < 4; ++pt) y[pt] = (f32x4){0.f, 0.f, 0.f, 0.f};
#pragma unroll
        for (int kh = 0; kh < 2; ++kh) { bf16x8 hb[2][4];
#pragma unroll
            for (int k2 = 0; k2 < 2; ++k2)
#pragma unroll
                for (int pt = 0; pt < 4; ++pt) hb[k2][pt] = ldfrag(Hi, 16 * pt, 2 * kh + k2, fr, fq);
            __builtin_amdgcn_sched_barrier(0); LDS_WAIT(); __builtin_amdgcn_sched_barrier(0);
#pragma unroll
            for (int k2 = 0; k2 < 2; ++k2)
#pragma unroll
                for (int pt = 0; pt < 4; ++pt) y[pt] = MFMA16(hb[k2][pt], ca[2 * kh + k2], y[pt]);
            __builtin_amdgcn_sched_barrier(0); }
        const float eai = ea_s[irow];
#pragma unroll
        for (int pt = 0; pt < 4; ++pt) y[pt] = y[pt] * eai;
        LDS_WAIT();
#pragma unroll
        for (int kh = 0; kh < 2; ++kh) if (2 * kh <= (w >> 1)) { bf16x8 wa[2], xb[2][4];
#pragma unroll
            for (int k2 = 0; k2 < 2; ++k2) { wa[k2] = ldfrag(Wi, 16 * w, 2 * kh + k2, fr, fq);
#pragma unroll
                for (int pt = 0; pt < 4; ++pt) xb[k2][pt] = trfrag128(XDi, 16 * pt, 2 * kh + k2, lq); }
            __builtin_amdgcn_sched_barrier(0); LDS_WAIT(); __builtin_amdgcn_sched_barrier(0);
#pragma unroll
            for (int k2 = 0; k2 < 2; ++k2) if (2 * kh + k2 <= (w >> 1))
#pragma unroll
                for (int pt = 0; pt < 4; ++pt) y[pt] = MFMA16(xb[k2][pt], wa[k2], y[pt]);
            __builtin_amdgcn_sched_barrier(0); }
        { float ssq = 0.f; const float dti = dt_s[irow], rdt = dti > 0.f ? 1.0f / dti : 0.f;
#pragma unroll
            for (int pt = 0; pt < 4; ++pt) xo[pt] = *(const LAS u32x2*)(XDi + irow * 128 + ((((2 * pt + (fq >> 1)) ^ irow) & 7) << 4) + ((fq & 1) << 3));
#pragma unroll
            for (int pt = 0; pt < 4; ++pt) { const float x4[4] = {bf_lo(xo[pt].x) * rdt, bf_hi(xo[pt].x) * rdt, bf_lo(xo[pt].y) * rdt, bf_hi(xo[pt].y) * rdt}, z4[4] = {bf_lo(zo[pt].x), bf_hi(zo[pt].x), bf_lo(zo[pt].y), bf_hi(zo[pt].y)}; float gv[4];
#pragma unroll
                for (int r = 0; r < 4; ++r) { gv[r] = (y[pt][r] + Dh * x4[r]) * z4[r]; ssq += gv[r] * gv[r]; }
                u32x2 o; o.x = cvt_pk_bf16(gv[0], gv[1]); o.y = cvt_pk_bf16(gv[2], gv[3]); *(u32x2*)(YG + (size_t)rg * K2 + head * 64 + 16 * pt + 4 * fq) = o; }
            ssq += __shfl_xor(ssq, 16); ssq += __shfl_xor(ssq, 32);
            if (fq == 0) SSQ[(size_t)rg * 64 + head] = ssq; }
        }
    }
    { const int fr = lane & 15, fq = lane >> 4; float* so = a.out + O_NSSMP + (size_t)(b * NH + head) * HP * NS;
#pragma unroll
    for (int pt = 0; pt < 4; ++pt) *(f32x4*)(so + (size_t)(16 * pt + fr) * NS + 16 * w + 4 * fq) = st[pt]; }
}

__device__ __forceinline__ void phase_ssd_sample(const Args& a, LAS unsigned char* lds, int G) {
    const int tid = threadIdx.x, u = tid >> 8, tt = tid & 255, pq = tt >> 3, nq = tid & 7, p0 = 2 * pq;
    const bf16_t* XC = (const bf16_t*)(a.ws + W_XC); const float* DT = (const float*)(a.ws + W_DT); bf16_t* Y = (bf16_t*)(a.ws + W_A2);
    const bf16_t* ZSp = (const bf16_t*)(a.ws + W_ZS); float* SSQp = (float*)(a.ws + W_SSQ);
    constexpr int BCR = 160;
    constexpr int BUF = 8 * 64 + 2 * 8 * BCR + 16 + 8 * 64;
    const int nit = (DECB * NH - (int)blockIdx.x + G - 1) / G;
    const float dsk_l = a.in[I_DSKIP][tid & 63], al_l = a.in[I_ALOG][tid & 63];
    const int pcA = tid, pcB = 512 + (tid & 127);
    f32x4 hs[8]; u32x4 pfA, pfB; float pdt; unsigned pzz;
    auto item_of = [&](int kk) -> int { return blockIdx.x + (kk < nit ? kk : nit - 1) * G; };
    auto piece_ptr = [&](int k, int pc) -> const bf16_t* { const int it = item_of(k + pc / 320), seq = it >> 6, head = it & 63, g = head >> 3, r = pc % 320, pi = r / 40, pq40 = r % 40;
        const int col = pq40 < 8 ? head * 64 + pq40 * 8 : (pq40 < 24 ? DI + g * 128 + (pq40 - 8) * 8 : DI + 1024 + g * 128 + (pq40 - 24) * 8); return XC + (size_t)(ROW_S0 + seq * 8 + pi) * CONVD + col; };
    auto issue = [&](int k) { const int it = item_of(k + u), seq = it >> 6, head = it & 63;
        const float* s0 = a.in[I_SSM] + ((size_t)it * HP + p0) * NS + nq * 16;
#pragma unroll
        for (int j = 0; j < 4; ++j) { hs[j] = *(const f32x4*)(s0 + 4 * j); hs[4 + j] = *(const f32x4*)(s0 + NS + 4 * j); }
        pfA = *(const u32x4*)piece_ptr(k, pcA); pfB = *(const u32x4*)piece_ptr(k, pcB);
        pdt = DT[(size_t)(ROW_S0 + seq * 8 + (tid & 7)) * 64 + head];
        pzz = *(const unsigned*)(ZSp + (size_t)(ROW_S0 + seq * 8 + ((tt >> 5) & 7)) * DI + head * 64 + (tt & 31) * 2); };
    auto stash = [&](int pc, const u32x4 v) { const int uu = pc / 320, r = pc % 320, pi = r / 40, q = r % 40; float f[8]; unpack8(v, f);
        LAS float* xs = (LAS float*)lds + uu * BUF; const int hb = q < 24 ? q - 8 : q - 24;
        LAS float* dst = q < 8 ? xs + pi * 64 + q * 8 : (q < 24 ? xs + 512 + pi * BCR + (hb >> 1) * 20 + (hb & 1) * 8 : xs + 512 + 8 * BCR + pi * BCR + (hb >> 1) * 20 + (hb & 1) * 8);
        *(LAS f32x4*)dst = (f32x4){f[0], f[1], f[2], f[3]}; *(LAS f32x4*)(dst + 4) = (f32x4){f[4], f[5], f[6], f[7]}; };
    issue(0);
    for (int k = 0; k < nit; k += 2) {
        const int it = item_of(k + u), seq = it >> 6, head = it & 63; const bool live = k + u < nit;
        LAS float* xs = (LAS float*)lds + u * BUF; LAS float* Bs = xs + 512; LAS float* Cs = Bs + 8 * BCR; LAS float* dts = Cs + 8 * BCR; LAS float* das = dts + 8; LAS float* ys = das + 8;
        f32x2 h2[2][8];
#pragma unroll
        for (int r = 0; r < 2; ++r)
#pragma unroll
            for (int j = 0; j < 4; ++j) { h2[r][2 * j] = (f32x2){hs[4 * r + j][0], hs[4 * r + j][1]}; h2[r][2 * j + 1] = (f32x2){hs[4 * r + j][2], hs[4 * r + j][3]}; }
        stash(pcA, pfA); if (tid < 128) stash(pcB, pfB);
        const float Dh = __shfl(dsk_l, head), alh = __shfl(al_l, head); const unsigned zz = pzz;
        if ((tid & 255) < 8) { dts[tid & 7] = pdt; das[tid & 7] = __expf(-pdt * __expf(alh)); }
        LDS_BARRIER();
        issue(k + 2);
        float ya[2][8];
#pragma unroll
        for (int i = 0; i < 8; ++i) {
            const f32x2 xv = *(const LAS f32x2*)(xs + i * 64 + p0); const float dtv = dts[i], av = das[i]; const float xd0 = xv[0] * dtv, xd1 = xv[1] * dtv; f32x2 y0 = (f32x2){0.f, 0.f}, y1 = y0;
#pragma unroll
            for (int j = 0; j < 4; ++j) { const f32x4 bb = *(const LAS f32x4*)(Bs + i * BCR + nq * 20 + 4 * j), cc = *(const LAS f32x4*)(Cs + i * BCR + nq * 20 + 4 * j);
                const f32x2 bl = (f32x2){bb[0], bb[1]}, bh = (f32x2){bb[2], bb[3]}, cl = (f32x2){cc[0], cc[1]}, ch = (f32x2){cc[2], cc[3]};
                h2[0][2 * j] = h2[0][2 * j] * av + bl * xd0; h2[0][2 * j + 1] = h2[0][2 * j + 1] * av + bh * xd0; y0 = y0 + cl * h2[0][2 * j]; y0 = y0 + ch * h2[0][2 * j + 1];
                h2[1][2 * j] = h2[1][2 * j] * av + bl * xd1; h2[1][2 * j + 1] = h2[1][2 * j + 1] * av + bh * xd1; y1 = y1 + cl * h2[1][2 * j]; y1 = y1 + ch * h2[1][2 * j + 1]; }
            ya[0][i] = y0[0] + y0[1]; ya[1][i] = y1[0] + y1[1];
        }
#pragma unroll
        for (int r = 0; r < 2; ++r) { float t4[4], t2[2], t1;
#pragma unroll
            for (int i = 0; i < 4; ++i) { const float keep = (nq & 4) ? ya[r][i + 4] : ya[r][i], send = (nq & 4) ? ya[r][i] : ya[r][i + 4]; t4[i] = keep + __shfl_xor(send, 4); }
#pragma unroll
            for (int i = 0; i < 2; ++i) { const float keep = (nq & 2) ? t4[i + 2] : t4[i], send = (nq & 2) ? t4[i] : t4[i + 2]; t2[i] = keep + __shfl_xor(send, 2); }
            { const float keep = (nq & 1) ? t2[1] : t2[0], send = (nq & 1) ? t2[0] : t2[1]; t1 = keep + __shfl_xor(send, 1); }
            ys[nq * 64 + p0 + r] = t1 + Dh * xs[nq * 64 + p0 + r]; }
        if (live) { float* so = a.out + O_NSSMS + ((size_t)it * HP + p0) * NS + nq * 16;
#pragma unroll
            for (int r = 0; r < 2; ++r)
#pragma unroll
                for (int j = 0; j < 4; ++j) *(f32x4*)(so + r * NS + 4 * j) = (f32x4){h2[r][2 * j][0], h2[r][2 * j][1], h2[r][2 * j + 1][0], h2[r][2 * j + 1][1]}; }
        LDS_BARRIER();
        if (live) { const int i = tt >> 5, pp = (tt & 31) * 2; const size_t ro = (size_t)(ROW_S0 + seq * 8 + i);
            const float g0 = ys[i * 64 + pp] * bf_lo(zz), g1 = ys[i * 64 + pp + 1] * bf_hi(zz); float sq = g0 * g0 + g1 * g1;
            *(unsigned*)(Y + ro * K2 + head * 64 + pp) = cvt_pk_bf16(g0, g1);
            sq += __shfl_xor(sq, 1); sq += __shfl_xor(sq, 2); sq += __shfl_xor(sq, 4); sq += __shfl_xor(sq, 8); sq += __shfl_xor(sq, 16);
            if ((tt & 31) == 0) SSQp[ro * 64 + head] = sq; }
        LDS_BARRIER();
    }
}
__device__ __forceinline__ void phase_ssd(const Args& a, LAS unsigned char* lds, int G) {
    for (int it = blockIdx.x; it < NB * NH; it += G) { const int v = (G == 256) ? (it & 7) * 32 + (it >> 3) : it; ssd_prompt_item(a, lds, v >> 6, v & 63); }
    __syncthreads();
    phase_ssd_sample(a, lds, G);
}

struct SmallAcc { f32x4 v[2][2]; };
template <class Off, class Hook, class Pre>
__device__ __forceinline__ void small_gemm_kloop(LAS unsigned char* lds, const bf16_t* A, const bf16_t* Bt, int ld, int nks, SmallAcc& acc, Off koff, Hook hook, Pre pre) {
    const int tid = threadIdx.x, lane = tid & 63, w = __builtin_amdgcn_readfirstlane(tid >> 6), wm = w >> 1, wn = w & 1, fr = lane & 15, fq = lane >> 4;
    constexpr int ABYTES = 128 * 256, BUFB = ABYTES + 64 * 256;
    const int lr = lane >> 4, lc = (lane & 15) ^ ((4 * w + lr) & 15);
    const bf16_t* ga = A + (size_t)(4 * w + lr) * ld + lc * 8; const bf16_t* gb = Bt + (size_t)(4 * w + lr) * ld + lc * 8; const size_t r32 = (size_t)32 * ld;
    const unsigned lw = (unsigned)w * 1024u;
#define SG_ISSUE(kt, bufi) do { const int _kt = (kt) < nks ? (kt) : nks - 1; LAS unsigned char* _b = lds + (bufi) * BUFB + lw; const int _ko = koff(_kt); \
        _Pragma("unroll") for (int _i = 0; _i < 4; ++_i) __builtin_amdgcn_global_load_lds((const unsigned*)(ga + _i * r32 + _ko), (LAS unsigned*)(_b + _i * 8192), 16, 0, 0); \
        _Pragma("unroll") for (int _i = 0; _i < 2; ++_i) __builtin_amdgcn_global_load_lds((const unsigned*)(gb + _i * r32 + _ko), (LAS unsigned*)(_b + ABYTES + _i * 8192), 16, 0, 0); } while (0)
    SG_ISSUE(0, 0); SG_ISSUE(1, 1);
    pre();
    int bi = 0;
    for (int k = 0; k < nks; ++k) {
        asm volatile("s_waitcnt vmcnt(6)" ::: "memory");
        __builtin_amdgcn_s_barrier();
        asm volatile("" ::: "memory");
        const int bn = bi == 0 ? 2 : bi - 1;
        SG_ISSUE(k + 2, bn);
        const LAS unsigned char* cur = lds + bi * BUFB;
        bf16x8 af[2][2][2], bfm[2][2][2];
#pragma unroll
        for (int hk = 0; hk < 2; ++hk) {
#pragma unroll
            for (int ks = 0; ks < 2; ++ks)
#pragma unroll
                for (int i = 0; i < 2; ++i) { const int ra = 32 * wm + 16 * i + fr, rbw = 32 * wn + 16 * i + fr, ch = 8 * hk + 4 * ks + fq;
                    af[hk][ks][i] = *(const LAS bf16x8*)(cur + ra * 256 + (((ch ^ ra) & 15) << 4)); bfm[hk][ks][i] = *(const LAS bf16x8*)(cur + ABYTES + rbw * 256 + (((ch ^ rbw) & 15) << 4)); }
            __builtin_amdgcn_sched_barrier(0);
        }
        asm volatile("s_waitcnt lgkmcnt(8)" ::: "memory");
        __builtin_amdgcn_sched_barrier(0);
#pragma unroll
        for (int ks = 0; ks < 2; ++ks)
#pragma unroll
            for (int mb = 0; mb < 2; ++mb)
#pragma unroll
                for (int nb = 0; nb < 2; ++nb) acc.v[mb][nb] = __builtin_amdgcn_mfma_f32_16x16x32_bf16(bfm[0][ks][nb], af[0][ks][mb], acc.v[mb][nb], 0, 0, 0);
        __builtin_amdgcn_sched_barrier(0);
        asm volatile("s_waitcnt lgkmcnt(0)" ::: "memory");
        __builtin_amdgcn_sched_barrier(0);
#pragma unroll
        for (int ks = 0; ks < 2; ++ks)
#pragma unroll
            for (int mb = 0; mb < 2; ++mb)
#pragma unroll
                for (int nb = 0; nb < 2; ++nb) acc.v[mb][nb] = __builtin_amdgcn_mfma_f32_16x16x32_bf16(bfm[1][ks][nb], af[1][ks][mb], acc.v[mb][nb], 0, 0, 0);
        hook(k, acc);
        bi = bi == 2 ? 0 : bi + 1;
    }
    asm volatile("s_waitcnt vmcnt(0)" ::: "memory");
    __builtin_amdgcn_s_barrier();
    asm volatile("" ::: "memory");
#undef SG_ISSUE
}
__device__ __forceinline__ void small_gemm2_tile(const Args& a, LAS unsigned char* lds, int tm, int tn) {
    const int tid = threadIdx.x, lane = tid & 63, w = __builtin_amdgcn_readfirstlane(tid >> 6), wm = w >> 1, wn = w & 1, fr = lane & 15, fq = lane >> 4;
    const bf16_t* A2 = (const bf16_t*)(a.ws + W_A2) + (size_t)(ROW_S0 + 128 * tm) * K2; const bf16_t* WT2 = (const bf16_t*)(a.ws + W_WT2) + (size_t)(64 * tn) * K2;
    const bf16_t* SGA = (const bf16_t*)(a.ws + W_SGA); const bf16_t* SGR = (const bf16_t*)(a.ws + W_SGR); bf16_t* MG = (bf16_t*)(a.ws + W_MERGED); const float* SSQ = (const float*)(a.ws + W_SSQ);
    float rs[2][8];
    u32x2 rr[2][2];
    SmallAcc acc;
#pragma unroll
    for (int mb = 0; mb < 2; ++mb)
#pragma unroll
        for (int nb = 0; nb < 2; ++nb) acc.v[mb][nb] = (f32x4){0.f, 0.f, 0.f, 0.f};
    small_gemm_kloop(lds, A2, WT2, K2, 48, acc,
        [](int k) { return k < 16 ? DI + 128 * k : 128 * (k - 16); },
        [&](int k, SmallAcc& ac) {
            if (k == 15) {
#pragma unroll
                for (int mb = 0; mb < 2; ++mb) { const float t0 = 1.0f / rs[mb][0];
#pragma unroll
                    for (int nb = 0; nb < 2; ++nb) { f32x4& v = ac.v[mb][nb]; const u32x2 r = rr[mb][nb]; v = (f32x4){v[0] * bf_lo(r.x) * t0, v[1] * bf_hi(r.x) * t0, v[2] * bf_lo(r.y) * t0, v[3] * bf_hi(r.y) * t0}; } } }
            else if (k >= 19 && k < 47 && ((k - 19) & 3) == 0) { const int g = (k - 19) >> 2;
#pragma unroll
                for (int mb = 0; mb < 2; ++mb) { float tf = 0.f;
#pragma unroll
                    for (int gg = 0; gg < 7; ++gg) tf = (g == gg) ? rs[mb][gg] / rs[mb][gg + 1] : tf;
#pragma unroll
                    for (int nb = 0; nb < 2; ++nb) ac.v[mb][nb] = ac.v[mb][nb] * tf; } } },
        [&]() {
#pragma unroll
    for (int mb = 0; mb < 2; ++mb) { const float* sp = SSQ + (size_t)(ROW_S0 + 128 * tm + 32 * wm + 16 * mb + fr) * 64;
#pragma unroll
        for (int g = 0; g < 8; ++g) { const f32x4 q0 = *(const f32x4*)(sp + 8 * g), q1 = *(const f32x4*)(sp + 8 * g + 4); const float sm = ((q0[0] + q0[1]) + (q0[2] + q0[3])) + ((q1[0] + q1[1]) + (q1[2] + q1[3])); rs[mb][g] = 1.0f / sqrtf(sm * (1.0f / 512.0f) + EPS); } }
#pragma unroll
    for (int mb = 0; mb < 2; ++mb)
#pragma unroll
        for (int nb = 0; nb < 2; ++nb) rr[mb][nb] = *(const u32x2*)(SGR + (size_t)(ROW_S0 + 128 * tm + 32 * wm + 16 * mb + fr) * D + 64 * tn + 32 * wn + 16 * nb + 4 * fq);
#pragma unroll
        for (int mb = 0; mb < 2; ++mb)
#pragma unroll
            for (int nb = 0; nb < 2; ++nb) asm volatile("" : "+v"(rr[mb][nb].x), "+v"(rr[mb][nb].y));
        });
#pragma unroll
    for (int mb = 0; mb < 2; ++mb)
#pragma unroll
        for (int nb = 0; nb < 2; ++nb) { const size_t off = (size_t)(ROW_S0 + 128 * tm + 32 * wm + 16 * mb + fr) * D + 64 * tn + 32 * wn + 16 * nb + 4 * fq; const u32x2 g = *(const u32x2*)(SGA + off); const float t8 = rs[mb][7];
            const f32x4 v = acc.v[mb][nb]; u32x2 o; o.x = cvt_pk_bf16(v[0] * bf_lo(g.x) * t8, v[1] * bf_hi(g.x) * t8); o.y = cvt_pk_bf16(v[2] * bf_lo(g.y) * t8, v[3] * bf_hi(g.y) * t8); *(u32x2*)(MG + off) = o; }
}
__device__ __forceinline__ void small_gemm3_tile(const Args& a, LAS unsigned char* lds, int tm, int tn) {
    const int tid = threadIdx.x, lane = tid & 63, w = __builtin_amdgcn_readfirstlane(tid >> 6), wm = w >> 1, wn = w & 1, fr = lane & 15, fq = lane >> 4;
    const bf16_t* MG = (const bf16_t*)(a.ws + W_MERGED) + (size_t)(ROW_S0 + 128 * tm) * D; const bf16_t* WT3 = (const bf16_t*)(a.ws + W_WT3) + (size_t)(64 * tn) * D;
    float* PS2 = (float*)(a.ws + W_PS2); unsigned* cnt = (unsigned*)(a.ws + W_CTL + CTL_PANEL2) + 64 * tm;
    LDS_BARRIER();
    SmallAcc acc;
#pragma unroll
    for (int mb = 0; mb < 2; ++mb)
#pragma unroll
        for (int nb = 0; nb < 2; ++nb) acc.v[mb][nb] = (f32x4){0.f, 0.f, 0.f, 0.f};
    f32x4 xv[2][2], fw[2];
#pragma unroll
    for (int mb = 0; mb < 2; ++mb)
#pragma unroll
        for (int nb = 0; nb < 2; ++nb) xv[mb][nb] = *(const f32x4*)(a.in[I_XS] + (size_t)(128 * tm + 32 * wm + 16 * mb + fr) * D + 64 * tn + 32 * wn + 16 * nb + 4 * fq);
#pragma unroll
    for (int nb = 0; nb < 2; ++nb) fw[nb] = *(const f32x4*)(a.in[I_FNW] + 64 * tn + 32 * wn + 16 * nb + 4 * fq);
    small_gemm_kloop(lds, MG, WT3, D, D / 128, acc, [](int k) { return 128 * k; }, [](int, SmallAcc&) {}, []() {});
    LAS float* P = (LAS float*)lds;
    LAS float* Sc = P + 256;
#pragma unroll
    for (int mb = 0; mb < 2; ++mb) { const int rl = 32 * wm + 16 * mb + fr; float sq = 0.f;
#pragma unroll
        for (int nb = 0; nb < 2; ++nb) { f32x4& v = acc.v[mb][nb]; v = v + xv[mb][nb]; sq += (v[0] * v[0] + v[1] * v[1]) + (v[2] * v[2] + v[3] * v[3]); }
        sq += __shfl_xor(sq, 16); sq += __shfl_xor(sq, 32);
        if (fq == 0) P[rl * 2 + wn] = sq; }
    LDS_BARRIER();
    if (tid < 128) __hip_atomic_store(PS2 + (size_t)(128 * tm + tid) * 32 + tn, P[tid * 2] + P[tid * 2 + 1], __ATOMIC_RELAXED, __HIP_MEMORY_SCOPE_AGENT);
    asm volatile("s_waitcnt vmcnt(0)" ::: "memory");
    if (tid < 128 && (tid & 63) == 0) __hip_atomic_fetch_add(cnt, 1u, __ATOMIC_RELAXED, __HIP_MEMORY_SCOPE_AGENT);
    if (w == 0) { unsigned spins = 0;
        while ((unsigned)__builtin_amdgcn_readfirstlane(__hip_atomic_load(cnt, __ATOMIC_RELAXED, __HIP_MEMORY_SCOPE_AGENT)) < 64u) { __builtin_amdgcn_s_sleep(2); if (++spins > (1u << 22)) break; }
        __builtin_amdgcn_fence(__ATOMIC_ACQUIRE, "agent");
        asm volatile("s_waitcnt vmcnt(0)" ::: "memory"); }
    LDS_BARRIER();
    if (tid < 128) { const float* pp = PS2 + (size_t)(128 * tm + tid) * 32; float sm = 0.f;
#pragma unroll
        for (int t = 0; t < 32; ++t) sm += __hip_atomic_load(pp + t, __ATOMIC_RELAXED, __HIP_MEMORY_SCOPE_AGENT);
        Sc[tid] = 1.0f / sqrtf(sm * (1.0f / D) + EPS); }
    LDS_BARRIER();
#pragma unroll
    for (int mb = 0; mb < 2; ++mb) { const int rl = 32 * wm + 16 * mb + fr; const float rs = Sc[rl];
#pragma unroll
        for (int nb = 0; nb < 2; ++nb) { const int col = 64 * tn + 32 * wn + 16 * nb + 4 * fq;
            *(f32x4*)(a.out + O_YS + (size_t)(128 * tm + rl) * D + col) = acc.v[mb][nb] * rs * fw[nb]; } }
    LDS_BARRIER();
}

constexpr int N_PHASES = 6;
__global__ void __launch_bounds__(512, 2) fwd_kernel(Args a) {
    extern __shared__ __attribute__((aligned(16))) unsigned char lds_raw[];
    LAS unsigned char* lds = (LAS unsigned char*)lds_raw;
    const int G = gridDim.x; const int lo = a.ph_lo, hi = a.ph_hi;
#define IN(k) (lo <= (k) && (k) < hi)
    volatile LAS unsigned* misc = (volatile LAS unsigned*)(lds + LDS_MISC);
    if (threadIdx.x < 16) misc[threadIdx.x] = 0u;
    __syncthreads();
    XcdBarrier bar; bar.bar = (unsigned*)(a.ws + W_CTL); bar.x = 0; bar.st = misc;
    if (hi - lo > 1) bar = xcd_barrier_post((unsigned*)(a.ws + W_CTL), misc);
#define SEAM(k) do { if (IN(k) && IN((k) + 1)) xcd_barrier(bar); } while (0)
    if (IN(0)) phase_prep(a, lds, G);
    SEAM(0);
    if (IN(1)) {
        if (G == 256) { const int x = blockIdx.x & 7, j = blockIdx.x >> 3, wv = __builtin_amdgcn_readfirstlane(threadIdx.x >> 6); constexpr int PX = PREP_I23 / 8;
            const int off = (PX * (j * (j - 1) / 2)) / 496, nj = (PX * (j * (j + 1) / 2)) / 496 - off;
            transpose_range(a, lds, PREP_I1 + x * PX + off + wv, 8, PREP_I1 + x * PX + off + nj); }
        else if ((G & 7) == 0) { const int x = blockIdx.x & 7, wpx = (G >> 3) * 8, wi = (blockIdx.x >> 3) * 8 + __builtin_amdgcn_readfirstlane(threadIdx.x >> 6);
            const int off = (PREP_I23 * (x * (x - 1) / 2)) / 28, nx = (PREP_I23 * (x * (x + 1) / 2)) / 28 - off;
            transpose_range(a, lds, PREP_I1 + off + wi, wpx, PREP_I1 + off + nx); }
        else transpose_range(a, lds, PREP_I1 + blockIdx.x * 8 + __builtin_amdgcn_readfirstlane(threadIdx.x >> 6), G * 8, PREP_I1 + PREP_I23);
        asm volatile("s_waitcnt vmcnt(0)" ::: "memory"); __syncthreads();
        pg8::Gemm g{(const bf16_t*)(a.ws + W_H), (const bf16_t*)(a.ws + W_WT1), D, 0, D / 64, 0, 0}; pg8::StaticOrder S; S.init(MP, NP1, G, (int)blockIdx.x);
        Epi1 E{(bf16_t*)(a.ws + W_ZS), (bf16_t*)(a.ws + W_XBC), (bf16_t*)(a.ws + W_U), (bf16_t*)(a.ws + W_GB), (bf16_t*)(a.ws + W_SGA), (bf16_t*)(a.ws + W_SGR), (float*)(a.ws + W_DT), a.in[I_DTB], a.out};
        pg8::gemm_phase<Epi1, pg8::StaticOrder, true, true>(lds, g, S, E);
    }
    SEAM(1);
    if (IN(2)) phase_conv(a, G);
    SEAM(2);
    if (IN(3)) phase_ssd(a, lds, G);
    SEAM(3);
    if (IN(4)) {
        pg8::Gemm g{(const bf16_t*)(a.ws + W_A2), (const bf16_t*)(a.ws + W_WT2), K2, DI, D / 64, 512, 8}; pg8::SegOrder<9> S; S.init(ROW_S0, D, G, (int)blockIdx.x);
        Epi2 E{(const bf16_t*)(a.ws + W_SGA), (const bf16_t*)(a.ws + W_SGR), (bf16_t*)(a.ws + W_MERGED), lds};
        { pg8::Unit u0; if (S.next(0, u0)) build_rs_table(lds, (const float*)(a.ws + W_SSQ), u0.pm); }
        __syncthreads();
        pg8::gemm_phase<Epi2, pg8::SegOrder<9>, true, true>(lds, g, S, E);
        for (int t = blockIdx.x; t < 256; t += G) small_gemm2_tile(a, lds, t >> 5, t & 31);
    }
    SEAM(4);
    if (IN(5)) {
        pg8::Gemm g{(const bf16_t*)(a.ws + W_MERGED), (const bf16_t*)(a.ws + W_WT3), D, 0, D / 64, 0, 0}; pg8::StaticOrder S; S.init(ROW_S0, D, G, (int)blockIdx.x);
        EpiOutNorm E{a.in[I_XP], a.in[I_FNW], a.out, (float*)(a.ws + W_PS), (unsigned*)(a.ws + W_CTL + CTL_PANEL)};
        pg8::gemm_phase<EpiOutNorm, pg8::StaticOrder, true, true>(lds, g, S, E);
        for (int t = blockIdx.x; t < 256; t += G) small_gemm3_tile(a, lds, t >> 5, t & 31);
    }
#undef IN
}

extern "C" void kernel_launch(void* const* d_in, const int* in_sizes, int n_in, void* d_out, int out_size, void* d_ws, size_t ws_size, hipStream_t stream) {
    static int grid = 0;
    if (grid == 0) {
        int dev = 0, cus = 0;
        if (n_in != 19 || ws_size < W_END) { fprintf(stderr, "kernel_launch: unexpected n_in %d or ws_size %zu (< %zu)\n", n_in, ws_size, (size_t)W_END); grid = -1; return; }
        if (hipGetDevice(&dev) != hipSuccess || hipDeviceGetAttribute(&cus, hipDeviceAttributeMultiprocessorCount, dev) != hipSuccess) { grid = -1; return; }
        if (hipFuncSetAttribute((const void*)fwd_kernel, hipFuncAttributeMaxDynamicSharedMemorySize, LDS_BYTES) != hipSuccess) { fprintf(stderr, "kernel_launch: hipFuncSetAttribute failed\n"); grid = -1; return; }
        int per_cu = 0; (void)hipOccupancyMaxActiveBlocksPerMultiprocessor(&per_cu, (const void*)fwd_kernel, 512, LDS_BYTES); (void)hipGetLastError();
        if (per_cu < 1) fprintf(stderr, "kernel_launch: occupancy query says %d blocks per CU\n", per_cu);
        grid = cus;
    }
    if (grid < 0) return;
    Args a{};
    for (int i = 0; i < 19; ++i) a.in[i] = (const float*)d_in[i];
    a.out = (float*)d_out; a.ws = (unsigned char*)d_ws;
    a.ph_lo = 0; a.ph_hi = N_PHASES;
    (void)hipMemsetAsync((unsigned char*)d_ws + W_CTL, 0, CTL_BYTES, stream);
    hipLaunchKernelGGL(fwd_kernel, dim3(grid), dim3(512), LDS_BYTES, stream, a);
}
```

```cpp
#include <hip/hip_runtime.h>
#include <cstdio>
#include <cstdint>

#define LAS __attribute__((address_space(3)))
typedef unsigned short bf16_t;
typedef short bf16x8 __attribute__((ext_vector_type(8)));
typedef float f32x4 __attribute__((ext_vector_type(4)));
typedef float f32x2 __attribute__((ext_vector_type(2)));
typedef unsigned u32x4 __attribute__((ext_vector_type(4)));
typedef unsigned u32x2 __attribute__((ext_vector_type(2)));

constexpr int D = 2048, NB = 4, SEQ = 2048, META = 16, DECB = 128, DECS = 8;
constexpr int DI = 4096, NH = 64, HP = 64, NS = 128, NG = 8, CONVD = 6144, SCW = 2048, PROJ = 22592;
constexpr float EPS = 1e-6f;
constexpr int ROW_S0 = 8192, ROW_M0 = 9216, M_REAL = 9232, MP = 9472, M_OUT = 9216;
constexpr int NP1 = 89 * 256;
constexpr int C_XBC = 4096, C_DT = 10240, C_SC = 10304, C_G = 18496;
constexpr size_t O_YP = 0, O_YS = 16777216, O_NCP = 18874368, O_NSSMP = 18948096, O_NSCP = 21045248, O_NCS = 21061632, O_NSSMS = 23420928, O_NSCS = 90529792;
constexpr size_t SZ_R2K = (size_t)MP * 2048 * 2;
constexpr size_t W_H = 0;
constexpr size_t W_WT1 = W_H + SZ_R2K;
constexpr int K2 = 6144;
constexpr size_t W_WT2 = W_WT1 + (size_t)NP1 * 2048 * 2;
constexpr size_t W_WT3 = W_WT2 + (size_t)2048 * K2 * 2;
constexpr size_t W_ZS = W_WT3 + (size_t)2048 * 2048 * 2;
constexpr size_t W_XBC = W_ZS + (size_t)MP * 4096 * 2;
constexpr size_t W_DT = W_XBC + (size_t)MP * 6144 * 2;
constexpr size_t W_U = W_DT + (size_t)MP * 64 * 4;
constexpr size_t W_GB = W_U + SZ_R2K;
constexpr size_t W_SGA = W_GB + SZ_R2K;
constexpr size_t W_SGR = W_SGA + SZ_R2K;
constexpr size_t W_XC = W_SGR + SZ_R2K;
constexpr size_t W_A2 = W_XC + (size_t)MP * 6144 * 2;
constexpr size_t W_MERGED = W_A2 + (size_t)MP * K2 * 2;
constexpr size_t W_CTL = W_MERGED + SZ_R2K;
constexpr size_t CTL_BYTES = 32768;
constexpr size_t CTL_PANEL = 16384, CTL_PANEL2 = 24576;
constexpr size_t W_SSQ = W_CTL + CTL_BYTES;
constexpr size_t W_PS = W_SSQ + (size_t)MP * 64 * 4;
constexpr size_t W_PS2 = W_PS + (size_t)ROW_S0 * 8 * 4;
constexpr size_t W_END = W_PS2 + (size_t)1024 * 32 * 4;
constexpr size_t W_OUTP = W_XBC;

constexpr int LDS_BYTES = 163840;
constexpr int LDS_MISC = 163840 - 64;

typedef __bf16 bf16x2v __attribute__((ext_vector_type(2)));
__device__ __forceinline__ unsigned cvt_pk_bf16(float lo, float hi) { f32x2 v = {lo, hi}; bf16x2v b = __builtin_convertvector(v, bf16x2v); return __builtin_bit_cast(unsigned, b); }
__device__ __forceinline__ float bf_lo(unsigned w) { return __uint_as_float(w << 16); }
__device__ __forceinline__ float bf_hi(unsigned w) { return __uint_as_float(w & 0xffff0000u); }
__device__ __forceinline__ float fsigmoid(float x) { return __builtin_amdgcn_rcpf(1.0f + __expf(-x)); }
__device__ __forceinline__ float fsilu(float x) { return x * fsigmoid(x); }
__device__ __forceinline__ f32x4 silu4(const f32x4 v) {
    const f32x2 xa = (f32x2){v[0], v[1]}, xb = (f32x2){v[2], v[3]}, cs = (f32x2){-1.44269504088896f, -1.44269504088896f}, one = (f32x2){1.0f, 1.0f};
    const f32x2 ta = xa * cs, tb = xb * cs;
    const float e0 = __builtin_amdgcn_exp2f(ta[0]), e1 = __builtin_amdgcn_exp2f(ta[1]), e2 = __builtin_amdgcn_exp2f(tb[0]), e3 = __builtin_amdgcn_exp2f(tb[1]);
    const f32x2 ua = (f32x2){e0, e1} + one, ub = (f32x2){e2, e3} + one;
    const float r0 = __builtin_amdgcn_rcpf(ua[0]), r1 = __builtin_amdgcn_rcpf(ua[1]), r2 = __builtin_amdgcn_rcpf(ub[0]), r3 = __builtin_amdgcn_rcpf(ub[1]);
    const f32x2 ya = xa * (f32x2){r0, r1}, yb = xb * (f32x2){r2, r3};
    return (f32x4){ya[0], ya[1], yb[0], yb[1]};
}
__device__ __forceinline__ void gate4(const f32x4 ga4, const f32x4 gb4, float* sa, float* rt) {
    const f32x2 cs = (f32x2){-1.44269504088896f, -1.44269504088896f}, one = (f32x2){1.0f, 1.0f};
    f32x2 a0 = (f32x2){fminf(fmaxf(ga4[0], -30.f), 30.f), fminf(fmaxf(ga4[1], -30.f), 30.f)}, a1 = (f32x2){fminf(fmaxf(ga4[2], -30.f), 30.f), fminf(fmaxf(ga4[3], -30.f), 30.f)};
    f32x2 b0 = (f32x2){fminf(fmaxf(gb4[0], -30.f), 30.f), fminf(fmaxf(gb4[1], -30.f), 30.f)}, b1 = (f32x2){fminf(fmaxf(gb4[2], -30.f), 30.f), fminf(fmaxf(gb4[3], -30.f), 30.f)};
    a0 = a0 * cs; a1 = a1 * cs; b0 = b0 * cs; b1 = b1 * cs;
    const f32x2 ea0 = (f32x2){__builtin_amdgcn_exp2f(a0[0]), __builtin_amdgcn_exp2f(a0[1])} + one, ea1 = (f32x2){__builtin_amdgcn_exp2f(a1[0]), __builtin_amdgcn_exp2f(a1[1])} + one;
    const f32x2 eb0 = (f32x2){__builtin_amdgcn_exp2f(b0[0]), __builtin_amdgcn_exp2f(b0[1])} + one, eb1 = (f32x2){__builtin_amdgcn_exp2f(b1[0]), __builtin_amdgcn_exp2f(b1[1])} + one;
    sa[0] = __builtin_amdgcn_rcpf(ea0[0]); sa[1] = __builtin_amdgcn_rcpf(ea0[1]); sa[2] = __builtin_amdgcn_rcpf(ea1[0]); sa[3] = __builtin_amdgcn_rcpf(ea1[1]);
    const f32x2 r0 = ea0 * (f32x2){__builtin_amdgcn_rcpf(eb0[0]), __builtin_amdgcn_rcpf(eb0[1])}, r1 = ea1 * (f32x2){__builtin_amdgcn_rcpf(eb1[0]), __builtin_amdgcn_rcpf(eb1[1])};
    rt[0] = r0[0]; rt[1] = r0[1]; rt[2] = r1[0]; rt[3] = r1[1];
}
__device__ __forceinline__ void silu4_pk_bf16(const f32x4 v, unsigned& lo, unsigned& hi) {
    const f32x2 xa = (f32x2){v[0], v[1]}, xb = (f32x2){v[2], v[3]}, cs = (f32x2){-1.44269504088896f, -1.44269504088896f}, one = (f32x2){1.0f, 1.0f};
    const f32x2 ta = xa * cs, tb = xb * cs;
    const float e0 = __builtin_amdgcn_exp2f(ta[0]), e1 = __builtin_amdgcn_exp2f(ta[1]), e2 = __builtin_amdgcn_exp2f(tb[0]), e3 = __builtin_amdgcn_exp2f(tb[1]);
    const f32x2 ua = (f32x2){e0, e1} + one, ub = (f32x2){e2, e3} + one;
    const float r0 = __builtin_amdgcn_rcpf(ua[0]), r1 = __builtin_amdgcn_rcpf(ua[1]), r2 = __builtin_amdgcn_rcpf(ub[0]), r3 = __builtin_amdgcn_rcpf(ub[1]);
    const f32x2 ya = xa * (f32x2){r0, r1}, yb = xb * (f32x2){r2, r3};
    lo = cvt_pk_bf16(ya[0], ya[1]); hi = cvt_pk_bf16(yb[0], yb[1]);
}
__device__ __forceinline__ float wave_sum(float v) {
#pragma unroll
    for (int o = 1; o < 64; o <<= 1) v += __shfl_xor(v, o);
    return v;
}
__device__ __forceinline__ void unpack8(const u32x4 w, float (&f)[8]) {
    f[0] = bf_lo(w.x); f[1] = bf_hi(w.x); f[2] = bf_lo(w.y); f[3] = bf_hi(w.y); f[4] = bf_lo(w.z); f[5] = bf_hi(w.z); f[6] = bf_lo(w.w); f[7] = bf_hi(w.w);
}
__device__ __forceinline__ u32x4 pack8(const float (&f)[8]) {
    u32x4 w; w.x = cvt_pk_bf16(f[0], f[1]); w.y = cvt_pk_bf16(f[2], f[3]); w.z = cvt_pk_bf16(f[4], f[5]); w.w = cvt_pk_bf16(f[6], f[7]); return w;
}
#define LDS_WAIT() asm volatile("s_waitcnt lgkmcnt(0)" ::: "memory")
#define LDS_BARRIER() do { asm volatile("s_waitcnt lgkmcnt(0)" ::: "memory"); __builtin_amdgcn_s_barrier(); asm volatile("" ::: "memory"); } while (0)

namespace pg8 {
constexpr int BM = 256, BK = 64, HALF = 128, HTB = HALF * BK * 2, STAGE_BYTES = 8 * HTB, NXCD = 8, WGM = 8;
__host__ __device__ __forceinline__ int lds_byte(int r, int c) { const int st = (r >> 4) * 2 + (c >> 5), rr = r & 15, cc = c & 31, ob = rr * 64 + cc * 2; return st * 1024 + (ob ^ (((ob >> 9) & 1) << 5)); }
__host__ __device__ __forceinline__ void stage_rc(int b, int& R, int& C) { const int st = b / 1024, sb = b % 1024, swz = sb ^ (((sb >> 9) & 1) << 5); R = (st >> 1) * 16 + swz / 64; C = (st & 1) * 32 + (swz % 64) / 2; }
__host__ __device__ __forceinline__ int perm32(int rho) { const int n = rho >> 4, i = rho & 15; return 8 * (i >> 2) + 4 * n + (i & 3); }
struct Unit { int pm, pn, seg; };
struct Gemm { const bf16_t* A; const bf16_t* Bt; int ldk; int koff0, nt0; int kseg, ntseg;
    __device__ __forceinline__ int koff(int s) const { return s ? (s - 1) * kseg : koff0; } __device__ __forceinline__ int ntiles(int s) const { return s ? ntseg : nt0; } };
struct StaticOrder {
    int nM, nN, nwg, G, c;
    __host__ __device__ __forceinline__ void init(int M, int N, int G_, int c_) { nM = M / BM; nN = N / BM; nwg = nM * nN; G = G_; c = c_; }
    __host__ __device__ __forceinline__ bool next(int i, Unit& u) const {
        const long L = (long)i * G + c; if (L >= nwg) return false;
        int wgid = (int)L; { const int q = nwg / NXCD, r = nwg % NXCD, xcd = wgid % NXCD, off = wgid / NXCD; wgid = (xcd < r ? xcd * (q + 1) : r * (q + 1) + (xcd - r) * q) + off; }
        const int nig = WGM * nN, gid = wgid / nig, fm = gid * WGM, gsz = (nM - fm) < WGM ? (nM - fm) : WGM;
        u.pm = fm + ((wgid % nig) % gsz); u.pn = (wgid % nig) / gsz; u.seg = 0; return true;
    }
    __device__ __forceinline__ void a_ready(const Unit&) const {}
    __device__ __forceinline__ void done(const Unit&) const {}
};
template <int NSEG> struct SegOrder : StaticOrder {
    __host__ __device__ __forceinline__ bool next(int i, Unit& u) const { if (!StaticOrder::next(i / NSEG, u)) return false; u.seg = i % NSEG; return true; }
};

template <class Epi, class Sched, bool ALIGN_EPI = false, bool SP2 = false>
__device__ __forceinline__ void gemm_phase(LAS unsigned char* lds, const Gemm g, const Sched& S, const Epi& E) {
    const int tid = threadIdx.x, wid = __builtin_amdgcn_readfirstlane(tid >> 6), lane = tid & 63, wr = wid >> 2, wc = wid & 3, fr = lane & 15, fq = lane >> 4;
    const int K = g.ldk;
    unsigned voffA[2], voffB[2];
#pragma unroll
    for (int i = 0; i < 2; ++i) { int R, C; stage_rc(tid * 16 + i * 8192, R, C); const int Rb = Epi::PERM ? ((R & ~31) + perm32(R & 31)) : R;
        voffA[i] = (unsigned)(R * K + C) * 2u; voffB[i] = (unsigned)(Rb * K + C) * 2u; }
    const size_t kstep = (size_t)(BK * 2);
    const size_t hstep = (size_t)HALF * K * 2;
    const size_t tstep = 2 * hstep;
    const unsigned ldsw = (unsigned)wid * 1024u;
    const int aoff = lds_byte(wr * 64 + fr, fq * 8), boff = lds_byte(wc * 32 + fr, fq * 8);
#define PG8_SA(b, h) (((b) * 2 + (h)) * HTB)
#define PG8_SB(b, h) ((4 + (b) * 2 + (h)) * HTB)
#define PG8_STAGE(bufoff, gbase, voff) do { _Pragma("unroll") for (int _i = 0; _i < 2; ++_i) \
        __builtin_amdgcn_global_load_lds((const unsigned*)((const char*)(gbase) + (voff)[_i]), (LAS unsigned*)(lds + (bufoff) + ldsw + _i * 8192), 16, 0, 0); } while (0)
#define PG8_LDA(dst, b, h) do { _Pragma("unroll") for (int m = 0; m < 4; ++m) _Pragma("unroll") for (int k = 0; k < 2; ++k) dst[m][k] = *(const LAS bf16x8*)(lds + PG8_SA(b, h) + aoff + m * 2048 + k * 1024); } while (0)
#define PG8_LDB(dst, b, h) do { _Pragma("unroll") for (int n = 0; n < 2; ++n) _Pragma("unroll") for (int k = 0; k < 2; ++k) dst[n][k] = *(const LAS bf16x8*)(lds + PG8_SB(b, h) + boff + n * 2048 + k * 1024); } while (0)
#define PG8_MMA(ai, bj, At, Bt) do { __builtin_amdgcn_s_setprio(1); _Pragma("unroll") for (int m = 0; m < 4; ++m) _Pragma("unroll") for (int n = 0; n < 2; ++n) _Pragma("unroll") for (int k = 0; k < 2; ++k) \
        acc[ai][bj][m][n] = __builtin_amdgcn_mfma_f32_16x16x32_bf16(Bt[n][k], At[m][k], acc[ai][bj][m][n], 0, 0, 0); __builtin_amdgcn_s_setprio(0); } while (0)
#define PG8_WAIT_V(n) asm volatile("s_waitcnt vmcnt(" #n ")" ::: "memory")
#define PG8_WAIT_L(n) asm volatile("s_waitcnt lgkmcnt(" #n ")" ::: "memory")
#define PG8_WAIT_V8R(rx) asm volatile("s_waitcnt vmcnt(24)\n\ts_cmp_lg_u32 %0, 0\n\ts_cbranch_scc1 1\n\ts_waitcnt vmcnt(8)" :: "s"(__builtin_amdgcn_readfirstlane(rx)) : "scc", "memory")
#define PG8_BAR __builtin_amdgcn_s_barrier()
#define PG8_SCHED __builtin_amdgcn_sched_barrier(0)
    Unit cur, nxt; int ui = 0; int rx = 0;
    if (!S.next(0, cur)) return;
    f32x4 acc[2][2][4][2];
#pragma unroll
    for (int a = 0; a < 2; ++a)
#pragma unroll
        for (int b = 0; b < 2; ++b)
#pragma unroll
            for (int m = 0; m < 4; ++m)
#pragma unroll
                for (int n = 0; n < 2; ++n) acc[a][b][m][n] = (f32x4){0.f, 0.f, 0.f, 0.f};
    bf16x8 At[4][2], B0[2][2], B1[2][2];
    const char* cA = (const char*)g.A + (size_t)cur.pm * tstep + (size_t)g.koff(cur.seg) * 2; const char* cB = (const char*)g.Bt + (size_t)cur.pn * tstep + (size_t)g.koff(cur.seg) * 2;
    S.a_ready(cur);
    if constexpr (SP2) {
        PG8_STAGE(PG8_SB(0, 0), cB, voffB); PG8_STAGE(PG8_SB(0, 1), cB + hstep, voffB); PG8_STAGE(PG8_SA(0, 0), cA, voffA); PG8_STAGE(PG8_SA(0, 1), cA + hstep, voffA);
        if (wr == 1) PG8_BAR;
        PG8_WAIT_V(2); PG8_BAR;
        PG8_STAGE(PG8_SB(1, 0), cB + kstep, voffB); PG8_STAGE(PG8_SA(1, 0), cA + kstep, voffA); PG8_STAGE(PG8_SB(1, 1), cB + hstep + kstep, voffB);
        PG8_WAIT_V(6); PG8_BAR;
    } else {
        PG8_STAGE(PG8_SB(0, 0), cB, voffB); PG8_STAGE(PG8_SA(0, 0), cA, voffA); PG8_STAGE(PG8_SB(0, 1), cB + hstep, voffB); PG8_STAGE(PG8_SA(0, 1), cA + hstep, voffA);
        if (wr == 1) PG8_BAR;
        PG8_WAIT_V(4); PG8_BAR;
        PG8_STAGE(PG8_SB(1, 0), cB + kstep, voffB); PG8_STAGE(PG8_SA(1, 0), cA + kstep, voffA); PG8_STAGE(PG8_SB(1, 1), cB + hstep + kstep, voffB);
        PG8_WAIT_V(6); PG8_BAR;
    }
    for (;;) {
        const bool has_next = S.next(ui + 1, nxt);
        const char* nA = has_next ? (const char*)g.A + (size_t)nxt.pm * tstep + (size_t)g.koff(nxt.seg) * 2 : cA; const char* nB = has_next ? (const char*)g.Bt + (size_t)nxt.pn * tstep + (size_t)g.koff(nxt.seg) * 2 : cB;
        const int nt = g.ntiles(cur.seg);
        for (int t = 0; t < nt; t += 2) {
            const bool last = (t == nt - 2);
            const char* a1 = cA + (size_t)(t + 1) * kstep;
            const char* a2 = last ? nA : cA + (size_t)(t + 2) * kstep; const char* b2 = last ? nB : cB + (size_t)(t + 2) * kstep;
            const char* a3 = a2 + kstep; const char* b3 = b2 + kstep;
            if (last && has_next) S.a_ready(nxt);
            if constexpr (SP2) {
            PG8_LDB(B0, 0, 0); PG8_LDB(B1, 0, 1); PG8_SCHED; PG8_LDA(At, 0, 0); PG8_STAGE(PG8_SA(1, 1), a1 + hstep, voffA);
            PG8_WAIT_V8R(rx); PG8_WAIT_L(0); PG8_BAR; PG8_MMA(0, 0, At, B0); PG8_MMA(0, 1, At, B1); PG8_BAR; PG8_SCHED;
            PG8_LDA(At, 0, 1); PG8_STAGE(PG8_SB(0, 0), b2, voffB); PG8_STAGE(PG8_SB(0, 1), b2 + hstep, voffB); PG8_STAGE(PG8_SA(0, 0), a2, voffA);
            PG8_WAIT_V8R(rx); asm volatile("s_mov_b32 %0, 0" : "=s"(rx)); PG8_WAIT_L(0); PG8_BAR; PG8_MMA(1, 0, At, B0); PG8_MMA(1, 1, At, B1); PG8_BAR; PG8_SCHED;
            PG8_LDB(B0, 1, 0); PG8_LDB(B1, 1, 1); PG8_SCHED; PG8_LDA(At, 1, 0); PG8_STAGE(PG8_SA(0, 1), a2 + hstep, voffA);
            PG8_WAIT_V(8); PG8_WAIT_L(0); PG8_BAR; PG8_MMA(0, 0, At, B0); PG8_MMA(0, 1, At, B1); PG8_BAR; PG8_SCHED;
            PG8_LDA(At, 1, 1); PG8_STAGE(PG8_SB(1, 0), b3, voffB); PG8_STAGE(PG8_SB(1, 1), b3 + hstep, voffB); PG8_STAGE(PG8_SA(1, 0), a3, voffA);
            PG8_WAIT_V(8); PG8_WAIT_L(0); PG8_BAR; PG8_MMA(1, 0, At, B0); PG8_MMA(1, 1, At, B1); PG8_BAR; PG8_SCHED;
            } else {
            PG8_LDB(B0, 0, 0); PG8_SCHED; PG8_LDA(At, 0, 0); PG8_STAGE(PG8_SA(1, 1), a1 + hstep, voffA);
            PG8_WAIT_L(8); PG8_BAR; PG8_WAIT_L(0); PG8_MMA(0, 0, At, B0); PG8_BAR; PG8_SCHED;
            PG8_LDB(B1, 0, 1); PG8_STAGE(PG8_SB(0, 0), b2, voffB);
            PG8_BAR; PG8_WAIT_L(0); PG8_MMA(0, 1, At, B1); PG8_BAR;
            PG8_LDA(At, 0, 1); PG8_STAGE(PG8_SA(0, 0), a2, voffA);
            PG8_BAR; PG8_WAIT_L(0); PG8_MMA(1, 0, At, B0); PG8_BAR; PG8_SCHED;
            PG8_STAGE(PG8_SB(0, 1), b2 + hstep, voffB);
            PG8_WAIT_V(6); PG8_BAR; PG8_MMA(1, 1, At, B1); PG8_BAR;
            PG8_LDB(B0, 1, 0); PG8_SCHED; PG8_LDA(At, 1, 0); PG8_STAGE(PG8_SA(0, 1), a2 + hstep, voffA);
            PG8_WAIT_L(8); PG8_BAR; PG8_WAIT_L(0); PG8_MMA(0, 0, At, B0); PG8_BAR; PG8_SCHED;
            PG8_LDB(B1, 1, 1); PG8_STAGE(PG8_SB(1, 0), b3, voffB);
            PG8_BAR; PG8_WAIT_L(0); PG8_MMA(0, 1, At, B1); PG8_BAR;
            PG8_LDA(At, 1, 1); PG8_STAGE(PG8_SA(1, 0), a3, voffA);
            PG8_BAR; PG8_WAIT_L(0); PG8_MMA(1, 0, At, B0); PG8_BAR; PG8_SCHED;
            PG8_STAGE(PG8_SB(1, 1), b3 + hstep, voffB);
            PG8_WAIT_V(6); PG8_BAR; PG8_MMA(1, 1, At, B1); PG8_BAR;
            }
        }
        if constexpr (ALIGN_EPI) { if (wr == 0) PG8_BAR; }
        if constexpr (!Epi::AFTER_DRAIN) E(acc, cur, wr, wc, fr, fq);
        S.done(cur); rx = Epi::stores16(cur);
        if (!has_next) break;
        if (!Epi::CARRY || cur.seg == Epi::LAST_SEG) {
#pragma unroll
        for (int a = 0; a < 2; ++a)
#pragma unroll
            for (int b = 0; b < 2; ++b)
#pragma unroll
                for (int m = 0; m < 4; ++m)
#pragma unroll
                    for (int n = 0; n < 2; ++n) acc[a][b][m][n] = (f32x4){0.f, 0.f, 0.f, 0.f};
        }
        cur = nxt; cA = nA; cB = nB; ++ui;
        if constexpr (ALIGN_EPI) { if (wr == 1) PG8_BAR; }
    }
    PG8_WAIT_V(0);
    if constexpr (!ALIGN_EPI) { if (wr == 0) PG8_BAR; }
    PG8_BAR;
    if constexpr (Epi::AFTER_DRAIN) E.fused(acc, cur, wr, wc, fr, fq, lds);
#undef PG8_SA
#undef PG8_SB
#undef PG8_STAGE
#undef PG8_LDA
#undef PG8_LDB
#undef PG8_MMA
#undef PG8_WAIT_V
#undef PG8_WAIT_V8R
#undef PG8_WAIT_L
#undef PG8_BAR
#undef PG8_SCHED
}
}

__device__ __forceinline__ float fsoftplus(float v) {
    const float e = __expf(fminf(v, 20.f)), u = 1.0f + e, l = (u == 1.0f) ? e : __logf(u) * (e * __builtin_amdgcn_rcpf(u - 1.0f));
    return v > 20.f ? v : l;
}
struct Epi1 {
    static constexpr bool PERM = true, CARRY = false, AFTER_DRAIN = false; static constexpr int LAST_SEG = 0;
    bf16_t *ZS, *XBC, *U, *GB, *SGA, *SGR; float* DT; const float* dt_bias; float* out;
    static __device__ __forceinline__ int stores16(const pg8::Unit& u) { return u.pn < 88 ? 1 : 0; }
    __device__ __forceinline__ void operator()(f32x4 (&acc)[2][2][4][2], const pg8::Unit& u, int wr, int wc, int fr, int fq) const {
        const int pn = u.pn; const int rbase = u.pm * 256 + wr * 64 + fr;
        const bool has_o = u.pm < 32 ? (u.pm & 7) == 7 : u.pm < 36;
        if (pn < 16) {
#pragma unroll
            for (int ai = 0; ai < 2; ++ai)
#pragma unroll
                for (int m = 0; m < 4; ++m) { const int row = rbase + ai * 128 + m * 16; bf16_t* rowp = ZS + (size_t)row * DI + pn * 256 + wc * 32 + 8 * fq;
#pragma unroll
                    for (int bj = 0; bj < 2; ++bj) { const f32x4 v0 = acc[ai][bj][m][0], v1 = acc[ai][bj][m][1]; u32x4 w;
                        unsigned q0, q1, q2, q3; silu4_pk_bf16(v0, q0, q1); silu4_pk_bf16(v1, q2, q3); w = (u32x4){q0, q1, q2, q3};
                        *(u32x4*)(rowp + bj * 128) = w; } }
        } else if (pn < 40) {
#pragma unroll
            for (int ai = 0; ai < 2; ++ai)
#pragma unroll
                for (int m = 0; m < 4; ++m) { const int row = rbase + ai * 128 + m * 16; const int col = (pn - 16) * 256 + wc * 32 + 8 * fq; bf16_t* rowp = XBC + (size_t)row * CONVD + col;
                    int oidx = -1;
                    if (!has_o) {} else if (row < ROW_S0) { const int t = row & 2047; if (t >= 2045) oidx = (int)O_NCP + ((row >> 11) * 3 + (t - 2045)) * CONVD; }
                    else if (row < ROW_M0) { const int t = row & 7; if (t >= 5) oidx = (int)O_NCS + (((row - ROW_S0) >> 3) * 3 + (t - 5)) * CONVD; }
#pragma unroll
                    for (int bj = 0; bj < 2; ++bj) { const f32x4 v0 = acc[ai][bj][m][0], v1 = acc[ai][bj][m][1]; u32x4 w;
                        w.x = cvt_pk_bf16(v0[0], v0[1]); w.y = cvt_pk_bf16(v0[2], v0[3]); w.z = cvt_pk_bf16(v1[0], v1[1]); w.w = cvt_pk_bf16(v1[2], v1[3]);
                        *(u32x4*)(rowp + bj * 128) = w;
                        if (oidx >= 0) { float* o = out + oidx + col + bj * 128; *(f32x4*)o = v0; *(f32x4*)(o + 4) = v1; } } }
        } else if (pn < 72) {
#pragma unroll
            for (int ai = 0; ai < 2; ++ai)
#pragma unroll
                for (int m = 0; m < 4; ++m) { const int row = rbase + ai * 128 + m * 16; const int j0 = (pn - 40) * 64 + wc * 16 + fq * 4;
                    const f32x4 sb = acc[ai][0][m][0], sc = acc[ai][0][m][1], sh = acc[ai][1][m][0], sz = acc[ai][1][m][1];
                    const f32x4 uu = sc * sh; const f32x4 gg = sb * silu4(sz);
                    u32x2 wu, wg; wu.x = cvt_pk_bf16(uu[0], uu[1]); wu.y = cvt_pk_bf16(uu[2], uu[3]); wg.x = cvt_pk_bf16(gg[0], gg[1]); wg.y = cvt_pk_bf16(gg[2], gg[3]);
                    *(u32x2*)(U + (size_t)row * SCW + j0) = wu; *(u32x2*)(GB + (size_t)row * SCW + j0) = wg;
                    int oidx = -1;
                    if (!has_o) {} else if (row < ROW_S0) { const int t = row & 2047; if (t >= 2046) oidx = (int)O_NSCP + ((row >> 11) * 2 + (t - 2046)) * SCW; }
                    else if (row < ROW_M0) { const int t = row & 7; if (t >= 6) oidx = (int)O_NSCS + (((row - ROW_S0) >> 3) * 2 + (t - 6)) * SCW; }
                    if (oidx >= 0) *(f32x4*)(out + oidx + j0) = uu; }
        } else if (pn < 88) {
#pragma unroll
            for (int ai = 0; ai < 2; ++ai)
#pragma unroll
                for (int m = 0; m < 4; ++m) { const int row = rbase + ai * 128 + m * 16; const int j0 = (pn - 72) * 128 + wc * 32 + 8 * fq; float sa[8], rt[8];
#pragma unroll
                    for (int n = 0; n < 2; ++n) gate4(acc[ai][0][m][n], acc[ai][1][m][n], sa + 4 * n, rt + 4 * n);
                    *(u32x4*)(SGA + (size_t)row * D + j0) = pack8(sa); *(u32x4*)(SGR + (size_t)row * D + j0) = pack8(rt); }
        } else {
            if (wc < 2) {
                const int c0 = wc * 32 + 8 * fq; const f32x4 bb0 = *(const f32x4*)(dt_bias + c0), bb1 = *(const f32x4*)(dt_bias + c0 + 4);
#pragma unroll
                for (int ai = 0; ai < 2; ++ai)
#pragma unroll
                    for (int m = 0; m < 4; ++m) { const int row = rbase + ai * 128 + m * 16; f32x4 v0 = acc[ai][0][m][0] + bb0, v1 = acc[ai][0][m][1] + bb1;
#pragma unroll
                        for (int e = 0; e < 4; ++e) { v0[e] = fsoftplus(v0[e]); v1[e] = fsoftplus(v1[e]); }
                        *(f32x4*)(DT + (size_t)row * 64 + c0) = v0; *(f32x4*)(DT + (size_t)row * 64 + c0 + 4) = v1; }
            }
        }
    }
};
constexpr int LDS_RST = 131072;
__device__ __forceinline__ void build_rs_table(LAS unsigned char* lds, const float* SSQ, int pm) {
    LAS float* T = (LAS float*)(lds + LDS_RST);
    const int tid = threadIdx.x, trow = tid >> 1, half = tid & 1; const float* sp = SSQ + (size_t)(pm * 256 + trow) * 64 + 32 * half; float rs[4];
#pragma unroll
    for (int g = 0; g < 4; ++g) { const f32x4 q0 = *(const f32x4*)(sp + 8 * g), q1 = *(const f32x4*)(sp + 8 * g + 4); const float sm = ((q0[0] + q0[1]) + (q0[2] + q0[3])) + ((q1[0] + q1[1]) + (q1[2] + q1[3])); rs[g] = 1.0f / sqrtf(sm * (1.0f / 512.0f) + EPS); }
    const float rprev = __shfl_xor(rs[3], 1);
    LAS float* tp = T + trow * 12 + 4 * half;
    if (half == 0) { tp[0] = 1.0f / rs[0]; tp[1] = rs[0] / rs[1]; tp[2] = rs[1] / rs[2]; tp[3] = rs[2] / rs[3]; }
    else { tp[0] = rprev / rs[0]; tp[1] = rs[0] / rs[1]; tp[2] = rs[1] / rs[2]; tp[3] = rs[2] / rs[3]; tp[4] = rs[3]; }
}
struct Epi2 {
    static constexpr bool PERM = true, CARRY = true, AFTER_DRAIN = false; static constexpr int LAST_SEG = 8;
    static __device__ __forceinline__ int stores16(const pg8::Unit&) { return 0; }
    const bf16_t* SGA; const bf16_t* SGR; bf16_t* MG; LAS unsigned char* lds;
    __device__ __forceinline__ void operator()(f32x4 (&acc)[2][2][4][2], const pg8::Unit& u, int wr, int wc, int fr, int fq) const {
        const int rbase = u.pm * 256 + wr * 64 + fr; LAS float* T = (LAS float*)(lds + LDS_RST);
        const bool gated = (u.seg == 0) || (u.seg == 8); const bf16_t* gp = u.seg == 0 ? SGR : SGA;
#pragma unroll
        for (int ai = 0; ai < 2; ++ai) { u32x4 g[4][2];
#pragma unroll
            for (int m = 0; m < 4; ++m)
#pragma unroll
                for (int bj = 0; bj < 2; ++bj) g[m][bj] = (u32x4){0x3f803f80u, 0x3f803f80u, 0x3f803f80u, 0x3f803f80u};
            if (gated) {
#pragma unroll
                for (int m = 0; m < 4; ++m)
#pragma unroll
                    for (int bj = 0; bj < 2; ++bj) g[m][bj] = *(const u32x4*)(gp + (size_t)(rbase + ai * 128 + m * 16) * D + u.pn * 256 + bj * 128 + wc * 32 + 8 * fq); }
#pragma unroll
            for (int m = 0; m < 4; ++m) { const float tf = T[(wr * 64 + fr + ai * 128 + m * 16) * 12 + u.seg];
#pragma unroll
                for (int bj = 0; bj < 2; ++bj) { float gf[8]; unpack8(g[m][bj], gf); f32x4& v0 = acc[ai][bj][m][0]; f32x4& v1 = acc[ai][bj][m][1];
                    v0 = (f32x4){v0[0] * gf[0] * tf, v0[1] * gf[1] * tf, v0[2] * gf[2] * tf, v0[3] * gf[3] * tf}; v1 = (f32x4){v1[0] * gf[4] * tf, v1[1] * gf[5] * tf, v1[2] * gf[6] * tf, v1[3] * gf[7] * tf};
                    if (u.seg == 8) { u32x4 w; w.x = cvt_pk_bf16(v0[0], v0[1]); w.y = cvt_pk_bf16(v0[2], v0[3]); w.z = cvt_pk_bf16(v1[0], v1[1]); w.w = cvt_pk_bf16(v1[2], v1[3]);
                        *(u32x4*)(MG + (size_t)(rbase + ai * 128 + m * 16) * D + u.pn * 256 + bj * 128 + wc * 32 + 8 * fq) = w; } } }
            asm volatile("" ::: "memory"); }
    }
};
struct EpiOutNorm {
    static constexpr bool PERM = false, CARRY = false, AFTER_DRAIN = true; static constexpr int LAST_SEG = 0;
    static __device__ __forceinline__ int stores16(const pg8::Unit&) { return 0; }
    const float* xp; const float* fnw; float* out; float* PS; unsigned* cnt;
    __device__ __forceinline__ void operator()(f32x4 (&)[2][2][4][2], const pg8::Unit&, int, int, int, int) const {}
    __device__ __forceinline__ void fused(f32x4 (&acc)[2][2][4][2], const pg8::Unit& u, int wr, int wc, int fr, int fq, LAS unsigned char* lds) const {
        const int tid = threadIdx.x, wid = tid >> 6; const int rbase = u.pm * 256 + wr * 64 + fr;
        LAS float* P = (LAS float*)lds;
        LAS float* Sc = P + 1024;
#pragma unroll
        for (int ai = 0; ai < 2; ++ai)
#pragma unroll
            for (int mp = 0; mp < 2; ++mp) { f32x4 xv[2][2][2];
#pragma unroll
                for (int mm = 0; mm < 2; ++mm) { const float* xr = xp + (size_t)(rbase + ai * 128 + (2 * mp + mm) * 16) * D;
#pragma unroll
                    for (int bj = 0; bj < 2; ++bj)
#pragma unroll
                        for (int n = 0; n < 2; ++n) xv[mm][bj][n] = *(const f32x4*)(xr + u.pn * 256 + bj * 128 + wc * 32 + n * 16 + 4 * fq); }
#pragma unroll
                for (int mm = 0; mm < 2; ++mm) { float sq = 0.f;
#pragma unroll
                    for (int bj = 0; bj < 2; ++bj)
#pragma unroll
                        for (int n = 0; n < 2; ++n) { f32x4& v = acc[ai][bj][2 * mp + mm][n]; v = v + xv[mm][bj][n]; sq += (v[0] * v[0] + v[1] * v[1]) + (v[2] * v[2] + v[3] * v[3]); }
                    sq += __shfl_xor(sq, 16); sq += __shfl_xor(sq, 32);
                    if (fq == 0) P[(wr * 64 + fr + ai * 128 + (2 * mp + mm) * 16) * 4 + wc] = sq; }
                asm volatile("" ::: "memory"); }
        LDS_BARRIER();
        if (tid < 256) { const f32x4 q = *(const LAS f32x4*)(P + tid * 4); __hip_atomic_store(PS + (size_t)(u.pm * 256 + tid) * 8 + u.pn, (q[0] + q[1]) + (q[2] + q[3]), __ATOMIC_RELAXED, __HIP_MEMORY_SCOPE_AGENT); }
        asm volatile("s_waitcnt vmcnt(0)" ::: "memory");
        if (tid < 256 && (tid & 63) == 0) __hip_atomic_fetch_add(cnt + 64 * u.pm, 1u, __ATOMIC_RELAXED, __HIP_MEMORY_SCOPE_AGENT);
        if (wid == 0) { unsigned spins = 0;
            while ((unsigned)__builtin_amdgcn_readfirstlane(__hip_atomic_load(cnt + 64 * u.pm, __ATOMIC_RELAXED, __HIP_MEMORY_SCOPE_AGENT)) < 32u) { __builtin_amdgcn_s_sleep(2); if (++spins > (1u << 22)) break; }
            __builtin_amdgcn_fence(__ATOMIC_ACQUIRE, "agent");
            asm volatile("s_waitcnt vmcnt(0)" ::: "memory"); }
        LDS_BARRIER();
        if (tid < 256) { const float* pp = PS + (size_t)(u.pm * 256 + tid) * 8; float sm = 0.f;
#pragma unroll
            for (int t = 0; t < 8; ++t) sm += __hip_atomic_load(pp + t, __ATOMIC_RELAXED, __HIP_MEMORY_SCOPE_AGENT);
            Sc[tid] = 1.0f / sqrtf(sm * (1.0f / D) + EPS); }
        LDS_BARRIER();
        f32x4 fw[2][2];
#pragma unroll
        for (int bj = 0; bj < 2; ++bj)
#pragma unroll
            for (int n = 0; n < 2; ++n) fw[bj][n] = *(const f32x4*)(fnw + u.pn * 256 + bj * 128 + wc * 32 + n * 16 + 4 * fq);
#pragma unroll
        for (int ai = 0; ai < 2; ++ai)
#pragma unroll
            for (int m = 0; m < 4; ++m) { const int rl = wr * 64 + fr + ai * 128 + m * 16; const float rs = Sc[rl];
#pragma unroll
                for (int bj = 0; bj < 2; ++bj)
#pragma unroll
                    for (int n = 0; n < 2; ++n) *(f32x4*)(out + (size_t)(u.pm * 256 + rl) * D + u.pn * 256 + bj * 128 + wc * 32 + n * 16 + 4 * fq) = acc[ai][bj][m][n] * rs * fw[bj][n]; }
    }
};

#define XB_TMO      128
#define XB_XCNT(j)  (256  + 64 * (j))
#define XB_XSUB(j)  (1280 + 64 * (j))
#define XB_XGEN(j)  (2304 + 64 * (j))
#define XB_TOP      3328
#define XB_TOPGEN   3392
#define XCD_BAR_WORDS 3456
#define XB_SPIN_CAP (1u << 21)
__device__ __forceinline__ unsigned xb_ld(unsigned* p)              { return __hip_atomic_load(p, __ATOMIC_RELAXED, __HIP_MEMORY_SCOPE_AGENT); }
__device__ __forceinline__ unsigned xb_add(unsigned* p, unsigned v) { return __hip_atomic_fetch_add(p, v, __ATOMIC_RELAXED, __HIP_MEMORY_SCOPE_AGENT); }
__device__ __forceinline__ unsigned xb_xcc_id() { return (unsigned)__builtin_amdgcn_s_getreg((3 << 11) | 20) & 0xFu; }
#define XB_SPIN(cond, bar) do { unsigned _sp = 0; while (cond) { __builtin_amdgcn_s_sleep(1); \
    if ((++_sp & 255u) == 0u) { if (xb_ld(&(bar)[XB_TMO])) break; if (_sp > XB_SPIN_CAP) { atomicAdd(&(bar)[XB_TMO], 1u); break; } } } } while (0)
struct XcdBarrier { unsigned* bar; unsigned x; volatile LAS unsigned* st; };
__device__ __forceinline__ XcdBarrier xcd_barrier_post(unsigned* bar, volatile LAS unsigned* st) {
    XcdBarrier b; b.bar = bar; b.x = xb_xcc_id(); b.st = st;
    if (threadIdx.x == 0) (void)xb_add(&bar[XB_XCNT(b.x)], 1u);
    return b;
}
__device__ __forceinline__ void xcd_barrier_complete(unsigned* bar, unsigned x, unsigned& nloc, unsigned& nx) {
    const unsigned G = gridDim.x * gridDim.y * gridDim.z;
    unsigned sum, cnt, mine, sp = 0u;
    for (;;) {
        sum = 0u; cnt = 0u; mine = 0u;
#pragma unroll
        for (unsigned j = 0; j < 16; ++j) { const unsigned c = xb_ld(&bar[XB_XCNT(j)]); sum += c; cnt += (c > 0u) ? 1u : 0u; mine = (j == x) ? c : mine; }
        if (sum == G) break;
        __builtin_amdgcn_s_sleep(1);
        if ((++sp & 255u) == 0u) { if (xb_ld(&bar[XB_TMO])) break; if (sp > XB_SPIN_CAP) { atomicAdd(&bar[XB_TMO], 1u); break; } }
    }
    nloc = mine > 0u ? mine : 1u; nx = cnt > 0u ? cnt : 1u;
}
__device__ __forceinline__ void xcd_barrier(const XcdBarrier& b) {
    asm volatile("s_waitcnt vmcnt(0)" ::: "memory");
    __syncthreads();
    if (threadIdx.x == 0) {
        unsigned* bar = b.bar;
        __builtin_amdgcn_s_waitcnt(0);
        unsigned nloc = b.st[0], nx = b.st[1];
        if (nloc == 0u) { xcd_barrier_complete(bar, b.x, nloc, nx); b.st[0] = nloc; b.st[1] = nx; }
        const unsigned old = xb_add(&bar[XB_XSUB(b.x)], 1u);
        const unsigned gen = old / nloc;
        if (old + 1u == (gen + 1u) * nloc) {
            __builtin_amdgcn_fence(__ATOMIC_RELEASE, "agent");
            asm volatile("s_waitcnt vmcnt(0)" ::: "memory");
            const unsigned og = xb_add(&bar[XB_TOP], 1u);
            const unsigned tg = og / nx;
            if (og + 1u == (tg + 1u) * nx) xb_add(&bar[XB_TOPGEN], 1u);
            else XB_SPIN(xb_ld(&bar[XB_TOPGEN]) == tg, bar);
            __builtin_amdgcn_fence(__ATOMIC_ACQUIRE, "agent");
            xb_add(&bar[XB_XGEN(b.x)], 1u);
            asm volatile("s_waitcnt vmcnt(0)" ::: "memory");
        } else {
            XB_SPIN(xb_ld(&bar[XB_XGEN(b.x)]) == gen, bar);
            __builtin_amdgcn_fence(__ATOMIC_ACQUIRE, "agent");
            asm volatile("s_waitcnt vmcnt(0)" ::: "memory");
        }
    }
    __syncthreads();
}

struct Args { const float* in[19]; float* out; unsigned char* ws; int ph_lo, ph_hi; };
enum { I_XP = 0, I_XS, I_SCONV4, I_SSM, I_SSCONV, I_META, I_NORMW, I_WIN, I_CW, I_CB, I_DTB, I_ALOG, I_DSKIP, I_SNW, I_WSSD, I_SCW, I_WSC, I_WO, I_FNW };

__device__ __forceinline__ int wt1_src_col(int np) {
    const int pn = np >> 8, c = np & 255;
    if (pn < 40) return np;
    if (pn < 72) { const int q = 2 * (c >> 7) + ((c >> 2) & 1), jl = 16 * ((c >> 5) & 3) + 4 * ((c >> 3) & 3) + (c & 3); return C_SC + 2048 * q + 64 * (pn - 40) + jl; }
    if (pn < 88) return C_G + 2048 * (c >> 7) + 128 * (pn - 72) + (c & 127);
    return c < 64 ? C_DT + c : -1;
}
struct TItem { const float* src; const float* ksc; bf16_t* dst; int ldw, pitch; bool valid; };
__device__ __forceinline__ TItem prep_decode(const Args& a, int it, int lane) {
    constexpr int I1 = 32 * (NP1 / 64), I2A = 64 * 32, I2B = 32 * 32, I3 = 32 * 32;
    TItem t; t.valid = it < I1 + I2A + I2B + I3; t.src = nullptr; t.ksc = nullptr; t.dst = nullptr; t.ldw = 0; t.pitch = 0;
    if (!t.valid) return t;
    const int l4 = 4 * (lane & 15), kr = lane >> 4, c8 = 8 * (lane & 7); int r = it;
    if (r < I1) { const int kb = r / (NP1 / 64), nb = r % (NP1 / 64); const int sc = wt1_src_col(nb * 64 + l4); t.ldw = PROJ; t.pitch = D;
        t.src = sc >= 0 ? a.in[I_WIN] + (size_t)(kb * 64 + kr) * PROJ + sc : nullptr; t.dst = (bf16_t*)(a.ws + W_WT1) + (size_t)(nb * 64) * D + kb * 64; return t; } r -= I1;
    if (r < I2A) { const int kb = r / 32, nb = r % 32; t.ldw = D; t.pitch = K2; t.src = a.in[I_WSSD] + (size_t)(kb * 64 + kr) * D + nb * 64 + l4; t.ksc = a.in[I_SNW] + kb * 64 + c8;
        t.dst = (bf16_t*)(a.ws + W_WT2) + (size_t)(nb * 64) * K2 + kb * 64; return t; } r -= I2A;
    if (r < I2B) { const int kb = r / 32, nb = r % 32; t.ldw = D; t.pitch = K2; t.src = a.in[I_WSC] + (size_t)(kb * 64 + kr) * D + nb * 64 + l4; t.dst = (bf16_t*)(a.ws + W_WT2) + (size_t)(nb * 64) * K2 + DI + kb * 64; return t; } r -= I2B;
    { const int kb = r / 32, nb = r % 32; t.ldw = D; t.pitch = D; t.src = a.in[I_WO] + (size_t)(kb * 64 + kr) * D + nb * 64 + l4; t.dst = (bf16_t*)(a.ws + W_WT3) + (size_t)(nb * 64) * D + kb * 64; }
    return t;
}
__device__ __forceinline__ void transpose_range(const Args& a, LAS unsigned char* lds, int first, int stride, int end) {
    const int tid = threadIdx.x, lane = tid & 63, wave = __builtin_amdgcn_readfirstlane(tid >> 6);
    LAS unsigned char* scr = lds + wave * 16384;
    const int kr = lane >> 4, n4 = lane & 15, c = lane & 7, nn = lane >> 3;
    f32x4 buf[16];
    TItem cur = prep_decode(a, first < end ? first : 1 << 30, lane);
    if (cur.valid) {
#pragma unroll
        for (int i = 0; i < 16; ++i) buf[i] = cur.src ? *(const f32x4*)(cur.src + (size_t)(4 * i) * cur.ldw) : (f32x4){0.f, 0.f, 0.f, 0.f}; }
    for (int it = first; cur.valid; it += stride) {
        const TItem nxt = prep_decode(a, it + stride < end ? it + stride : 1 << 30, lane);
#pragma unroll
        for (int i = 0; i < 16; ++i) { const int k = 4 * i + kr; *(LAS f32x4*)(scr + k * 256 + ((n4 ^ (k >> 3)) << 4)) = buf[i]; }
        if (nxt.valid) {
#pragma unroll
            for (int i = 0; i < 16; ++i) buf[i] = nxt.src ? *(const f32x4*)(nxt.src + (size_t)(4 * i) * nxt.ldw) : (f32x4){0.f, 0.f, 0.f, 0.f}; }
        f32x4 k0v = (f32x4){1.f, 1.f, 1.f, 1.f}, k1v = k0v; if (cur.ksc) { k0v = *(const f32x4*)cur.ksc; k1v = *(const f32x4*)(cur.ksc + 4); }
        LDS_WAIT();
#pragma unroll
        for (int j = 0; j < 8; ++j) { const int n = nn + 8 * j; const LAS unsigned char* sp = scr + (8 * c) * 256 + (((n >> 2) ^ c) << 4) + ((n & 3) << 2); float f[8];
#pragma unroll
            for (int e = 0; e < 8; ++e) f[e] = *(const LAS float*)(sp + e * 256) * (e < 4 ? k0v[e & 3] : k1v[e & 3]);
            *(u32x4*)(cur.dst + (size_t)n * cur.pitch + 8 * c) = pack8(f); }
        LDS_WAIT();
        cur = nxt;
    }
}
constexpr int PRE_IN_PREP = 1216;
constexpr int PREP_I1 = 32 * (NP1 / 64), PREP_I23 = 64 * 32 + 32 * 32 + 32 * 32;
__device__ __forceinline__ void phase_prep(const Args& a, LAS unsigned char* lds, int G) {
    const int tid = threadIdx.x, lane = tid & 63, wave = __builtin_amdgcn_readfirstlane(tid >> 6);
    const int gw = blockIdx.x * 8 + wave, NGW = G * 8;
    transpose_range(a, lds, gw, NGW, PREP_I1 + (G == 256 ? PRE_IN_PREP : 0));
    bf16_t* H = (bf16_t*)(a.ws + W_H); const float* nw = a.in[I_NORMW];
    auto rowsrc = [&](int r) -> const float* { return r < ROW_S0 ? a.in[I_XP] + (size_t)r * D : (r < ROW_M0 ? a.in[I_XS] + (size_t)(r - ROW_S0) * D : (r < M_REAL ? a.in[I_META] + (size_t)(r - ROW_M0) * D : nullptr)); };
    f32x4 pv[8];
    { const float* src = gw < MP ? rowsrc(gw) : nullptr;
#pragma unroll
        for (int j = 0; j < 8; ++j) pv[j] = src ? ((const f32x4*)src)[lane + 64 * j] : (f32x4){0.f, 0.f, 0.f, 0.f}; }
    for (int r = gw; r < MP; r += NGW) {
        f32x4 v[8]; float s = 0.f;
#pragma unroll
        for (int j = 0; j < 8; ++j) { v[j] = pv[j]; s += (v[j][0] * v[j][0] + v[j][1] * v[j][1]) + (v[j][2] * v[j][2] + v[j][3] * v[j][3]); }
        { const float* src = r + NGW < MP ? rowsrc(r + NGW) : nullptr;
#pragma unroll
            for (int j = 0; j < 8; ++j) pv[j] = src ? ((const f32x4*)src)[lane + 64 * j] : (f32x4){0.f, 0.f, 0.f, 0.f}; }
        const float rs = 1.0f / sqrtf(wave_sum(s) * (1.0f / D) + EPS);
#pragma unroll
        for (int j = 0; j < 8; ++j) { const f32x4 w = ((const f32x4*)nw)[lane + 64 * j]; u32x2 o; o.x = cvt_pk_bf16(v[j][0] * rs * w[0], v[j][1] * rs * w[1]); o.y = cvt_pk_bf16(v[j][2] * rs * w[2], v[j][3] * rs * w[3]);
            ((u32x2*)(H + (size_t)r * D))[lane + 64 * j] = o; }
    }
}

__device__ __forceinline__ void phase_conv(const Args& a, int G) {
    const int tid = threadIdx.x;
    const bf16_t* XBC = (const bf16_t*)(a.ws + W_XBC); const bf16_t* U = (const bf16_t*)(a.ws + W_U); const bf16_t* GBp = (const bf16_t*)(a.ws + W_GB);
    bf16_t* XC = (bf16_t*)(a.ws + W_XC); bf16_t* A2 = (bf16_t*)(a.ws + W_A2);
    constexpr int NBLK = 512 + 64 + 1;
    for (int item = blockIdx.x; item < 512 + 2 * (NBLK - 512); item += G) {
        const int hf = item < 512 ? 1 : ((item - 512) & 1), blk = item < 512 ? item : 512 + ((item - 512) >> 1); const int cg = hf * 512 + tid; const bool isx = cg < 768;
        int r0, nseg, segrows, mode;
        if (blk < 512) { r0 = blk * 16; nseg = 1; segrows = 16; mode = (blk & 127) == 0 ? 1 : 0; }
        else if (blk < 576) { r0 = ROW_S0 + (blk - 512) * 16; nseg = 2; segrows = 8; mode = 2; }
        else { r0 = ROW_M0; nseg = 1; segrows = 16; mode = 3; }
        if (isx) {
            const int c0 = cg * 8; float w[4][8], bias[8];
#pragma unroll
            for (int k = 0; k < 4; ++k) { const f32x4 pv = *(const f32x4*)(a.in[I_CW] + k * CONVD + c0), qv = *(const f32x4*)(a.in[I_CW] + k * CONVD + c0 + 4);
                w[k][0] = pv[0]; w[k][1] = pv[1]; w[k][2] = pv[2]; w[k][3] = pv[3]; w[k][4] = qv[0]; w[k][5] = qv[1]; w[k][6] = qv[2]; w[k][7] = qv[3]; }
            { const f32x4 pv = *(const f32x4*)(a.in[I_CB] + c0), qv = *(const f32x4*)(a.in[I_CB] + c0 + 4); bias[0] = pv[0]; bias[1] = pv[1]; bias[2] = pv[2]; bias[3] = pv[3]; bias[4] = qv[0]; bias[5] = qv[1]; bias[6] = qv[2]; bias[7] = qv[3]; }
            for (int sg = 0; sg < nseg; ++sg) {
                const int rs = r0 + sg * segrows; float x3[8], x2[8], x1[8];
                if (mode == 0 || mode == 1) { const int pr = mode == 0 ? rs - 3 : M_REAL - 3;
                    unpack8(*(const u32x4*)(XBC + (size_t)pr * CONVD + c0), x3); unpack8(*(const u32x4*)(XBC + (size_t)(pr + 1) * CONVD + c0), x2); unpack8(*(const u32x4*)(XBC + (size_t)(pr + 2) * CONVD + c0), x1); }
                else if (mode == 2) { const float* st = a.in[I_SCONV4] + (size_t)((rs - ROW_S0) >> 3) * 3 * CONVD + c0;
#pragma unroll
                    for (int e = 0; e < 8; ++e) { x3[e] = st[e]; x2[e] = st[CONVD + e]; x1[e] = st[2 * CONVD + e]; } }
                else {
#pragma unroll
                    for (int e = 0; e < 8; ++e) { x3[e] = 0.f; x2[e] = 0.f; x1[e] = 0.f; } }
                for (int i0 = 0; i0 < segrows; i0 += 8) { u32x4 ld[8];
#pragma unroll
                    for (int j = 0; j < 8; ++j) ld[j] = *(const u32x4*)(XBC + (size_t)(rs + i0 + j) * CONVD + c0);
#pragma unroll
                    for (int j = 0; j < 8; ++j) { float cur[8], o[8]; unpack8(ld[j], cur);
#pragma unroll
                        for (int e = 0; e < 8; ++e) { const float v = bias[e] + w[0][e] * x3[e] + w[1][e] * x2[e] + w[2][e] * x1[e] + w[3][e] * cur[e]; o[e] = fsilu(v); x3[e] = x2[e]; x2[e] = x1[e]; x1[e] = cur[e]; }
                        *(u32x4*)(XC + (size_t)(rs + i0 + j) * CONVD + c0) = pack8(o); } }
            }
        } else {
            const int j0 = (cg - 768) * 8; float w[3][8];
#pragma unroll
            for (int k = 0; k < 3; ++k) { const f32x4 pv = *(const f32x4*)(a.in[I_SCW] + k * SCW + j0), qv = *(const f32x4*)(a.in[I_SCW] + k * SCW + j0 + 4);
                w[k][0] = pv[0]; w[k][1] = pv[1]; w[k][2] = pv[2]; w[k][3] = pv[3]; w[k][4] = qv[0]; w[k][5] = qv[1]; w[k][6] = qv[2]; w[k][7] = qv[3]; }
            for (int sg = 0; sg < nseg; ++sg) {
                const int rs = r0 + sg * segrows; float u2[8], u1[8];
                if (mode == 0 || mode == 1) { const int pr = mode == 0 ? rs - 2 : M_REAL - 2;
                    unpack8(*(const u32x4*)(U + (size_t)pr * SCW + j0), u2); unpack8(*(const u32x4*)(U + (size_t)(pr + 1) * SCW + j0), u1); }
                else if (mode == 2) { const float* st = a.in[I_SSCONV] + (size_t)((rs - ROW_S0) >> 3) * 2 * SCW + j0;
#pragma unroll
                    for (int e = 0; e < 8; ++e) { u2[e] = st[e]; u1[e] = st[SCW + e]; } }
                else {
#pragma unroll
                    for (int e = 0; e < 8; ++e) { u2[e] = 0.f; u1[e] = 0.f; } }
                for (int i0 = 0; i0 < segrows; i0 += 8) { u32x4 ld[8], lg[8];
#pragma unroll
                    for (int j = 0; j < 8; ++j) { ld[j] = *(const u32x4*)(U + (size_t)(rs + i0 + j) * SCW + j0); lg[j] = *(const u32x4*)(GBp + (size_t)(rs + i0 + j) * SCW + j0); }
#pragma unroll
                    for (int j = 0; j < 8; ++j) { float cur[8], gt[8], o[8]; unpack8(ld[j], cur); unpack8(lg[j], gt);
#pragma unroll
                        for (int e = 0; e < 8; ++e) { const float v = w[0][e] * u2[e] + w[1][e] * u1[e] + w[2][e] * cur[e]; o[e] = gt[e] * v; u2[e] = u1[e]; u1[e] = cur[e]; }
                        *(u32x4*)(A2 + (size_t)(rs + i0 + j) * K2 + DI + j0) = pack8(o); } }
            }
        }
    }
}

constexpr int SL_C = 0, SL_B = 32768, SL_W = 65536, SL_XD = 98304, SL_XE = 114688, SL_H = 131072, SL_SM = 147456;
typedef short s16x4 __attribute__((ext_vector_type(4)));
__device__ __forceinline__ int img_off(int row, int col) { return row * 256 + ((((col >> 3) ^ row) & 15) << 4) + ((col & 7) << 1); }
__device__ __forceinline__ int img_off128(int row, int col) { return row * 128 + ((((col >> 3) ^ row) & 7) << 4) + ((col & 7) << 1); }
__device__ __forceinline__ bf16x8 ldfrag(const LAS unsigned char* img, int r0, int ks, int fr, int fq) { return *(const LAS bf16x8*)(img + (r0 + fr) * 256 + ((((4 * ks + fq) ^ fr) & 15) << 4)); }
__device__ __forceinline__ bf16x8 trfrag256(const LAS unsigned char* img, int c0, int ks, int lane) {
    const int i16 = lane & 15, fq = lane >> 4, q = i16 >> 2, p = i16 & 3, krow = 32 * ks + 8 * fq + q, col = c0 + 4 * p;
    const s16x4 lo = __builtin_amdgcn_ds_read_tr16_b64_v4i16((LAS s16x4*)(img + img_off(krow, col))), hi = __builtin_amdgcn_ds_read_tr16_b64_v4i16((LAS s16x4*)(img + img_off(krow + 4, col)));
    return __builtin_shufflevector(lo, hi, 0, 1, 2, 3, 4, 5, 6, 7);
}
__device__ __forceinline__ bf16x8 trfrag128(const LAS unsigned char* img, int c0, int ks, int lane) {
    const int i16 = lane & 15, fq = lane >> 4, q = i16 >> 2, p = i16 & 3, krow = 32 * ks + 8 * fq + q, col = c0 + 4 * p;
    const s16x4 lo = __builtin_amdgcn_ds_read_tr16_b64_v4i16((LAS s16x4*)(img + img_off128(krow, col))), hi = __builtin_amdgcn_ds_read_tr16_b64_v4i16((LAS s16x4*)(img + img_off128(krow + 4, col)));
    return __builtin_shufflevector(lo, hi, 0, 1, 2, 3, 4, 5, 6, 7);
}
#define MFMA16(a, b, c) __builtin_amdgcn_mfma_f32_16x16x32_bf16((a), (b), (c), 0, 0, 0)
__device__ __forceinline__ void ssd_prompt_item(const Args& a, LAS unsigned char* lds, int b, int head) {
    const int tid = threadIdx.x, lane = tid & 63, w = __builtin_amdgcn_readfirstlane(tid >> 6), g = head >> 3;
    const bf16_t* XC = (const bf16_t*)(a.ws + W_XC); const float* DT = (const float*)(a.ws + W_DT); const bf16_t* ZS = (const bf16_t*)(a.ws + W_ZS);
    bf16_t* YG = (bf16_t*)(a.ws + W_A2); float* SSQ = (float*)(a.ws + W_SSQ);
    LAS unsigned char* Ci = lds + SL_C; LAS unsigned char* Bi = lds + SL_B; LAS unsigned char* Wi = lds + SL_W; LAS unsigned char* XDi = lds + SL_XD; LAS unsigned char* XEi = lds + SL_XE; LAS unsigned char* Hi = lds + SL_H;
    LAS float* acum_s = (LAS float*)(lds + SL_SM); LAS float* dt_s = acum_s + 128; LAS float* ea_s = acum_s + 256; LAS float* ee_s = acum_s + 384;
    const float Ah = -expf(a.in[I_ALOG][head]); const float Dh = a.in[I_DSKIP][head];
    f32x4 st[4];
#pragma unroll
    for (int pt = 0; pt < 4; ++pt) st[pt] = (f32x4){0.f, 0.f, 0.f, 0.f};
    u32x4 pc[4], pb[4], pr[2][4]; float pdt0 = 0.f, pdt1 = 0.f;
    const bf16_t* XBCr = (const bf16_t*)(a.ws + W_XBC);
    float cw[4][8], cbias[8];
    { const int c0 = head * 64 + 8 * (tid & 7);
#pragma unroll
      for (int k = 0; k < 4; ++k) { const f32x4 pv = *(const f32x4*)(a.in[I_CW] + k * CONVD + c0), qv = *(const f32x4*)(a.in[I_CW] + k * CONVD + c0 + 4);
          cw[k][0] = pv[0]; cw[k][1] = pv[1]; cw[k][2] = pv[2]; cw[k][3] = pv[3]; cw[k][4] = qv[0]; cw[k][5] = qv[1]; cw[k][6] = qv[2]; cw[k][7] = qv[3]; }
      const f32x4 pv = *(const f32x4*)(a.in[I_CB] + c0), qv = *(const f32x4*)(a.in[I_CB] + c0 + 4);
      cbias[0] = pv[0]; cbias[1] = pv[1]; cbias[2] = pv[2]; cbias[3] = pv[3]; cbias[4] = qv[0]; cbias[5] = qv[1]; cbias[6] = qv[2]; cbias[7] = qv[3]; }
    auto rowg = [&](int c, int i) -> int { return c == 0 ? ROW_M0 + i : b * 2048 + (c - 1) * 128 + i; };
    auto prefetch = [&](int c, int t) {
        const int valid = c == 0 ? META : 128;
#pragma unroll
        for (int k = 0; k < 4; ++k) { const int q = t + 512 * k, row = q >> 4, ch = q & 15;
            if (row < valid) { const bf16_t* base = XC + (size_t)rowg(c, row) * CONVD + g * 128 + ch * 8; pb[k] = *(const u32x4*)(base + DI); pc[k] = *(const u32x4*)(base + DI + 1024); }
            else { pb[k] = (u32x4){0u, 0u, 0u, 0u}; pc[k] = (u32x4){0u, 0u, 0u, 0u}; } }
#pragma unroll
        for (int k = 0; k < 2; ++k) { const int q = t + 512 * k, row = q >> 3, ch = q & 7;
            if (c == 0) { pr[k][0] = row < valid ? *(const u32x4*)(XC + (size_t)rowg(0, row) * CONVD + head * 64 + ch * 8) : (u32x4){0u, 0u, 0u, 0u}; }
            else {
#pragma unroll
                for (int d = 0; d < 4; ++d) { const int t = (c - 1) * 128 + row - d;
                    pr[k][d] = *(const u32x4*)(XBCr + (size_t)(t >= 0 ? b * 2048 + t : ROW_M0 + 16 + t) * CONVD + head * 64 + ch * 8); } } }
        if (w == 0) { const int r0 = 2 * (t & 63); pdt0 = r0 < valid ? DT[(size_t)rowg(c, r0) * 64 + head] : 0.f; pdt1 = r0 + 1 < valid ? DT[(size_t)rowg(c, r0 + 1) * 64 + head] : 0.f; }
    };
    prefetch(0, tid);
    for (int c = 0; c < 17; ++c) {
        int tq = tid; asm volatile("" : "+v"(tq));
        const int lq = tq & 63, fr = lq & 15, fq = lq >> 4;
        LDS_BARRIER();
        if (w == 0) {
            const float l0 = pdt0 * Ah, l1 = pdt1 * Ah; float sc = l0 + l1;
#pragma unroll
            for (int o = 1; o < 64; o <<= 1) { const float t = __shfl_up(sc, o); if (lane >= o) sc += t; }
            const float a1 = sc, a0 = sc - l1, alast = __shfl(sc, 63);
            acum_s[2 * lane] = a0; acum_s[2 * lane + 1] = a1; dt_s[2 * lane] = pdt0; dt_s[2 * lane + 1] = pdt1;
            ea_s[2 * lane] = __expf(a0); ea_s[2 * lane + 1] = __expf(a1); ee_s[2 * lane] = __expf(alast - a0); ee_s[2 * lane + 1] = __expf(alast - a1);
        }
#pragma unroll
        for (int k = 0; k < 4; ++k) { const int q = tq + 512 * k, row = q >> 4, ch = q & 15; const int o = row * 256 + (((ch ^ row) & 15) << 4);
            *(LAS u32x4*)(Ci + o) = pc[k]; *(LAS u32x4*)(Bi + o) = pb[k]; }
#pragma unroll
        for (int pt = 0; pt < 4; ++pt) { u32x2 hv; hv.x = cvt_pk_bf16(st[pt][0], st[pt][1]); hv.y = cvt_pk_bf16(st[pt][2], st[pt][3]); *(LAS u32x2*)(Hi + img_off(16 * pt + fr, 16 * w + 4 * fq)) = hv; }
        LDS_BARRIER();
#pragma unroll
        for (int k = 0; k < 2; ++k) { const int q = tq + 512 * k, row = q >> 3, ch = q & 7; float f[8], fd[8], fe[8]; const float dtj = dt_s[row], ej = ee_s[row] * dtj;
            if (c == 0) unpack8(pr[k][0], f);
            else { float x0[8], x1[8], x2[8], x3[8]; unpack8(pr[k][0], x0); unpack8(pr[k][1], x1); unpack8(pr[k][2], x2); unpack8(pr[k][3], x3);
#pragma unroll
                for (int e = 0; e < 8; ++e) f[e] = fsilu(cbias[e] + cw[0][e] * x3[e] + cw[1][e] * x2[e] + cw[2][e] * x1[e] + cw[3][e] * x0[e]); }
#pragma unroll
            for (int e = 0; e < 8; ++e) { fd[e] = f[e] * dtj; fe[e] = f[e] * ej; }
            const int o = row * 128 + (((ch ^ row) & 7) << 4);
            *(LAS u32x4*)(XDi + o) = pack8(fd); *(LAS u32x4*)(XEi + o) = pack8(fe); }
        LDS_BARRIER();
        if (c + 1 < 17) prefetch(c + 1, tq);
        const float dA = ea_s[127];
#pragma unroll
        for (int pt = 0; pt < 4; ++pt) st[pt] = st[pt] * dA;
#pragma unroll
        for (int kh = 0; kh < 2; ++kh) { bf16x8 bt[2], xe[2][4];
#pragma unroll
            for (int k2 = 0; k2 < 2; ++k2) { bt[k2] = trfrag256(Bi, 16 * w, 2 * kh + k2, lq);
#pragma unroll
                for (int pt = 0; pt < 4; ++pt) xe[k2][pt] = trfrag128(XEi, 16 * pt, 2 * kh + k2, lq); }
            __builtin_amdgcn_sched_barrier(0); LDS_WAIT(); __builtin_amdgcn_sched_barrier(0);
#pragma unroll
            for (int k2 = 0; k2 < 2; ++k2)
#pragma unroll
                for (int pt = 0; pt < 4; ++pt) st[pt] = MFMA16(bt[k2], xe[k2][pt], st[pt]);
            __builtin_amdgcn_sched_barrier(0); }
        if (c >= 1) {
        bf16x8 ca[4];
#pragma unroll
        for (int ks = 0; ks < 4; ++ks) ca[ks] = ldfrag(Ci, 16 * w, ks, fr, fq);
        const int irow = 16 * w + fr; const float aci = acum_s[irow];
#pragma unroll
        for (int j2 = 0; j2 < 4; ++j2) if (j2 <= (w >> 1)) { bf16x8 bf[2][4]; f32x4 acj[2];
#pragma unroll
            for (int h = 0; h < 2; ++h) {
#pragma unroll
                for (int ks = 0; ks < 4; ++ks) bf[h][ks] = ldfrag(Bi, 16 * (2 * j2 + h), ks, fr, fq);
                acj[h] = *(const LAS f32x4*)(acum_s + 16 * (2 * j2 + h) + 4 * fq); }
            __builtin_amdgcn_sched_barrier(0); LDS_WAIT(); __builtin_amdgcn_sched_barrier(0);
#pragma unroll
            for (int h = 0; h < 2; ++h) { const int jt = 2 * j2 + h; f32x4 G = (f32x4){0.f, 0.f, 0.f, 0.f};
#pragma unroll
                for (int ks = 0; ks < 4; ++ks) G = MFMA16(bf[h][ks], ca[ks], G);
                const int j0 = 16 * jt + 4 * fq; float wv[4];
#pragma unroll
                for (int r = 0; r < 4; ++r) wv[r] = (j0 + r <= irow) ? G[r] * __expf(aci - acj[h][r]) : 0.f;
                u32x2 o; o.x = cvt_pk_bf16(wv[0], wv[1]); o.y = cvt_pk_bf16(wv[2], wv[3]); *(LAS u32x2*)(Wi + img_off(irow, j0)) = o; }
            __builtin_amdgcn_sched_barrier(0); }
        u32x2 xo[4], zo[4]; const int rg = rowg(c, irow);
        {
#pragma unroll
            for (int pt = 0; pt < 4; ++pt) zo[pt] = *(const u32x2*)(ZS + (size_t)rg * DI + head * 64 + 16 * pt + 4 * fq); }
        f32x4 y[4];
#pragma unroll
        for (int pt = 0; pt < 4; ++pt) y[pt] = (f32x4){0.f, 0.f, 0.f, 0.f};
#pragma unroll
        for (int kh = 0; kh < 2; ++kh) { bf16x8 hb[2][4];
#pragma unroll
            for (int k2 = 0; k2 < 2; ++k2)
#pragma unroll
                for (int pt = 0; pt < 4; ++pt) hb[k2][pt] = ldfrag(Hi, 16 * pt, 2 * kh + k2, fr, fq);
            __builtin_amdgcn_sched_barrier(0); LDS_WAIT(); __builtin_amdgcn_sched_barrier(0);
#pragma unroll
            for (int k2 = 0; k2 < 2; ++k2)
#pragma unroll
                for (int pt = 0; pt < 4; ++pt) y[pt] = MFMA16(hb[k2][pt], ca[2 * kh + k2], y[pt]);
            __builtin_amdgcn_sched_barrier(0); }
        const float eai = ea_s[irow];
#pragma unroll
        for (int pt = 0; pt < 4; ++pt) y[pt] = y[pt] * eai;
        LDS_WAIT();
#pragma unroll
        for (int kh = 0; kh < 2; ++kh) if (2 * kh <= (w >> 1)) { bf16x8 wa[2], xb[2][4];
#pragma unroll
            for (int k2 = 0; k2 < 2; ++k2) { wa[k2] = ldfrag(Wi, 16 * w, 2 * kh + k2, fr, fq);
#pragma unroll
                for (int pt = 0; pt < 4; ++pt) xb[k2][pt] = trfrag128(XDi, 16 * pt, 2 * kh + k2, lq); }
            __builtin_amdgcn_sched_barrier(0); LDS_WAIT(); __builtin_amdgcn_sched_barrier(0);
#pragma unroll
            for (int k2 = 0; k2 < 2; ++k2) if (2 * kh + k2 <= (w >> 1))
#pragma unroll
                for (int pt = 0; pt < 4; ++pt) y[pt] = MFMA16(xb[k2][pt], wa[k2], y[pt]);
            __builtin_amdgcn_sched_barrier(0); }
        { float ssq = 0.f; const float dti = dt_s[irow], rdt = dti > 0.f ? 1.0f / dti : 0.f;
#pragma unroll
            for (int pt = 0; pt < 4; ++pt) xo[pt] = *(const LAS u32x2*)(XDi + irow * 128 + ((((2 * pt + (fq >> 1)) ^ irow) & 7) << 4) + ((fq & 1) << 3));
#pragma unroll
            for (int pt = 0; pt < 4; ++pt) { const float x4[4] = {bf_lo(xo[pt].x) * rdt, bf_hi(xo[pt].x) * rdt, bf_lo(xo[pt].y) * rdt, bf_hi(xo[pt].y) * rdt}, z4[4] = {bf_lo(zo[pt].x), bf_hi(zo[pt].x), bf_lo(zo[pt].y), bf_hi(zo[pt].y)}; float gv[4];
#pragma unroll
                for (int r = 0; r < 4; ++r) { gv[r] = (y[pt][r] + Dh * x4[r]) * z4[r]; ssq += gv[r] * gv[r]; }
                u32x2 o; o.x = cvt_pk_bf16(gv[0], gv[1]); o.y = cvt_pk_bf16(gv[2], gv[3]); *(u32x2*)(YG + (size_t)rg * K2 + head * 64 + 16 * pt + 4 * fq) = o; }
            ssq += __shfl_xor(ssq, 16); ssq += __shfl_xor(ssq, 32);
            if (fq == 0) SSQ[(size_t)rg * 64 + head] = ssq; }
        }
    }
    { const int fr = lane & 15, fq = lane >> 4; float* so = a.out + O_NSSMP + (size_t)(b * NH + head) * HP * NS;
#pragma unroll
    for (int pt = 0; pt < 4; ++pt) *(f32x4*)(so + (size_t)(16 * pt + fr) * NS + 16 * w + 4 * fq) = st[pt]; }
}

__device__ __forceinline__ void phase_ssd_sample(const Args& a, LAS unsigned char* lds, int G) {
    const int tid = threadIdx.x, u = tid >> 8, tt = tid & 255, pq = tt >> 3, nq = tid & 7, p0 = 2 * pq;
    const bf16_t* XC = (const bf16_t*)(a.ws + W_XC); const float* DT = (const float*)(a.ws + W_DT); bf16_t* Y = (bf16_t*)(a.ws + W_A2);
    const bf16_t* ZSp = (const bf16_t*)(a.ws + W_ZS); float* SSQp = (float*)(a.ws + W_SSQ);
    constexpr int BCR = 160;
    constexpr int BUF = 8 * 64 + 2 * 8 * BCR + 16 + 8 * 64;
    const int nit = (DECB * NH - (int)blockIdx.x + G - 1) / G;
    const float dsk_l = a.in[I_DSKIP][tid & 63], al_l = a.in[I_ALOG][tid & 63];
    const int pcA = tid, pcB = 512 + (tid & 127);
    f32x4 hs[8]; u32x4 pfA, pfB; float pdt; unsigned pzz;
    auto item_of = [&](int kk) -> int { return blockIdx.x + (kk < nit ? kk : nit - 1) * G; };
    auto piece_ptr = [&](int k, int pc) -> const bf16_t* { const int it = item_of(k + pc / 320), seq = it >> 6, head = it & 63, g = head >> 3, r = pc % 320, pi = r / 40, pq40 = r % 40;
        const int col = pq40 < 8 ? head * 64 + pq40 * 8 : (pq40 < 24 ? DI + g * 128 + (pq40 - 8) * 8 : DI + 1024 + g * 128 + (pq40 - 24) * 8); return XC + (size_t)(ROW_S0 + seq * 8 + pi) * CONVD + col; };
    auto issue = [&](int k) { const int it = item_of(k + u), seq = it >> 6, head = it & 63;
        const float* s0 = a.in[I_SSM] + ((size_t)it * HP + p0) * NS + nq * 16;
#pragma unroll
        for (int j = 0; j < 4; ++j) { hs[j] = *(const f32x4*)(s0 + 4 * j); hs[4 + j] = *(const f32x4*)(s0 + NS + 4 * j); }
        pfA = *(const u32x4*)piece_ptr(k, pcA); pfB = *(const u32x4*)piece_ptr(k, pcB);
        pdt = DT[(size_t)(ROW_S0 + seq * 8 + (tid & 7)) * 64 + head];
        pzz = *(const unsigned*)(ZSp + (size_t)(ROW_S0 + seq * 8 + ((tt >> 5) & 7)) * DI + head * 64 + (tt & 31) * 2); };
    auto stash = [&](int pc, const u32x4 v) { const int uu = pc / 320, r = pc % 320, pi = r / 40, q = r % 40; float f[8]; unpack8(v, f);
        LAS float* xs = (LAS float*)lds + uu * BUF; const int hb = q < 24 ? q - 8 : q - 24;
        LAS float* dst = q < 8 ? xs + pi * 64 + q * 8 : (q < 24 ? xs + 512 + pi * BCR + (hb >> 1) * 20 + (hb & 1) * 8 : xs + 512 + 8 * BCR + pi * BCR + (hb >> 1) * 20 + (hb & 1) * 8);
        *(LAS f32x4*)dst = (f32x4){f[0], f[1], f[2], f[3]}; *(LAS f32x4*)(dst + 4) = (f32x4){f[4], f[5], f[6], f[7]}; };
    issue(0);
    for (int k = 0; k < nit; k += 2) {
        const int it = item_of(k + u), seq = it >> 6, head = it & 63; const bool live = k + u < nit;
        LAS float* xs = (LAS float*)lds + u * BUF; LAS float* Bs = xs + 512; LAS float* Cs = Bs + 8 * BCR; LAS float* dts = Cs + 8 * BCR; LAS float* das = dts + 8; LAS float* ys = das + 8;
        f32x2 h2[2][8];
#pragma unroll
        for (int r = 0; r < 2; ++r)
#pragma unroll
            for (int j = 0; j < 4; ++j) { h2[r][2 * j] = (f32x2){hs[4 * r + j][0], hs[4 * r + j][1]}; h2[r][2 * j + 1] = (f32x2){hs[4 * r + j][2], hs[4 * r + j][3]}; }
        stash(pcA, pfA); if (tid < 128) stash(pcB, pfB);
        const float Dh = __shfl(dsk_l, head), alh = __shfl(al_l, head); const unsigned zz = pzz;
        if ((tid & 255) < 8) { dts[tid & 7] = pdt; das[tid & 7] = __expf(-pdt * __expf(alh)); }
        LDS_BARRIER();
        issue(k + 2);
        float ya[2][8];
#pragma unroll
        for (int i = 0; i < 8; ++i) {
            const f32x2 xv = *(const LAS f32x2*)(xs + i * 64 + p0); const float dtv = dts[i], av = das[i]; const float xd0 = xv[0] * dtv, xd1 = xv[1] * dtv; f32x2 y0 = (f32x2){0.f, 0.f}, y1 = y0;
#pragma unroll
            for (int j = 0; j < 4; ++j) { const f32x4 bb = *(const LAS f32x4*)(Bs + i * BCR + nq * 20 + 4 * j), cc = *(const LAS f32x4*)(Cs + i * BCR + nq * 20 + 4 * j);
                const f32x2 bl = (f32x2){bb[0], bb[1]}, bh = (f32x2){bb[2], bb[3]}, cl = (f32x2){cc[0], cc[1]}, ch = (f32x2){cc[2], cc[3]};
                h2[0][2 * j] = h2[0][2 * j] * av + bl * xd0; h2[0][2 * j + 1] = h2[0][2 * j + 1] * av + bh * xd0; y0 = y0 + cl * h2[0][2 * j]; y0 = y0 + ch * h2[0][2 * j + 1];
                h2[1][2 * j] = h2[1][2 * j] * av + bl * xd1; h2[1][2 * j + 1] = h2[1][2 * j + 1] * av + bh * xd1; y1 = y1 + cl * h2[1][2 * j]; y1 = y1 + ch * h2[1][2 * j + 1]; }
            ya[0][i] = y0[0] + y0[1]; ya[1][i] = y1[0] + y1[1];
        }
#pragma unroll
        for (int r = 0; r < 2; ++r) { float t4[4], t2[2], t1;
#pragma unroll
            for (int i = 0; i < 4; ++i) { const float keep = (nq & 4) ? ya[r][i + 4] : ya[r][i], send = (nq & 4) ? ya[r][i] : ya[r][i + 4]; t4[i] = keep + __shfl_xor(send, 4); }
#pragma unroll
            for (int i = 0; i < 2; ++i) { const float keep = (nq & 2) ? t4[i + 2] : t4[i], send = (nq & 2) ? t4[i] : t4[i + 2]; t2[i] = keep + __shfl_xor(send, 2); }
            { const float keep = (nq & 1) ? t2[1] : t2[0], send = (nq & 1) ? t2[0] : t2[1]; t1 = keep + __shfl_xor(send, 1); }
            ys[nq * 64 + p0 + r] = t1 + Dh * xs[nq * 64 + p0 + r]; }
        if (live) { float* so = a.out + O_NSSMS + ((size_t)it * HP + p0) * NS + nq * 16;
#pragma unroll
            for (int r = 0; r < 2; ++r)
#pragma unroll
                for (int j = 0; j < 4; ++j) *(f32x4*)(so + r * NS + 4 * j) = (f32x4){h2[r][2 * j][0], h2[r][2 * j][1], h2[r][2 * j + 1][0], h2[r][2 * j + 1][1]}; }
        LDS_BARRIER();
        if (live) { const int i = tt >> 5, pp = (tt & 31) * 2; const size_t ro = (size_t)(ROW_S0 + seq * 8 + i);
            const float g0 = ys[i * 64 + pp] * bf_lo(zz), g1 = ys[i * 64 + pp + 1] * bf_hi(zz); float sq = g0 * g0 + g1 * g1;
            *(unsigned*)(Y + ro * K2 + head * 64 + pp) = cvt_pk_bf16(g0, g1);
            sq += __shfl_xor(sq, 1); sq += __shfl_xor(sq, 2); sq += __shfl_xor(sq, 4); sq += __shfl_xor(sq, 8); sq += __shfl_xor(sq, 16);
            if ((tt & 31) == 0) SSQp[ro * 64 + head] = sq; }
        LDS_BARRIER();
    }
}
__device__ __forceinline__ void phase_ssd(const Args& a, LAS unsigned char* lds, int G) {
    for (int it = blockIdx.x; it < NB * NH; it += G) { const int v = (G == 256) ? (it & 7) * 32 + (it >> 3) : it; ssd_prompt_item(a, lds, v >> 6, v & 63); }
    __syncthreads();
    phase_ssd_sample(a, lds, G);
}

struct SmallAcc { f32x4 v[2][2]; };
template <class Off, class Hook, class Pre>
__device__ __forceinline__ void small_gemm_kloop(LAS unsigned char* lds, const bf16_t* A, const bf16_t* Bt, int ld, int nks, SmallAcc& acc, Off koff, Hook hook, Pre pre) {
    const int tid = threadIdx.x, lane = tid & 63, w = __builtin_amdgcn_readfirstlane(tid >> 6), wm = w >> 1, wn = w & 1, fr = lane & 15, fq = lane >> 4;
    constexpr int ABYTES = 128 * 256, BUFB = ABYTES + 64 * 256;
    const int lr = lane >> 4, lc = (lane & 15) ^ ((4 * w + lr) & 15);
    const bf16_t* ga = A + (size_t)(4 * w + lr) * ld + lc * 8; const bf16_t* gb = Bt + (size_t)(4 * w + lr) * ld + lc * 8; const size_t r32 = (size_t)32 * ld;
    const unsigned lw = (unsigned)w * 1024u;
#define SG_ISSUE(kt, bufi) do { const int _kt = (kt) < nks ? (kt) : nks - 1; LAS unsigned char* _b = lds + (bufi) * BUFB + lw; const int _ko = koff(_kt); \
        _Pragma("unroll") for (int _i = 0; _i < 4; ++_i) __builtin_amdgcn_global_load_lds((const unsigned*)(ga + _i * r32 + _ko), (LAS unsigned*)(_b + _i * 8192), 16, 0, 0); \
        _Pragma("unroll") for (int _i = 0; _i < 2; ++_i) __builtin_amdgcn_global_load_lds((const unsigned*)(gb + _i * r32 + _ko), (LAS unsigned*)(_b + ABYTES + _i * 8192), 16, 0, 0); } while (0)
    SG_ISSUE(0, 0); SG_ISSUE(1, 1);
    pre();
    int bi = 0;
    for (int k = 0; k < nks; ++k) {
        asm volatile("s_waitcnt vmcnt(6)" ::: "memory");
        __builtin_amdgcn_s_barrier();
        asm volatile("" ::: "memory");
        const int bn = bi == 0 ? 2 : bi - 1;
        SG_ISSUE(k + 2, bn);
        const LAS unsigned char* cur = lds + bi * BUFB;
        bf16x8 af[2][2][2], bfm[2][2][2];
#pragma unroll
        for (int hk = 0; hk < 2; ++hk) {
#pragma unroll
            for (int ks = 0; ks < 2; ++ks)
#pragma unroll
                for (int i = 0; i < 2; ++i) { const int ra = 32 * wm + 16 * i + fr, rbw = 32 * wn + 16 * i + fr, ch = 8 * hk + 4 * ks + fq;
                    af[hk][ks][i] = *(const LAS bf16x8*)(cur + ra * 256 + (((ch ^ ra) & 15) << 4)); bfm[hk][ks][i] = *(const LAS bf16x8*)(cur + ABYTES + rbw * 256 + (((ch ^ rbw) & 15) << 4)); }
            __builtin_amdgcn_sched_barrier(0);
        }
        asm volatile("s_waitcnt lgkmcnt(8)" ::: "memory");
        __builtin_amdgcn_sched_barrier(0);
#pragma unroll
        for (int ks = 0; ks < 2; ++ks)
#pragma unroll
            for (int mb = 0; mb < 2; ++mb)
#pragma unroll
                for (int nb = 0; nb < 2; ++nb) acc.v[mb][nb] = __builtin_amdgcn_mfma_f32_16x16x32_bf16(bfm[0][ks][nb], af[0][ks][mb], acc.v[mb][nb], 0, 0, 0);
        __builtin_amdgcn_sched_barrier(0);
        asm volatile("s_waitcnt lgkmcnt(0)" ::: "memory");
        __builtin_amdgcn_sched_barrier(0);
#pragma unroll
        for (int ks = 0; ks < 2; ++ks)
#pragma unroll
            for (int mb = 0; mb < 2; ++mb)
#pragma unroll
                for (int nb = 0; nb < 2; ++nb) acc.v[mb][nb] = __builtin_amdgcn_mfma_f32_16x16x32_bf16(bfm[1][ks][nb], af[1][ks][mb], acc.v[mb][nb], 0, 0, 0);
        hook(k, acc);
        bi = bi == 2 ? 0 : bi + 1;
    }
    asm volatile("s_waitcnt vmcnt(0)" ::: "memory");
    __builtin_amdgcn_s_barrier();
    asm volatile("" ::: "memory");
#undef SG_ISSUE
}
__device__ __forceinline__ void small_gemm2_tile(const Args& a, LAS unsigned char* lds, int tm, int tn) {
    const int tid = threadIdx.x, lane = tid & 63, w = __builtin_amdgcn_readfirstlane(tid >> 6), wm = w >> 1, wn = w & 1, fr = lane & 15, fq = lane >> 4;
    const bf16_t* A2 = (const bf16_t*)(a.ws + W_A2) + (size_t)(ROW_S0 + 128 * tm) * K2; const bf16_t* WT2 = (const bf16_t*)(a.ws + W_WT2) + (size_t)(64 * tn) * K2;
    const bf16_t* SGA = (const bf16_t*)(a.ws + W_SGA); const bf16_t* SGR = (const bf16_t*)(a.ws + W_SGR); bf16_t* MG = (bf16_t*)(a.ws + W_MERGED); const float* SSQ = (const float*)(a.ws + W_SSQ);
    float rs[2][8];
    u32x2 rr[2][2];
    SmallAcc acc;
#pragma unroll
    for (int mb = 0; mb < 2; ++mb)
#pragma unroll
        for (int nb = 0; nb < 2; ++nb) acc.v[mb][nb] = (f32x4){0.f, 0.f, 0.f, 0.f};
    small_gemm_kloop(lds, A2, WT2, K2, 48, acc,
        [](int k) { return k < 16 ? DI + 128 * k : 128 * (k - 16); },
        [&](int k, SmallAcc& ac) {
            if (k == 15) {
#pragma unroll
                for (int mb = 0; mb < 2; ++mb) { const float t0 = 1.0f / rs[mb][0];
#pragma unroll
                    for (int nb = 0; nb < 2; ++nb) { f32x4& v = ac.v[mb][nb]; const u32x2 r = rr[mb][nb]; v = (f32x4){v[0] * bf_lo(r.x) * t0, v[1] * bf_hi(r.x) * t0, v[2] * bf_lo(r.y) * t0, v[3] * bf_hi(r.y) * t0}; } } }
            else if (k >= 19 && k < 47 && ((k - 19) & 3) == 0) { const int g = (k - 19) >> 2;
#pragma unroll
                for (int mb = 0; mb < 2; ++mb) { float tf = 0.f;
#pragma unroll
                    for (int gg = 0; gg < 7; ++gg) tf = (g == gg) ? rs[mb][gg] / rs[mb][gg + 1] : tf;
#pragma unroll
                    for (int nb = 0; nb < 2; ++nb) ac.v[mb][nb] = ac.v[mb][nb] * tf; } } },
        [&]() {
#pragma unroll
    for (int mb = 0; mb < 2; ++mb) { const float* sp = SSQ + (size_t)(ROW_S0 + 128 * tm + 32 * wm + 16 * mb + fr) * 64;
#pragma unroll
        for (int g = 0; g < 8; ++g) { const f32x4 q0 = *(const f32x4*)(sp + 8 * g), q1 = *(const f32x4*)(sp + 8 * g + 4); const float sm = ((q0[0] + q0[1]) + (q0[2] + q0[3])) + ((q1[0] + q1[1]) + (q1[2] + q1[3])); rs[mb][g] = 1.0f / sqrtf(sm * (1.0f / 512.0f) + EPS); } }
#pragma unroll
    for (int mb = 0; mb < 2; ++mb)
#pragma unroll
        for (int nb = 0; nb < 2; ++nb) rr[mb][nb] = *(const u32x2*)(SGR + (size_t)(ROW_S0 + 128 * tm + 32 * wm + 16 * mb + fr) * D + 64 * tn + 32 * wn + 16 * nb + 4 * fq);
#pragma unroll
        for (int mb = 0; mb < 2; ++mb)
#pragma unroll
            for (int nb = 0; nb < 2; ++nb) asm volatile("" : "+v"(rr[mb][nb].x), "+v"(rr[mb][nb].y));
        });
#pragma unroll
    for (int mb = 0; mb < 2; ++mb)
#pragma unroll
        for (int nb = 0; nb < 2; ++nb) { const size_t off = (size_t)(ROW_S0 + 128 * tm + 32 * wm + 16 * mb + fr) * D + 64 * tn + 32 * wn + 16 * nb + 4 * fq; const u32x2 g = *(const u32x2*)(SGA + off); const float t8 = rs[mb][7];
            const f32x4 v = acc.v[mb][nb]; u32x2 o; o.x = cvt_pk_bf16(v[0] * bf_lo(g.x) * t8, v[1] * bf_hi(g.x) * t8); o.y = cvt_pk_bf16(v[2] * bf_lo(g.y) * t8, v[3] * bf_hi(g.y) * t8); *(u32x2*)(MG + off) = o; }
}
__device__ __forceinline__ void small_gemm3_tile(const Args& a, LAS unsigned char* lds, int tm, int tn) {
    const int tid = threadIdx.x, lane = tid & 63, w = __builtin_amdgcn_readfirstlane(tid >> 6), wm = w >> 1, wn = w & 1, fr = lane & 15, fq = lane >> 4;
    const bf16_t* MG = (const bf16_t*)(a.ws + W_MERGED) + (size_t)(ROW_S0 + 128 * tm) * D; const bf16_t* WT3 = (const bf16_t*)(a.ws + W_WT3) + (size_t)(64 * tn) * D;
    float* PS2 = (float*)(a.ws + W_PS2); unsigned* cnt = (unsigned*)(a.ws + W_CTL + CTL_PANEL2) + 64 * tm;
    LDS_BARRIER();
    SmallAcc acc;
#pragma unroll
    for (int mb = 0; mb < 2; ++mb)
#pragma unroll
        for (int nb = 0; nb < 2; ++nb) acc.v[mb][nb] = (f32x4){0.f, 0.f, 0.f, 0.f};
    f32x4 xv[2][2], fw[2];
#pragma unroll
    for (int mb = 0; mb < 2; ++mb)
#pragma unroll
        for (int nb = 0; nb < 2; ++nb) xv[mb][nb] = *(const f32x4*)(a.in[I_XS] + (size_t)(128 * tm + 32 * wm + 16 * mb + fr) * D + 64 * tn + 32 * wn + 16 * nb + 4 * fq);
#pragma unroll
    for (int nb = 0; nb < 2; ++nb) fw[nb] = *(const f32x4*)(a.in[I_FNW] + 64 * tn + 32 * wn + 16 * nb + 4 * fq);
    small_gemm_kloop(lds, MG, WT3, D, D / 128, acc, [](int k) { return 128 * k; }, [](int, SmallAcc&) {}, []() {});
    LAS float* P = (LAS float*)lds;
    LAS float* Sc = P + 256;
#pragma unroll
    for (int mb = 0; mb < 2; ++mb) { const int rl = 32 * wm + 16 * mb + fr; float sq = 0.f;
#pragma unroll
        for (int nb = 0; nb < 2; ++nb) { f32x4& v = acc.v[mb][nb]; v = v + xv[mb][nb]; sq += (v[0] * v[0] + v[1] * v[1]) + (v[2] * v[2] + v[3] * v[3]); }
        sq += __shfl_xor(sq, 16); sq += __shfl_xor(sq, 32);
        if (fq == 0) P[rl * 2 + wn] = sq; }
    LDS_BARRIER();
    if (tid < 128) __hip_atomic_store(PS2 + (size_t)(128 * tm + tid) * 32 + tn, P[tid * 2] + P[tid * 2 + 1], __ATOMIC_RELAXED, __HIP_MEMORY_SCOPE_AGENT);
    asm volatile("s_waitcnt vmcnt(0)" ::: "memory");
    if (tid < 128 && (tid & 63) == 0) __hip_atomic_fetch_add(cnt, 1u, __ATOMIC_RELAXED, __HIP_MEMORY_SCOPE_AGENT);
    if (w == 0) { unsigned spins = 0;
        while ((unsigned)__builtin_amdgcn_readfirstlane(__hip_atomic_load(cnt, __ATOMIC_RELAXED, __HIP_MEMORY_SCOPE_AGENT)) < 64u) { __builtin_amdgcn_s_sleep(2); if (++spins > (1u << 22)) break; }
        __builtin_amdgcn_fence(__ATOMIC_ACQUIRE, "agent");
        asm volatile("s_waitcnt vmcnt(0)" ::: "memory"); }
    LDS_BARRIER();
    if (tid < 128) { const float* pp = PS2 + (size_t)(128 * tm + tid) * 32; float sm = 0.f;
#pragma unroll
        for (int t = 0; t < 32; ++t) sm += __hip_atomic_load(pp + t, __ATOMIC_RELAXED, __HIP_MEMORY_SCOPE_AGENT);
        Sc[tid] = 1.0f / sqrtf(sm * (1.0f / D) + EPS); }
    LDS_BARRIER();
#pragma unroll
    for (int mb = 0; mb < 2; ++mb) { const int rl = 32 * wm + 16 * mb + fr; const float rs = Sc[rl];
#pragma unroll
        for (int nb = 0; nb < 2; ++nb) { const int col = 64 * tn + 32 * wn + 16 * nb + 4 * fq;
            *(f32x4*)(a.out + O_YS + (size_t)(128 * tm + rl) * D + col) = acc.v[mb][nb] * rs * fw[nb]; } }
    LDS_BARRIER();
}

constexpr int N_PHASES = 6;
__global__ void __launch_bounds__(512, 2) fwd_kernel(Args a) {
    extern __shared__ __attribute__((aligned(16))) unsigned char lds_raw[];
    LAS unsigned char* lds = (LAS unsigned char*)lds_raw;
    const int G = gridDim.x; const int lo = a.ph_lo, hi = a.ph_hi;
#define IN(k) (lo <= (k) && (k) < hi)
    volatile LAS unsigned* misc = (volatile LAS unsigned*)(lds + LDS_MISC);
    if (threadIdx.x < 16) misc[threadIdx.x] = 0u;
    __syncthreads();
    XcdBarrier bar; bar.bar = (unsigned*)(a.ws + W_CTL); bar.x = 0; bar.st = misc;
    if (hi - lo > 1) bar = xcd_barrier_post((unsigned*)(a.ws + W_CTL), misc);
#define SEAM(k) do { if (IN(k) && IN((k) + 1)) xcd_barrier(bar); } while (0)
    if (IN(0)) phase_prep(a, lds, G);
    SEAM(0);
    if (IN(1)) {
        if (G == 256) { const int c = blockIdx.x, x = c & 7, j = c >> 3, wv = __builtin_amdgcn_readfirstlane(threadIdx.x >> 6);
            constexpr int REM = ((MP / 256) * (NP1 / 256)) % 256, B0 = PREP_I1 + PRE_IN_PREP, NL = (256 - REM) * 32, PXH = (PREP_I23 - PRE_IN_PREP - NL) / 8;
            static_assert(PXH == 220, "item split");
            if (c >= REM) transpose_range(a, lds, B0 + (c - REM) * 32 + wv, 8, B0 + (c - REM) * 32 + 32);
            else { const int n = ((REM - 1 - x) >> 3) + 1, S = n * (n - 1) / 2, R = PXH - 4 * n;
                const int off = 4 * j + (R * (j * (j - 1) / 2)) / S, nj = 4 * (j + 1) + (R * (j * (j + 1) / 2)) / S - off;
                transpose_range(a, lds, B0 + NL + x * PXH + off + wv, 8, B0 + NL + x * PXH + off + nj); } }
        else if ((G & 7) == 0) { const int x = blockIdx.x & 7, wpx = (G >> 3) * 8, wi = (blockIdx.x >> 3) * 8 + __builtin_amdgcn_readfirstlane(threadIdx.x >> 6);
            const int off = (PREP_I23 * (x * (x - 1) / 2)) / 28, nx = (PREP_I23 * (x * (x + 1) / 2)) / 28 - off;
            transpose_range(a, lds, PREP_I1 + off + wi, wpx, PREP_I1 + off + nx); }
        else transpose_range(a, lds, PREP_I1 + blockIdx.x * 8 + __builtin_amdgcn_readfirstlane(threadIdx.x >> 6), G * 8, PREP_I1 + PREP_I23);
        asm volatile("s_waitcnt vmcnt(0)" ::: "memory"); __syncthreads();
        pg8::Gemm g{(const bf16_t*)(a.ws + W_H), (const bf16_t*)(a.ws + W_WT1), D, 0, D / 64, 0, 0}; pg8::StaticOrder S; S.init(MP, NP1, G, (int)blockIdx.x);
        Epi1 E{(bf16_t*)(a.ws + W_ZS), (bf16_t*)(a.ws + W_XBC), (bf16_t*)(a.ws + W_U), (bf16_t*)(a.ws + W_GB), (bf16_t*)(a.ws + W_SGA), (bf16_t*)(a.ws + W_SGR), (float*)(a.ws + W_DT), a.in[I_DTB], a.out};
        pg8::gemm_phase<Epi1, pg8::StaticOrder, true, true>(lds, g, S, E);
    }
    SEAM(1);
    if (IN(2)) phase_conv(a, G);
    SEAM(2);
    if (IN(3)) phase_ssd(a, lds, G);
    SEAM(3);
    if (IN(4)) {
        pg8::Gemm g{(const bf16_t*)(a.ws + W_A2), (const bf16_t*)(a.ws + W_WT2), K2, DI, D / 64, 512, 8}; pg8::SegOrder<9> S; S.init(ROW_S0, D, G, (int)blockIdx.x);
        Epi2 E{(const bf16_t*)(a.ws + W_SGA), (const bf16_t*)(a.ws + W_SGR), (bf16_t*)(a.ws + W_MERGED), lds};
        { pg8::Unit u0; if (S.next(0, u0)) build_rs_table(lds, (const float*)(a.ws + W_SSQ), u0.pm); }
        __syncthreads();
        pg8::gemm_phase<Epi2, pg8::SegOrder<9>, true, true>(lds, g, S, E);
        for (int t = blockIdx.x; t < 256; t += G) small_gemm2_tile(a, lds, t >> 5, t & 31);
    }
    SEAM(4);
    if (IN(5)) {
        pg8::Gemm g{(const bf16_t*)(a.ws + W_MERGED), (const bf16_t*)(a.ws + W_WT3), D, 0, D / 64, 0, 0}; pg8::StaticOrder S; S.init(ROW_S0, D, G, (int)blockIdx.x);
        EpiOutNorm E{a.in[I_XP], a.in[I_FNW], a.out, (float*)(a.ws + W_PS), (unsigned*)(a.ws + W_CTL + CTL_PANEL)};
        pg8::gemm_phase<EpiOutNorm, pg8::StaticOrder, true, true>(lds, g, S, E);
        for (int t = blockIdx.x; t < 256; t += G) small_gemm3_tile(a, lds, t >> 5, t & 31);
    }
#undef IN
}

extern "C" void kernel_launch(void* const* d_in, const int* in_sizes, int n_in, void* d_out, int out_size, void* d_ws, size_t ws_size, hipStream_t stream) {
    static int grid = 0;
    if (grid == 0) {
        int dev = 0, cus = 0;
        if (n_in != 19 || ws_size < W_END) { fprintf(stderr, "kernel_launch: unexpected n_in %d or ws_size %zu (< %zu)\n", n_in, ws_size, (size_t)W_END); grid = -1; return; }
        if (hipGetDevice(&dev) != hipSuccess || hipDeviceGetAttribute(&cus, hipDeviceAttributeMultiprocessorCount, dev) != hipSuccess) { grid = -1; return; }
        if (hipFuncSetAttribute((const void*)fwd_kernel, hipFuncAttributeMaxDynamicSharedMemorySize, LDS_BYTES) != hipSuccess) { fprintf(stderr, "kernel_launch: hipFuncSetAttribute failed\n"); grid = -1; return; }
        int per_cu = 0; (void)hipOccupancyMaxActiveBlocksPerMultiprocessor(&per_cu, (const void*)fwd_kernel, 512, LDS_BYTES); (void)hipGetLastError();
        if (per_cu < 1) fprintf(stderr, "kernel_launch: occupancy query says %d blocks per CU\n", per_cu);
        grid = cus;
    }
    if (grid < 0) return;
    Args a{};
    for (int i = 0; i < 19; ++i) a.in[i] = (const float*)d_in[i];
    a.out = (float*)d_out; a.ws = (unsigned char*)d_ws;
    a.ph_lo = 0; a.ph_hi = N_PHASES;
    (void)hipMemsetAsync((unsigned char*)d_ws + W_CTL, 0, CTL_BYTES, stream);
    hipLaunchKernelGGL(fwd_kernel, dim3(grid), dim3(512), LDS_BYTES, stream, a);
}
```

```cpp
#include <hip/hip_runtime.h>
#include <cstdio>
#include <cstdint>

#define LAS __attribute__((address_space(3)))
typedef unsigned short bf16_t;
typedef short bf16x8 __attribute__((ext_vector_type(8)));
typedef float f32x4 __attribute__((ext_vector_type(4)));
typedef float f32x2 __attribute__((ext_vector_type(2)));
typedef unsigned u32x4 __attribute__((ext_vector_type(4)));
typedef unsigned u32x2 __attribute__((ext_vector_type(2)));

constexpr int D = 2048, NB = 4, SEQ = 2048, META = 16, DECB = 128, DECS = 8;
constexpr int DI = 4096, NH = 64, HP = 64, NS = 128, NG = 8, CONVD = 6144, SCW = 2048, PROJ = 22592;
constexpr float EPS = 1e-6f;
constexpr int ROW_S0 = 8192, ROW_M0 = 9216, M_REAL = 9232, MP = 9472, M_OUT = 9216;
constexpr int NP1 = 89 * 256;
constexpr int C_XBC = 4096, C_DT = 10240, C_SC = 10304, C_G = 18496;
constexpr size_t O_YP = 0, O_YS = 16777216, O_NCP = 18874368, O_NSSMP = 18948096, O_NSCP = 21045248, O_NCS = 21061632, O_NSSMS = 23420928, O_NSCS = 90529792;
constexpr size_t SZ_R2K = (size_t)MP * 2048 * 2;
constexpr size_t W_H = 0;
constexpr size_t W_WT1 = W_H + SZ_R2K;
constexpr int K2 = 6144;
constexpr size_t W_WT2 = W_WT1 + (size_t)NP1 * 2048 * 2;
constexpr size_t W_WT3 = W_WT2 + (size_t)2048 * K2 * 2;
constexpr size_t W_ZS = W_WT3 + (size_t)2048 * 2048 * 2;
constexpr size_t W_XBC = W_ZS + (size_t)MP * 4096 * 2;
constexpr size_t W_DT = W_XBC + (size_t)MP * 6144 * 2;
constexpr size_t W_U = W_DT + (size_t)MP * 64 * 4;
constexpr size_t W_GB = W_U + SZ_R2K;
constexpr size_t W_SGA = W_GB + SZ_R2K;
constexpr size_t W_SGR = W_SGA + SZ_R2K;
constexpr size_t W_XC = W_SGR + SZ_R2K;
constexpr size_t W_A2 = W_XC + (size_t)MP * 6144 * 2;
constexpr size_t W_MERGED = W_A2 + (size_t)MP * K2 * 2;
constexpr size_t W_CTL = W_MERGED + SZ_R2K;
constexpr size_t CTL_BYTES = 32768;
constexpr size_t CTL_PANEL = 16384, CTL_PANEL2 = 24576;
constexpr size_t W_SSQ = W_CTL + CTL_BYTES;
constexpr size_t W_PS = W_SSQ + (size_t)MP * 64 * 4;
constexpr size_t W_PS2 = W_PS + (size_t)ROW_S0 * 8 * 4;
constexpr size_t W_END = W_PS2 + (size_t)1024 * 32 * 4;
constexpr size_t W_OUTP = W_XBC;

constexpr int LDS_BYTES = 163840;
constexpr int LDS_MISC = 163840 - 64;

typedef __bf16 bf16x2v __attribute__((ext_vector_type(2)));
__device__ __forceinline__ unsigned cvt_pk_bf16(float lo, float hi) { f32x2 v = {lo, hi}; bf16x2v b = __builtin_convertvector(v, bf16x2v); return __builtin_bit_cast(unsigned, b); }
__device__ __forceinline__ float bf_lo(unsigned w) { return __uint_as_float(w << 16); }
__device__ __forceinline__ float bf_hi(unsigned w) { return __uint_as_float(w & 0xffff0000u); }
__device__ __forceinline__ float fsigmoid(float x) { return __builtin_amdgcn_rcpf(1.0f + __expf(-x)); }
__device__ __forceinline__ float fsilu(float x) { return x * fsigmoid(x); }
__device__ __forceinline__ f32x4 silu4(const f32x4 v) {
    const f32x2 xa = (f32x2){v[0], v[1]}, xb = (f32x2){v[2], v[3]}, cs = (f32x2){-1.44269504088896f, -1.44269504088896f}, one = (f32x2){1.0f, 1.0f};
    const f32x2 ta = xa * cs, tb = xb * cs;
    const float e0 = __builtin_amdgcn_exp2f(ta[0]), e1 = __builtin_amdgcn_exp2f(ta[1]), e2 = __builtin_amdgcn_exp2f(tb[0]), e3 = __builtin_amdgcn_exp2f(tb[1]);
    const f32x2 ua = (f32x2){e0, e1} + one, ub = (f32x2){e2, e3} + one;
    const float r0 = __builtin_amdgcn_rcpf(ua[0]), r1 = __builtin_amdgcn_rcpf(ua[1]), r2 = __builtin_amdgcn_rcpf(ub[0]), r3 = __builtin_amdgcn_rcpf(ub[1]);
    const f32x2 ya = xa * (f32x2){r0, r1}, yb = xb * (f32x2){r2, r3};
    return (f32x4){ya[0], ya[1], yb[0], yb[1]};
}
__device__ __forceinline__ void gate4(const f32x4 ga4, const f32x4 gb4, float* sa, float* rt) {
    const f32x2 cs = (f32x2){-1.44269504088896f, -1.44269504088896f}, one = (f32x2){1.0f, 1.0f};
    f32x2 a0 = (f32x2){fminf(fmaxf(ga4[0], -30.f), 30.f), fminf(fmaxf(ga4[1], -30.f), 30.f)}, a1 = (f32x2){fminf(fmaxf(ga4[2], -30.f), 30.f), fminf(fmaxf(ga4[3], -30.f), 30.f)};
    f32x2 b0 = (f32x2){fminf(fmaxf(gb4[0], -30.f), 30.f), fminf(fmaxf(gb4[1], -30.f), 30.f)}, b1 = (f32x2){fminf(fmaxf(gb4[2], -30.f), 30.f), fminf(fmaxf(gb4[3], -30.f), 30.f)};
    a0 = a0 * cs; a1 = a1 * cs; b0 = b0 * cs; b1 = b1 * cs;
    const f32x2 ea0 = (f32x2){__builtin_amdgcn_exp2f(a0[0]), __builtin_amdgcn_exp2f(a0[1])} + one, ea1 = (f32x2){__builtin_amdgcn_exp2f(a1[0]), __builtin_amdgcn_exp2f(a1[1])} + one;
    const f32x2 eb0 = (f32x2){__builtin_amdgcn_exp2f(b0[0]), __builtin_amdgcn_exp2f(b0[1])} + one, eb1 = (f32x2){__builtin_amdgcn_exp2f(b1[0]), __builtin_amdgcn_exp2f(b1[1])} + one;
    sa[0] = __builtin_amdgcn_rcpf(ea0[0]); sa[1] = __builtin_amdgcn_rcpf(ea0[1]); sa[2] = __builtin_amdgcn_rcpf(ea1[0]); sa[3] = __builtin_amdgcn_rcpf(ea1[1]);
    const f32x2 r0 = ea0 * (f32x2){__builtin_amdgcn_rcpf(eb0[0]), __builtin_amdgcn_rcpf(eb0[1])}, r1 = ea1 * (f32x2){__builtin_amdgcn_rcpf(eb1[0]), __builtin_amdgcn_rcpf(eb1[1])};
    rt[0] = r0[0]; rt[1] = r0[1]; rt[2] = r1[0]; rt[3] = r1[1];
}
__device__ __forceinline__ void silu4_pk_bf16(const f32x4 v, unsigned& lo, unsigned& hi) {
    const f32x2 xa = (f32x2){v[0], v[1]}, xb = (f32x2){v[2], v[3]}, cs = (f32x2){-1.44269504088896f, -1.44269504088896f}, one = (f32x2){1.0f, 1.0f};
    const f32x2 ta = xa * cs, tb = xb * cs;
    const float e0 = __builtin_amdgcn_exp2f(ta[0]), e1 = __builtin_amdgcn_exp2f(ta[1]), e2 = __builtin_amdgcn_exp2f(tb[0]), e3 = __builtin_amdgcn_exp2f(tb[1]);
    const f32x2 ua = (f32x2){e0, e1} + one, ub = (f32x2){e2, e3} + one;
    const float r0 = __builtin_amdgcn_rcpf(ua[0]), r1 = __builtin_amdgcn_rcpf(ua[1]), r2 = __builtin_amdgcn_rcpf(ub[0]), r3 = __builtin_amdgcn_rcpf(ub[1]);
    const f32x2 ya = xa * (f32x2){r0, r1}, yb = xb * (f32x2){r2, r3};
    lo = cvt_pk_bf16(ya[0], ya[1]); hi = cvt_pk_bf16(yb[0], yb[1]);
}
__device__ __forceinline__ float wave_sum(float v) {
#pragma unroll
    for (int o = 1; o < 64; o <<= 1) v += __shfl_xor(v, o);
    return v;
}
__device__ __forceinline__ void unpack8(const u32x4 w, float (&f)[8]) {
    f[0] = bf_lo(w.x); f[1] = bf_hi(w.x); f[2] = bf_lo(w.y); f[3] = bf_hi(w.y); f[4] = bf_lo(w.z); f[5] = bf_hi(w.z); f[6] = bf_lo(w.w); f[7] = bf_hi(w.w);
}
__device__ __forceinline__ u32x4 pack8(const float (&f)[8]) {
    u32x4 w; w.x = cvt_pk_bf16(f[0], f[1]); w.y = cvt_pk_bf16(f[2], f[3]); w.z = cvt_pk_bf16(f[4], f[5]); w.w = cvt_pk_bf16(f[6], f[7]); return w;
}
#define LDS_WAIT() asm volatile("s_waitcnt lgkmcnt(0)" ::: "memory")
#define LDS_BARRIER() do { asm volatile("s_waitcnt lgkmcnt(0)" ::: "memory"); __builtin_amdgcn_s_barrier(); asm volatile("" ::: "memory"); } while (0)

namespace pg8 {
constexpr int BM = 256, BK = 64, HALF = 128, HTB = HALF * BK * 2, STAGE_BYTES = 8 * HTB, NXCD = 8, WGM = 8;
__host__ __device__ __forceinline__ int lds_byte(int r, int c) { const int st = (r >> 4) * 2 + (c >> 5), rr = r & 15, cc = c & 31, ob = rr * 64 + cc * 2; return st * 1024 + (ob ^ (((ob >> 9) & 1) << 5)); }
__host__ __device__ __forceinline__ void stage_rc(int b, int& R, int& C) { const int st = b / 1024, sb = b % 1024, swz = sb ^ (((sb >> 9) & 1) << 5); R = (st >> 1) * 16 + swz / 64; C = (st & 1) * 32 + (swz % 64) / 2; }
__host__ __device__ __forceinline__ int perm32(int rho) { const int n = rho >> 4, i = rho & 15; return 8 * (i >> 2) + 4 * n + (i & 3); }
struct Unit { int pm, pn, seg; };
struct Gemm { const bf16_t* A; const bf16_t* Bt; int ldk; int koff0, nt0; int kseg, ntseg;
    __device__ __forceinline__ int koff(int s) const { return s ? (s - 1) * kseg : koff0; } __device__ __forceinline__ int ntiles(int s) const { return s ? ntseg : nt0; } };
struct StaticOrder {
    int nM, nN, nwg, G, c;
    __host__ __device__ void init(int M, int N, int G_, int c_) { nM = M / BM; nN = N / BM; nwg = nM * nN; G = G_; c = c_; }
    __host__ __device__ bool next(int i, Unit& u) const {
        const long L = (long)i * G + c; if (L >= nwg) return false;
        int wgid = (int)L; { const int q = nwg / NXCD, r = nwg % NXCD, xcd = wgid % NXCD, off = wgid / NXCD; wgid = (xcd < r ? xcd * (q + 1) : r * (q + 1) + (xcd - r) * q) + off; }
        const int nig = WGM * nN, gid = wgid / nig, fm = gid * WGM, gsz = (nM - fm) < WGM ? (nM - fm) : WGM;
        u.pm = fm + ((wgid % nig) % gsz); u.pn = (wgid % nig) / gsz; u.seg = 0; return true;
    }
    __device__ __forceinline__ void a_ready(const Unit&) const {}
    __device__ __forceinline__ void done(const Unit&) const {}
};
template <int NSEG> struct SegOrder : StaticOrder {
    __host__ __device__ bool next(int i, Unit& u) const { if (!StaticOrder::next(i / NSEG, u)) return false; u.seg = i % NSEG; return true; }
};

template <class Epi, class Sched, bool ALIGN_EPI = false, bool SP2 = false>
__device__ __forceinline__ void gemm_phase(LAS unsigned char* lds, const Gemm g, const Sched& S, const Epi& E) {
    const int tid = threadIdx.x, wid = __builtin_amdgcn_readfirstlane(tid >> 6), lane = tid & 63, wr = wid >> 2, wc = wid & 3, fr = lane & 15, fq = lane >> 4;
    const int K = g.ldk;
    unsigned voffA[2], voffB[2];
#pragma unroll
    for (int i = 0; i < 2; ++i) { int R, C; stage_rc(tid * 16 + i * 8192, R, C); const int Rb = Epi::PERM ? ((R & ~31) + perm32(R & 31)) : R;
        voffA[i] = (unsigned)(R * K + C) * 2u; voffB[i] = (unsigned)(Rb * K + C) * 2u; }
    const size_t kstep = (size_t)(BK * 2);
    const size_t hstep = (size_t)HALF * K * 2;
    const size_t tstep = 2 * hstep;
    const unsigned ldsw = (unsigned)wid * 1024u;
    const int aoff = lds_byte(wr * 64 + fr, fq * 8), boff = lds_byte(wc * 32 + fr, fq * 8);
#define PG8_SA(b, h) (((b) * 2 + (h)) * HTB)
#define PG8_SB(b, h) ((4 + (b) * 2 + (h)) * HTB)
#define PG8_STAGE(bufoff, gbase, voff) do { _Pragma("unroll") for (int _i = 0; _i < 2; ++_i) \
        __builtin_amdgcn_global_load_lds((const unsigned*)((const char*)(gbase) + (voff)[_i]), (LAS unsigned*)(lds + (bufoff) + ldsw + _i * 8192), 16, 0, 0); } while (0)
#define PG8_LDA(dst, b, h) do { _Pragma("unroll") for (int m = 0; m < 4; ++m) _Pragma("unroll") for (int k = 0; k < 2; ++k) dst[m][k] = *(const LAS bf16x8*)(lds + PG8_SA(b, h) + aoff + m * 2048 + k * 1024); } while (0)
#define PG8_LDB(dst, b, h) do { _Pragma("unroll") for (int n = 0; n < 2; ++n) _Pragma("unroll") for (int k = 0; k < 2; ++k) dst[n][k] = *(const LAS bf16x8*)(lds + PG8_SB(b, h) + boff + n * 2048 + k * 1024); } while (0)
#define PG8_MMA(ai, bj, At, Bt) do { __builtin_amdgcn_s_setprio(1); _Pragma("unroll") for (int m = 0; m < 4; ++m) _Pragma("unroll") for (int n = 0; n < 2; ++n) _Pragma("unroll") for (int k = 0; k < 2; ++k) \
        acc[ai][bj][m][n] = __builtin_amdgcn_mfma_f32_16x16x32_bf16(Bt[n][k], At[m][k], acc[ai][bj][m][n], 0, 0, 0); __builtin_amdgcn_s_setprio(0); } while (0)
#define PG8_WAIT_V(n) asm volatile("s_waitcnt vmcnt(" #n ")" ::: "memory")
#define PG8_WAIT_L(n) asm volatile("s_waitcnt lgkmcnt(" #n ")" ::: "memory")
#define PG8_WAIT_V8R(rx) asm volatile("s_waitcnt vmcnt(24)\n\ts_cmp_lg_u32 %0, 0\n\ts_cbranch_scc1 1\n\ts_waitcnt vmcnt(8)" :: "s"(__builtin_amdgcn_readfirstlane(rx)) : "scc", "memory")
#define PG8_BAR __builtin_amdgcn_s_barrier()
#define PG8_SCHED __builtin_amdgcn_sched_barrier(0)
    Unit cur, nxt; int ui = 0; int rx = 0;
    if (!S.next(0, cur)) return;
    f32x4 acc[2][2][4][2];
#pragma unroll
    for (int a = 0; a < 2; ++a)
#pragma unroll
        for (int b = 0; b < 2; ++b)
#pragma unroll
            for (int m = 0; m < 4; ++m)
#pragma unroll
                for (int n = 0; n < 2; ++n) acc[a][b][m][n] = (f32x4){0.f, 0.f, 0.f, 0.f};
    bf16x8 At[4][2], B0[2][2], B1[2][2];
    const char* cA = (const char*)g.A + (size_t)cur.pm * tstep + (size_t)g.koff(cur.seg) * 2; const char* cB = (const char*)g.Bt + (size_t)cur.pn * tstep + (size_t)g.koff(cur.seg) * 2;
    S.a_ready(cur);
    if constexpr (SP2) {
        PG8_STAGE(PG8_SB(0, 0), cB, voffB); PG8_STAGE(PG8_SB(0, 1), cB + hstep, voffB); PG8_STAGE(PG8_SA(0, 0), cA, voffA); PG8_STAGE(PG8_SA(0, 1), cA + hstep, voffA);
        if (wr == 1) PG8_BAR;
        PG8_WAIT_V(2); PG8_BAR;
        PG8_STAGE(PG8_SB(1, 0), cB + kstep, voffB); PG8_STAGE(PG8_SA(1, 0), cA + kstep, voffA); PG8_STAGE(PG8_SB(1, 1), cB + hstep + kstep, voffB);
        PG8_WAIT_V(6); PG8_BAR;
    } else {
        PG8_STAGE(PG8_SB(0, 0), cB, voffB); PG8_STAGE(PG8_SA(0, 0), cA, voffA); PG8_STAGE(PG8_SB(0, 1), cB + hstep, voffB); PG8_STAGE(PG8_SA(0, 1), cA + hstep, voffA);
        if (wr == 1) PG8_BAR;
        PG8_WAIT_V(4); PG8_BAR;
        PG8_STAGE(PG8_SB(1, 0), cB + kstep, voffB); PG8_STAGE(PG8_SA(1, 0), cA + kstep, voffA); PG8_STAGE(PG8_SB(1, 1), cB + hstep + kstep, voffB);
        PG8_WAIT_V(6); PG8_BAR;
    }
    for (;;) {
        const bool has_next = S.next(ui + 1, nxt);
        const char* nA = has_next ? (const char*)g.A + (size_t)nxt.pm * tstep + (size_t)g.koff(nxt.seg) * 2 : cA; const char* nB = has_next ? (const char*)g.Bt + (size_t)nxt.pn * tstep + (size_t)g.koff(nxt.seg) * 2 : cB;
        const int nt = g.ntiles(cur.seg);
        for (int t = 0; t < nt; t += 2) {
            const bool last = (t == nt - 2);
            const char* a1 = cA + (size_t)(t + 1) * kstep;
            const char* a2 = last ? nA : cA + (size_t)(t + 2) * kstep; const char* b2 = last ? nB : cB + (size_t)(t + 2) * kstep;
            const char* a3 = a2 + kstep; const char* b3 = b2 + kstep;
            if (last && has_next) S.a_ready(nxt);
            if constexpr (SP2) {
            PG8_LDB(B0, 0, 0); PG8_LDB(B1, 0, 1); PG8_SCHED; PG8_LDA(At, 0, 0); PG8_STAGE(PG8_SA(1, 1), a1 + hstep, voffA);
            PG8_WAIT_V8R(rx); PG8_WAIT_L(0); PG8_BAR; PG8_MMA(0, 0, At, B0); PG8_MMA(0, 1, At, B1); PG8_BAR; PG8_SCHED;
            PG8_LDA(At, 0, 1); PG8_STAGE(PG8_SB(0, 0), b2, voffB); PG8_STAGE(PG8_SB(0, 1), b2 + hstep, voffB); PG8_STAGE(PG8_SA(0, 0), a2, voffA);
            PG8_WAIT_V8R(rx); asm volatile("s_mov_b32 %0, 0" : "=s"(rx)); PG8_WAIT_L(0); PG8_BAR; PG8_MMA(1, 0, At, B0); PG8_MMA(1, 1, At, B1); PG8_BAR; PG8_SCHED;
            PG8_LDB(B0, 1, 0); PG8_LDB(B1, 1, 1); PG8_SCHED; PG8_LDA(At, 1, 0); PG8_STAGE(PG8_SA(0, 1), a2 + hstep, voffA);
            PG8_WAIT_V(8); PG8_WAIT_L(0); PG8_BAR; PG8_MMA(0, 0, At, B0); PG8_MMA(0, 1, At, B1); PG8_BAR; PG8_SCHED;
            PG8_LDA(At, 1, 1); PG8_STAGE(PG8_SB(1, 0), b3, voffB); PG8_STAGE(PG8_SB(1, 1), b3 + hstep, voffB); PG8_STAGE(PG8_SA(1, 0), a3, voffA);
            PG8_WAIT_V(8); PG8_WAIT_L(0); PG8_BAR; PG8_MMA(1, 0, At, B0); PG8_MMA(1, 1, At, B1); PG8_BAR; PG8_SCHED;
            } else {
            PG8_LDB(B0, 0, 0); PG8_SCHED; PG8_LDA(At, 0, 0); PG8_STAGE(PG8_SA(1, 1), a1 + hstep, voffA);
            PG8_WAIT_L(8); PG8_BAR; PG8_WAIT_L(0); PG8_MMA(0, 0, At, B0); PG8_BAR; PG8_SCHED;
            PG8_LDB(B1, 0, 1); PG8_STAGE(PG8_SB(0, 0), b2, voffB);
            PG8_BAR; PG8_WAIT_L(0); PG8_MMA(0, 1, At, B1); PG8_BAR;
            PG8_LDA(At, 0, 1); PG8_STAGE(PG8_SA(0, 0), a2, voffA);
            PG8_BAR; PG8_WAIT_L(0); PG8_MMA(1, 0, At, B0); PG8_BAR; PG8_SCHED;
            PG8_STAGE(PG8_SB(0, 1), b2 + hstep, voffB);
            PG8_WAIT_V(6); PG8_BAR; PG8_MMA(1, 1, At, B1); PG8_BAR;
            PG8_LDB(B0, 1, 0); PG8_SCHED; PG8_LDA(At, 1, 0); PG8_STAGE(PG8_SA(0, 1), a2 + hstep, voffA);
            PG8_WAIT_L(8); PG8_BAR; PG8_WAIT_L(0); PG8_MMA(0, 0, At, B0); PG8_BAR; PG8_SCHED;
            PG8_LDB(B1, 1, 1); PG8_STAGE(PG8_SB(1, 0), b3, voffB);
            PG8_BAR; PG8_WAIT_L(0); PG8_MMA(0, 1, At, B1); PG8_BAR;
            PG8_LDA(At, 1, 1); PG8_STAGE(PG8_SA(1, 0), a3, voffA);
            PG8_BAR; PG8_WAIT_L(0); PG8_MMA(1, 0, At, B0); PG8_BAR; PG8_SCHED;
            PG8_STAGE(PG8_SB(1, 1), b3 + hstep, voffB);
            PG8_WAIT_V(6); PG8_BAR; PG8_MMA(1, 1, At, B1); PG8_BAR;
            }
        }
        if constexpr (ALIGN_EPI) { if (wr == 0) PG8_BAR; }
        if constexpr (!Epi::AFTER_DRAIN) E(acc, cur, wr, wc, fr, fq);
        S.done(cur); rx = Epi::stores16(cur);
        if (!has_next) break;
        if (!Epi::CARRY || cur.seg == Epi::LAST_SEG) {
#pragma unroll
        for (int a = 0; a < 2; ++a)
#pragma unroll
            for (int b = 0; b < 2; ++b)
#pragma unroll
                for (int m = 0; m < 4; ++m)
#pragma unroll
                    for (int n = 0; n < 2; ++n) acc[a][b][m][n] = (f32x4){0.f, 0.f, 0.f, 0.f};
        }
        cur = nxt; cA = nA; cB = nB; ++ui;
        if constexpr (ALIGN_EPI) { if (wr == 1) PG8_BAR; }
    }
    PG8_WAIT_V(0);
    if constexpr (!ALIGN_EPI) { if (wr == 0) PG8_BAR; }
    PG8_BAR;
    if constexpr (Epi::AFTER_DRAIN) E.fused(acc, cur, wr, wc, fr, fq, lds);
#undef PG8_SA
#undef PG8_SB
#undef PG8_STAGE
#undef PG8_LDA
#undef PG8_LDB
#undef PG8_MMA
#undef PG8_WAIT_V
#undef PG8_WAIT_V8R
#undef PG8_WAIT_L
#undef PG8_BAR
#undef PG8_SCHED
}
}

__device__ __forceinline__ float fsoftplus(float v) {
    const float e = __expf(fminf(v, 20.f)), u = 1.0f + e, l = (u == 1.0f) ? e : __logf(u) * (e * __builtin_amdgcn_rcpf(u - 1.0f));
    return v > 20.f ? v : l;
}
struct Epi1 {
    static constexpr bool PERM = true, CARRY = false, AFTER_DRAIN = false; static constexpr int LAST_SEG = 0;
    bf16_t *ZS, *XBC, *U, *GB, *SGA, *SGR; float* DT; const float* dt_bias; float* out;
    static __device__ __forceinline__ int stores16(const pg8::Unit& u) { return u.pn < 88 ? 1 : 0; }
    __device__ __forceinline__ void operator()(f32x4 (&acc)[2][2][4][2], const pg8::Unit& u, int wr, int wc, int fr, int fq) const {
        const int pn = u.pn; const int rbase = u.pm * 256 + wr * 64 + fr;
        const bool has_o = u.pm < 32 ? (u.pm & 7) == 7 : u.pm < 36;
        if (pn < 16) {
#pragma unroll
            for (int ai = 0; ai < 2; ++ai)
#pragma unroll
                for (int m = 0; m < 4; ++m) { const int row = rbase + ai * 128 + m * 16; bf16_t* rowp = ZS + (size_t)row * DI + pn * 256 + wc * 32 + 8 * fq;
#pragma unroll
                    for (int bj = 0; bj < 2; ++bj) { const f32x4 v0 = acc[ai][bj][m][0], v1 = acc[ai][bj][m][1]; u32x4 w;
                        unsigned q0, q1, q2, q3; silu4_pk_bf16(v0, q0, q1); silu4_pk_bf16(v1, q2, q3); w = (u32x4){q0, q1, q2, q3};
                        *(u32x4*)(rowp + bj * 128) = w; } }
        } else if (pn < 40) {
#pragma unroll
            for (int ai = 0; ai < 2; ++ai)
#pragma unroll
                for (int m = 0; m < 4; ++m) { const int row = rbase + ai * 128 + m * 16; const int col = (pn - 16) * 256 + wc * 32 + 8 * fq; bf16_t* rowp = XBC + (size_t)row * CONVD + col;
                    int oidx = -1;
                    if (!has_o) {} else if (row < ROW_S0) { const int t = row & 2047; if (t >= 2045) oidx = (int)O_NCP + ((row >> 11) * 3 + (t - 2045)) * CONVD; }
                    else if (row < ROW_M0) { const int t = row & 7; if (t >= 5) oidx = (int)O_NCS + (((row - ROW_S0) >> 3) * 3 + (t - 5)) * CONVD; }
#pragma unroll
                    for (int bj = 0; bj < 2; ++bj) { const f32x4 v0 = acc[ai][bj][m][0], v1 = acc[ai][bj][m][1]; u32x4 w;
                        w.x = cvt_pk_bf16(v0[0], v0[1]); w.y = cvt_pk_bf16(v0[2], v0[3]); w.z = cvt_pk_bf16(v1[0], v1[1]); w.w = cvt_pk_bf16(v1[2], v1[3]);
                        *(u32x4*)(rowp + bj * 128) = w;
                        if (oidx >= 0) { float* o = out + oidx + col + bj * 128; *(f32x4*)o = v0; *(f32x4*)(o + 4) = v1; } } }
        } else if (pn < 72) {
#pragma unroll
            for (int ai = 0; ai < 2; ++ai)
#pragma unroll
                for (int m = 0; m < 4; ++m) { const int row = rbase + ai * 128 + m * 16; const int j0 = (pn - 40) * 64 + wc * 16 + fq * 4;
                    const f32x4 sb = acc[ai][0][m][0], sc = acc[ai][0][m][1], sh = acc[ai][1][m][0], sz = acc[ai][1][m][1];
                    const f32x4 uu = sc * sh; const f32x4 gg = sb * silu4(sz);
                    u32x2 wu, wg; wu.x = cvt_pk_bf16(uu[0], uu[1]); wu.y = cvt_pk_bf16(uu[2], uu[3]); wg.x = cvt_pk_bf16(gg[0], gg[1]); wg.y = cvt_pk_bf16(gg[2], gg[3]);
                    *(u32x2*)(U + (size_t)row * SCW + j0) = wu; *(u32x2*)(GB + (size_t)row * SCW + j0) = wg;
                    int oidx = -1;
                    if (!has_o) {} else if (row < ROW_S0) { const int t = row & 2047; if (t >= 2046) oidx = (int)O_NSCP + ((row >> 11) * 2 + (t - 2046)) * SCW; }
                    else if (row < ROW_M0) { const int t = row & 7; if (t >= 6) oidx = (int)O_NSCS + (((row - ROW_S0) >> 3) * 2 + (t - 6)) * SCW; }
                    if (oidx >= 0) *(f32x4*)(out + oidx + j0) = uu; }
        } else if (pn < 88) {
#pragma unroll
            for (int ai = 0; ai < 2; ++ai)
#pragma unroll
                for (int m = 0; m < 4; ++m) { const int row = rbase + ai * 128 + m * 16; const int j0 = (pn - 72) * 128 + wc * 32 + 8 * fq; float sa[8], rt[8];
#pragma unroll
                    for (int n = 0; n < 2; ++n) gate4(acc[ai][0][m][n], acc[ai][1][m][n], sa + 4 * n, rt + 4 * n);
                    *(u32x4*)(SGA + (size_t)row * D + j0) = pack8(sa); *(u32x4*)(SGR + (size_t)row * D + j0) = pack8(rt); }
        } else {
            if (wc < 2) {
                const int c0 = wc * 32 + 8 * fq; const f32x4 bb0 = *(const f32x4*)(dt_bias + c0), bb1 = *(const f32x4*)(dt_bias + c0 + 4);
#pragma unroll
                for (int ai = 0; ai < 2; ++ai)
#pragma unroll
                    for (int m = 0; m < 4; ++m) { const int row = rbase + ai * 128 + m * 16; f32x4 v0 = acc[ai][0][m][0] + bb0, v1 = acc[ai][0][m][1] + bb1;
#pragma unroll
                        for (int e = 0; e < 4; ++e) { v0[e] = fsoftplus(v0[e]); v1[e] = fsoftplus(v1[e]); }
                        *(f32x4*)(DT + (size_t)row * 64 + c0) = v0; *(f32x4*)(DT + (size_t)row * 64 + c0 + 4) = v1; }
            }
        }
    }
};
constexpr int LDS_RST = 131072;
__device__ __forceinline__ void build_rs_table(LAS unsigned char* lds, const float* SSQ, int pm) {
    LAS float* T = (LAS float*)(lds + LDS_RST);
    const int tid = threadIdx.x, trow = tid >> 1, half = tid & 1; const float* sp = SSQ + (size_t)(pm * 256 + trow) * 64 + 32 * half; float rs[4];
#pragma unroll
    for (int g = 0; g < 4; ++g) { const f32x4 q0 = *(const f32x4*)(sp + 8 * g), q1 = *(const f32x4*)(sp + 8 * g + 4); const float sm = ((q0[0] + q0[1]) + (q0[2] + q0[3])) + ((q1[0] + q1[1]) + (q1[2] + q1[3])); rs[g] = 1.0f / sqrtf(sm * (1.0f / 512.0f) + EPS); }
    const float rprev = __shfl_xor(rs[3], 1);
    LAS float* tp = T + trow * 12 + 4 * half;
    if (half == 0) { tp[0] = 1.0f / rs[0]; tp[1] = rs[0] / rs[1]; tp[2] = rs[1] / rs[2]; tp[3] = rs[2] / rs[3]; }
    else { tp[0] = rprev / rs[0]; tp[1] = rs[0] / rs[1]; tp[2] = rs[1] / rs[2]; tp[3] = rs[2] / rs[3]; tp[4] = rs[3]; }
}
struct Epi2 {
    static constexpr bool PERM = true, CARRY = true, AFTER_DRAIN = false; static constexpr int LAST_SEG = 8;
    static __device__ __forceinline__ int stores16(const pg8::Unit&) { return 0; }
    const bf16_t* SGA; const bf16_t* SGR; bf16_t* MG; LAS unsigned char* lds;
    __device__ __forceinline__ void operator()(f32x4 (&acc)[2][2][4][2], const pg8::Unit& u, int wr, int wc, int fr, int fq) const {
        const int rbase = u.pm * 256 + wr * 64 + fr; LAS float* T = (LAS float*)(lds + LDS_RST);
        const bool gated = (u.seg == 0) || (u.seg == 8); const bf16_t* gp = u.seg == 0 ? SGR : SGA;
#pragma unroll
        for (int ai = 0; ai < 2; ++ai) { u32x4 g[4][2];
#pragma unroll
            for (int m = 0; m < 4; ++m)
#pragma unroll
                for (int bj = 0; bj < 2; ++bj) g[m][bj] = (u32x4){0x3f803f80u, 0x3f803f80u, 0x3f803f80u, 0x3f803f80u};
            if (gated) {
#pragma unroll
                for (int m = 0; m < 4; ++m)
#pragma unroll
                    for (int bj = 0; bj < 2; ++bj) g[m][bj] = *(const u32x4*)(gp + (size_t)(rbase + ai * 128 + m * 16) * D + u.pn * 256 + bj * 128 + wc * 32 + 8 * fq); }
#pragma unroll
            for (int m = 0; m < 4; ++m) { const float tf = T[(wr * 64 + fr + ai * 128 + m * 16) * 12 + u.seg];
#pragma unroll
                for (int bj = 0; bj < 2; ++bj) { float gf[8]; unpack8(g[m][bj], gf); f32x4& v0 = acc[ai][bj][m][0]; f32x4& v1 = acc[ai][bj][m][1];
                    v0 = (f32x4){v0[0] * gf[0] * tf, v0[1] * gf[1] * tf, v0[2] * gf[2] * tf, v0[3] * gf[3] * tf}; v1 = (f32x4){v1[0] * gf[4] * tf, v1[1] * gf[5] * tf, v1[2] * gf[6] * tf, v1[3] * gf[7] * tf};
                    if (u.seg == 8) { u32x4 w; w.x = cvt_pk_bf16(v0[0], v0[1]); w.y = cvt_pk_bf16(v0[2], v0[3]); w.z = cvt_pk_bf16(v1[0], v1[1]); w.w = cvt_pk_bf16(v1[2], v1[3]);
                        *(u32x4*)(MG + (size_t)(rbase + ai * 128 + m * 16) * D + u.pn * 256 + bj * 128 + wc * 32 + 8 * fq) = w; } } }
            asm volatile("" ::: "memory"); }
    }
};
struct EpiOutNorm {
    static constexpr bool PERM = false, CARRY = false, AFTER_DRAIN = true; static constexpr int LAST_SEG = 0;
    static __device__ __forceinline__ int stores16(const pg8::Unit&) { return 0; }
    const float* xp; const float* fnw; float* out; float* PS; unsigned* cnt;
    __device__ __forceinline__ void operator()(f32x4 (&)[2][2][4][2], const pg8::Unit&, int, int, int, int) const {}
    __device__ __forceinline__ void fused(f32x4 (&acc)[2][2][4][2], const pg8::Unit& u, int wr, int wc, int fr, int fq, LAS unsigned char* lds) const {
        const int tid = threadIdx.x, wid = tid >> 6; const int rbase = u.pm * 256 + wr * 64 + fr;
        LAS float* P = (LAS float*)lds;
        LAS float* Sc = P + 1024;
#pragma unroll
        for (int ai = 0; ai < 2; ++ai)
#pragma unroll
            for (int mp = 0; mp < 2; ++mp) { f32x4 xv[2][2][2];
#pragma unroll
                for (int mm = 0; mm < 2; ++mm) { const float* xr = xp + (size_t)(rbase + ai * 128 + (2 * mp + mm) * 16) * D;
#pragma unroll
                    for (int bj = 0; bj < 2; ++bj)
#pragma unroll
                        for (int n = 0; n < 2; ++n) xv[mm][bj][n] = *(const f32x4*)(xr + u.pn * 256 + bj * 128 + wc * 32 + n * 16 + 4 * fq); }
#pragma unroll
                for (int mm = 0; mm < 2; ++mm) { float sq = 0.f;
#pragma unroll
                    for (int bj = 0; bj < 2; ++bj)
#pragma unroll
                        for (int n = 0; n < 2; ++n) { f32x4& v = acc[ai][bj][2 * mp + mm][n]; v = v + xv[mm][bj][n]; sq += (v[0] * v[0] + v[1] * v[1]) + (v[2] * v[2] + v[3] * v[3]); }
                    sq += __shfl_xor(sq, 16); sq += __shfl_xor(sq, 32);
                    if (fq == 0) P[(wr * 64 + fr + ai * 128 + (2 * mp + mm) * 16) * 4 + wc] = sq; }
                asm volatile("" ::: "memory"); }
        LDS_BARRIER();
        if (tid < 256) { const f32x4 q = *(const LAS f32x4*)(P + tid * 4); __hip_atomic_store(PS + (size_t)(u.pm * 256 + tid) * 8 + u.pn, (q[0] + q[1]) + (q[2] + q[3]), __ATOMIC_RELAXED, __HIP_MEMORY_SCOPE_AGENT); }
        asm volatile("s_waitcnt vmcnt(0)" ::: "memory");
        if (tid < 256 && (tid & 63) == 0) __hip_atomic_fetch_add(cnt + 64 * u.pm, 1u, __ATOMIC_RELAXED, __HIP_MEMORY_SCOPE_AGENT);
        if (wid == 0) { unsigned spins = 0;
            while ((unsigned)__builtin_amdgcn_readfirstlane(__hip_atomic_load(cnt + 64 * u.pm, __ATOMIC_RELAXED, __HIP_MEMORY_SCOPE_AGENT)) < 32u) { __builtin_amdgcn_s_sleep(2); if (++spins > (1u << 22)) break; }
            __builtin_amdgcn_fence(__ATOMIC_ACQUIRE, "agent");
            asm volatile("s_waitcnt vmcnt(0)" ::: "memory"); }
        LDS_BARRIER();
        if (tid < 256) { const float* pp = PS + (size_t)(u.pm * 256 + tid) * 8; float sm = 0.f;
#pragma unroll
            for (int t = 0; t < 8; ++t) sm += __hip_atomic_load(pp + t, __ATOMIC_RELAXED, __HIP_MEMORY_SCOPE_AGENT);
            Sc[tid] = 1.0f / sqrtf(sm * (1.0f / D) + EPS); }
        LDS_BARRIER();
        f32x4 fw[2][2];
#pragma unroll
        for (int bj = 0; bj < 2; ++bj)
#pragma unroll
            for (int n = 0; n < 2; ++n) fw[bj][n] = *(const f32x4*)(fnw + u.pn * 256 + bj * 128 + wc * 32 + n * 16 + 4 * fq);
#pragma unroll
        for (int ai = 0; ai < 2; ++ai)
#pragma unroll
            for (int m = 0; m < 4; ++m) { const int rl = wr * 64 + fr + ai * 128 + m * 16; const float rs = Sc[rl];
#pragma unroll
                for (int bj = 0; bj < 2; ++bj)
#pragma unroll
                    for (int n = 0; n < 2; ++n) *(f32x4*)(out + (size_t)(u.pm * 256 + rl) * D + u.pn * 256 + bj * 128 + wc * 32 + n * 16 + 4 * fq) = acc[ai][bj][m][n] * rs * fw[bj][n]; }
    }
};

#define XB_TMO      128
#define XB_XCNT(j)  (256  + 64 * (j))
#define XB_XSUB(j)  (1280 + 64 * (j))
#define XB_XGEN(j)  (2304 + 64 * (j))
#define XB_TOP      3328
#define XB_TOPGEN   3392
#define XCD_BAR_WORDS 3456
#define XB_SPIN_CAP (1u << 21)
__device__ __forceinline__ unsigned xb_ld(unsigned* p)              { return __hip_atomic_load(p, __ATOMIC_RELAXED, __HIP_MEMORY_SCOPE_AGENT); }
__device__ __forceinline__ unsigned xb_add(unsigned* p, unsigned v) { return __hip_atomic_fetch_add(p, v, __ATOMIC_RELAXED, __HIP_MEMORY_SCOPE_AGENT); }
__device__ __forceinline__ unsigned xb_xcc_id() { return (unsigned)__builtin_amdgcn_s_getreg((3 << 11) | 20) & 0xFu; }
#define XB_SPIN(cond, bar) do { unsigned _sp = 0; while (cond) { __builtin_amdgcn_s_sleep(1); \
    if ((++_sp & 255u) == 0u) { if (xb_ld(&(bar)[XB_TMO])) break; if (_sp > XB_SPIN_CAP) { atomicAdd(&(bar)[XB_TMO], 1u); break; } } } } while (0)
struct XcdBarrier { unsigned* bar; unsigned x; volatile LAS unsigned* st; };
__device__ __forceinline__ XcdBarrier xcd_barrier_post(unsigned* bar, volatile LAS unsigned* st) {
    XcdBarrier b; b.bar = bar; b.x = xb_xcc_id(); b.st = st;
    if (threadIdx.x == 0) (void)xb_add(&bar[XB_XCNT(b.x)], 1u);
    return b;
}
__device__ __forceinline__ void xcd_barrier_complete(unsigned* bar, unsigned x, unsigned& nloc, unsigned& nx) {
    const unsigned G = gridDim.x * gridDim.y * gridDim.z;
    unsigned sum, cnt, mine, sp = 0u;
    for (;;) {
        sum = 0u; cnt = 0u; mine = 0u;
#pragma unroll
        for (unsigned j = 0; j < 16; ++j) { const unsigned c = xb_ld(&bar[XB_XCNT(j)]); sum += c; cnt += (c > 0u) ? 1u : 0u; mine = (j == x) ? c : mine; }
        if (sum == G) break;
        __builtin_amdgcn_s_sleep(1);
        if ((++sp & 255u) == 0u) { if (xb_ld(&bar[XB_TMO])) break; if (sp > XB_SPIN_CAP) { atomicAdd(&bar[XB_TMO], 1u); break; } }
    }
    nloc = mine > 0u ? mine : 1u; nx = cnt > 0u ? cnt : 1u;
}
__device__ __forceinline__ void xcd_barrier(const XcdBarrier& b) {
    asm volatile("s_waitcnt vmcnt(0)" ::: "memory");
    __syncthreads();
    if (threadIdx.x == 0) {
        unsigned* bar = b.bar;
        __builtin_amdgcn_s_waitcnt(0);
        unsigned nloc = b.st[0], nx = b.st[1];
        if (nloc == 0u) { xcd_barrier_complete(bar, b.x, nloc, nx); b.st[0] = nloc; b.st[1] = nx; }
        const unsigned old = xb_add(&bar[XB_XSUB(b.x)], 1u);
        const unsigned gen = old / nloc;
        if (old + 1u == (gen + 1u) * nloc) {
            __builtin_amdgcn_fence(__ATOMIC_RELEASE, "agent");
            asm volatile("s_waitcnt vmcnt(0)" ::: "memory");
            const unsigned og = xb_add(&bar[XB_TOP], 1u);
            const unsigned tg = og / nx;
            if (og + 1u == (tg + 1u) * nx) xb_add(&bar[XB_TOPGEN], 1u);
            else XB_SPIN(xb_ld(&bar[XB_TOPGEN]) == tg, bar);
            __builtin_amdgcn_fence(__ATOMIC_ACQUIRE, "agent");
            xb_add(&bar[XB_XGEN(b.x)], 1u);
            asm volatile("s_waitcnt vmcnt(0)" ::: "memory");
        } else {
            XB_SPIN(xb_ld(&bar[XB_XGEN(b.x)]) == gen, bar);
            __builtin_amdgcn_fence(__ATOMIC_ACQUIRE, "agent");
            asm volatile("s_waitcnt vmcnt(0)" ::: "memory");
        }
    }
    __syncthreads();
}

struct Args { const float* in[19]; float* out; unsigned char* ws; int ph_lo, ph_hi; };
enum { I_XP = 0, I_XS, I_SCONV4, I_SSM, I_SSCONV, I_META, I_NORMW, I_WIN, I_CW, I_CB, I_DTB, I_ALOG, I_DSKIP, I_SNW, I_WSSD, I_SCW, I_WSC, I_WO, I_FNW };

__device__ __forceinline__ int wt1_src_col(int np) {
    const int pn = np >> 8, c = np & 255;
    if (pn < 40) return np;
    if (pn < 72) { const int q = 2 * (c >> 7) + ((c >> 2) & 1), jl = 16 * ((c >> 5) & 3) + 4 * ((c >> 3) & 3) + (c & 3); return C_SC + 2048 * q + 64 * (pn - 40) + jl; }
    if (pn < 88) return C_G + 2048 * (c >> 7) + 128 * (pn - 72) + (c & 127);
    return c < 64 ? C_DT + c : -1;
}
struct TItem { const float* src; const float* ksc; bf16_t* dst; int ldw, pitch; bool valid; };
__device__ __forceinline__ TItem prep_decode(const Args& a, int it, int lane) {
    constexpr int I1 = 32 * (NP1 / 64), I2A = 64 * 32, I2B = 32 * 32, I3 = 32 * 32;
    TItem t; t.valid = it < I1 + I2A + I2B + I3; t.src = nullptr; t.ksc = nullptr; t.dst = nullptr; t.ldw = 0; t.pitch = 0;
    if (!t.valid) return t;
    const int l4 = 4 * (lane & 15), kr = lane >> 4, c8 = 8 * (lane & 7); int r = it;
    if (r < I1) { const int kb = r / (NP1 / 64), nb = r % (NP1 / 64); const int sc = wt1_src_col(nb * 64 + l4); t.ldw = PROJ; t.pitch = D;
        t.src = sc >= 0 ? a.in[I_WIN] + (size_t)(kb * 64 + kr) * PROJ + sc : nullptr; t.dst = (bf16_t*)(a.ws + W_WT1) + (size_t)(nb * 64) * D + kb * 64; return t; } r -= I1;
    if (r < I2A) { const int kb = r / 32, nb = r % 32; t.ldw = D; t.pitch = K2; t.src = a.in[I_WSSD] + (size_t)(kb * 64 + kr) * D + nb * 64 + l4; t.ksc = a.in[I_SNW] + kb * 64 + c8;
        t.dst = (bf16_t*)(a.ws + W_WT2) + (size_t)(nb * 64) * K2 + kb * 64; return t; } r -= I2A;
    if (r < I2B) { const int kb = r / 32, nb = r % 32; t.ldw = D; t.pitch = K2; t.src = a.in[I_WSC] + (size_t)(kb * 64 + kr) * D + nb * 64 + l4; t.dst = (bf16_t*)(a.ws + W_WT2) + (size_t)(nb * 64) * K2 + DI + kb * 64; return t; } r -= I2B;
    { const int kb = r / 32, nb = r % 32; t.ldw = D; t.pitch = D; t.src = a.in[I_WO] + (size_t)(kb * 64 + kr) * D + nb * 64 + l4; t.dst = (bf16_t*)(a.ws + W_WT3) + (size_t)(nb * 64) * D + kb * 64; }
    return t;
}
__device__ __forceinline__ void transpose_range(const Args& a, LAS unsigned char* lds, int first, int stride, int end) {
    const int tid = threadIdx.x, lane = tid & 63, wave = __builtin_amdgcn_readfirstlane(tid >> 6);
    LAS unsigned char* scr = lds + wave * 16384;
    const int kr = lane >> 4, n4 = lane & 15, c = lane & 7, nn = lane >> 3;
    f32x4 buf[16];
    TItem cur = prep_decode(a, first < end ? first : 1 << 30, lane);
    if (cur.valid) {
#pragma unroll
        for (int i = 0; i < 16; ++i) buf[i] = cur.src ? *(const f32x4*)(cur.src + (size_t)(4 * i) * cur.ldw) : (f32x4){0.f, 0.f, 0.f, 0.f}; }
    for (int it = first; cur.valid; it += stride) {
        const TItem nxt = prep_decode(a, it + stride < end ? it + stride : 1 << 30, lane);
#pragma unroll
        for (int i = 0; i < 16; ++i) { const int k = 4 * i + kr; *(LAS f32x4*)(scr + k * 256 + ((n4 ^ (k >> 3)) << 4)) = buf[i]; }
        if (nxt.valid) {
#pragma unroll
            for (int i = 0; i < 16; ++i) buf[i] = nxt.src ? *(const f32x4*)(nxt.src + (size_t)(4 * i) * nxt.ldw) : (f32x4){0.f, 0.f, 0.f, 0.f}; }
        f32x4 k0v = (f32x4){1.f, 1.f, 1.f, 1.f}, k1v = k0v; if (cur.ksc) { k0v = *(const f32x4*)cur.ksc; k1v = *(const f32x4*)(cur.ksc + 4); }
        LDS_WAIT();
#pragma unroll
        for (int j = 0; j < 8; ++j) { const int n = nn + 8 * j; const LAS unsigned char* sp = scr + (8 * c) * 256 + (((n >> 2) ^ c) << 4) + ((n & 3) << 2); float f[8];
#pragma unroll
            for (int e = 0; e < 8; ++e) f[e] = *(const LAS float*)(sp + e * 256) * (e < 4 ? k0v[e & 3] : k1v[e & 3]);
            *(u32x4*)(cur.dst + (size_t)n * cur.pitch + 8 * c) = pack8(f); }
        LDS_WAIT();
        cur = nxt;
    }
}
constexpr int PREP_I1 = 32 * (NP1 / 64), PREP_I23 = 64 * 32 + 32 * 32 + 32 * 32;
__device__ __forceinline__ void phase_prep(const Args& a, LAS unsigned char* lds, int G) {
    const int tid = threadIdx.x, lane = tid & 63, wave = __builtin_amdgcn_readfirstlane(tid >> 6);
    const int gw = blockIdx.x * 8 + wave, NGW = G * 8;
    transpose_range(a, lds, gw, NGW, PREP_I1);
    bf16_t* H = (bf16_t*)(a.ws + W_H); const float* nw = a.in[I_NORMW];
    auto rowsrc = [&](int r) -> const float* { return r < ROW_S0 ? a.in[I_XP] + (size_t)r * D : (r < ROW_M0 ? a.in[I_XS] + (size_t)(r - ROW_S0) * D : (r < M_REAL ? a.in[I_META] + (size_t)(r - ROW_M0) * D : nullptr)); };
    f32x4 pv[8];
    { const float* src = gw < MP ? rowsrc(gw) : nullptr;
#pragma unroll
        for (int j = 0; j < 8; ++j) pv[j] = src ? ((const f32x4*)src)[lane + 64 * j] : (f32x4){0.f, 0.f, 0.f, 0.f}; }
    for (int r = gw; r < MP; r += NGW) {
        f32x4 v[8]; float s = 0.f;
#pragma unroll
        for (int j = 0; j < 8; ++j) { v[j] = pv[j]; s += (v[j][0] * v[j][0] + v[j][1] * v[j][1]) + (v[j][2] * v[j][2] + v[j][3] * v[j][3]); }
        { const float* src = r + NGW < MP ? rowsrc(r + NGW) : nullptr;
#pragma unroll
            for (int j = 0; j < 8; ++j) pv[j] = src ? ((const f32x4*)src)[lane + 64 * j] : (f32x4){0.f, 0.f, 0.f, 0.f}; }
        const float rs = 1.0f / sqrtf(wave_sum(s) * (1.0f / D) + EPS);
#pragma unroll
        for (int j = 0; j < 8; ++j) { const f32x4 w = ((const f32x4*)nw)[lane + 64 * j]; u32x2 o; o.x = cvt_pk_bf16(v[j][0] * rs * w[0], v[j][1] * rs * w[1]); o.y = cvt_pk_bf16(v[j][2] * rs * w[2], v[j][3] * rs * w[3]);
            ((u32x2*)(H + (size_t)r * D))[lane + 64 * j] = o; }
    }
}

__device__ __forceinline__ void phase_conv(const Args& a, int G) {
    const int tid = threadIdx.x;
    const bf16_t* XBC = (const bf16_t*)(a.ws + W_XBC); const bf16_t* U = (const bf16_t*)(a.ws + W_U); const bf16_t* GBp = (const bf16_t*)(a.ws + W_GB);
    bf16_t* XC = (bf16_t*)(a.ws + W_XC); bf16_t* A2 = (bf16_t*)(a.ws + W_A2);
    constexpr int NBLK = 512 + 64 + 1;
    for (int item = blockIdx.x; item < 512 + 2 * (NBLK - 512); item += G) {
        const int hf = item < 512 ? 1 : ((item - 512) & 1), blk = item < 512 ? item : 512 + ((item - 512) >> 1); const int cg = hf * 512 + tid; const bool isx = cg < 768;
        int r0, nseg, segrows, mode;
        if (blk < 512) { r0 = blk * 16; nseg = 1; segrows = 16; mode = (blk & 127) == 0 ? 1 : 0; }
        else if (blk < 576) { r0 = ROW_S0 + (blk - 512) * 16; nseg = 2; segrows = 8; mode = 2; }
        else { r0 = ROW_M0; nseg = 1; segrows = 16; mode = 3; }
        if (isx) {
            const int c0 = cg * 8; float w[4][8], bias[8];
#pragma unroll
            for (int k = 0; k < 4; ++k) { const f32x4 pv = *(const f32x4*)(a.in[I_CW] + k * CONVD + c0), qv = *(const f32x4*)(a.in[I_CW] + k * CONVD + c0 + 4);
                w[k][0] = pv[0]; w[k][1] = pv[1]; w[k][2] = pv[2]; w[k][3] = pv[3]; w[k][4] = qv[0]; w[k][5] = qv[1]; w[k][6] = qv[2]; w[k][7] = qv[3]; }
            { const f32x4 pv = *(const f32x4*)(a.in[I_CB] + c0), qv = *(const f32x4*)(a.in[I_CB] + c0 + 4); bias[0] = pv[0]; bias[1] = pv[1]; bias[2] = pv[2]; bias[3] = pv[3]; bias[4] = qv[0]; bias[5] = qv[1]; bias[6] = qv[2]; bias[7] = qv[3]; }
            for (int sg = 0; sg < nseg; ++sg) {
                const int rs = r0 + sg * segrows; float x3[8], x2[8], x1[8];
                if (mode == 0 || mode == 1) { const int pr = mode == 0 ? rs - 3 : M_REAL - 3;
                    unpack8(*(const u32x4*)(XBC + (size_t)pr * CONVD + c0), x3); unpack8(*(const u32x4*)(XBC + (size_t)(pr + 1) * CONVD + c0), x2); unpack8(*(const u32x4*)(XBC + (size_t)(pr + 2) * CONVD + c0), x1); }
                else if (mode == 2) { const float* st = a.in[I_SCONV4] + (size_t)((rs - ROW_S0) >> 3) * 3 * CONVD + c0;
#pragma unroll
                    for (int e = 0; e < 8; ++e) { x3[e] = st[e]; x2[e] = st[CONVD + e]; x1[e] = st[2 * CONVD + e]; } }
                else {
#pragma unroll
                    for (int e = 0; e < 8; ++e) { x3[e] = 0.f; x2[e] = 0.f; x1[e] = 0.f; } }
                for (int i0 = 0; i0 < segrows; i0 += 8) { u32x4 ld[8];
#pragma unroll
                    for (int j = 0; j < 8; ++j) ld[j] = *(const u32x4*)(XBC + (size_t)(rs + i0 + j) * CONVD + c0);
#pragma unroll
                    for (int j = 0; j < 8; ++j) { float cur[8], o[8]; unpack8(ld[j], cur);
#pragma unroll
                        for (int e = 0; e < 8; ++e) { const float v = bias[e] + w[0][e] * x3[e] + w[1][e] * x2[e] + w[2][e] * x1[e] + w[3][e] * cur[e]; o[e] = fsilu(v); x3[e] = x2[e]; x2[e] = x1[e]; x1[e] = cur[e]; }
                        *(u32x4*)(XC + (size_t)(rs + i0 + j) * CONVD + c0) = pack8(o); } }
            }
        } else {
            const int j0 = (cg - 768) * 8; float w[3][8];
#pragma unroll
            for (int k = 0; k < 3; ++k) { const f32x4 pv = *(const f32x4*)(a.in[I_SCW] + k * SCW + j0), qv = *(const f32x4*)(a.in[I_SCW] + k * SCW + j0 + 4);
                w[k][0] = pv[0]; w[k][1] = pv[1]; w[k][2] = pv[2]; w[k][3] = pv[3]; w[k][4] = qv[0]; w[k][5] = qv[1]; w[k][6] = qv[2]; w[k][7] = qv[3]; }
            for (int sg = 0; sg < nseg; ++sg) {
                const int rs = r0 + sg * segrows; float u2[8], u1[8];
                if (mode == 0 || mode == 1) { const int pr = mode == 0 ? rs - 2 : M_REAL - 2;
                    unpack8(*(const u32x4*)(U + (size_t)pr * SCW + j0), u2); unpack8(*(const u32x4*)(U + (size_t)(pr + 1) * SCW + j0), u1); }
                else if (mode == 2) { const float* st = a.in[I_SSCONV] + (size_t)((rs - ROW_S0) >> 3) * 2 * SCW + j0;
#pragma unroll
                    for (int e = 0; e < 8; ++e) { u2[e] = st[e]; u1[e] = st[SCW + e]; } }
                else {
#pragma unroll
                    for (int e = 0; e < 8; ++e) { u2[e] = 0.f; u1[e] = 0.f; } }
                for (int i0 = 0; i0 < segrows; i0 += 8) { u32x4 ld[8], lg[8];
#pragma unroll
                    for (int j = 0; j < 8; ++j) { ld[j] = *(const u32x4*)(U + (size_t)(rs + i0 + j) * SCW + j0); lg[j] = *(const u32x4*)(GBp + (size_t)(rs + i0 + j) * SCW + j0); }
#pragma unroll
                    for (int j = 0; j < 8; ++j) { float cur[8], gt[8], o[8]; unpack8(ld[j], cur); unpack8(lg[j], gt);
#pragma unroll
                        for (int e = 0; e < 8; ++e) { const float v = w[0][e] * u2[e] + w[1][e] * u1[e] + w[2][e] * cur[e]; o[e] = gt[e] * v; u2[e] = u1[e]; u1[e] = cur[e]; }
                        *(u32x4*)(A2 + (size_t)(rs + i0 + j) * K2 + DI + j0) = pack8(o); } }
            }
        }
    }
}

constexpr int SL_C = 0, SL_B = 32768, SL_W = 65536, SL_XD = 98304, SL_XE = 114688, SL_H = 131072, SL_SM = 147456;
typedef short s16x4 __attribute__((ext_vector_type(4)));
__device__ __forceinline__ int img_off(int row, int col) { return row * 256 + ((((col >> 3) ^ row) & 15) << 4) + ((col & 7) << 1); }
__device__ __forceinline__ int img_off128(int row, int col) { return row * 128 + ((((col >> 3) ^ row) & 7) << 4) + ((col & 7) << 1); }
__device__ __forceinline__ bf16x8 ldfrag(const LAS unsigned char* img, int r0, int ks, int fr, int fq) { return *(const LAS bf16x8*)(img + (r0 + fr) * 256 + ((((4 * ks + fq) ^ fr) & 15) << 4)); }
__device__ __forceinline__ bf16x8 trfrag256(const LAS unsigned char* img, int c0, int ks, int lane) {
    const int i16 = lane & 15, fq = lane >> 4, q = i16 >> 2, p = i16 & 3, krow = 32 * ks + 8 * fq + q, col = c0 + 4 * p;
    const s16x4 lo = __builtin_amdgcn_ds_read_tr16_b64_v4i16((LAS s16x4*)(img + img_off(krow, col))), hi = __builtin_amdgcn_ds_read_tr16_b64_v4i16((LAS s16x4*)(img + img_off(krow + 4, col)));
    return __builtin_shufflevector(lo, hi, 0, 1, 2, 3, 4, 5, 6, 7);
}
__device__ __forceinline__ bf16x8 trfrag128(const LAS unsigned char* img, int c0, int ks, int lane) {
    const int i16 = lane & 15, fq = lane >> 4, q = i16 >> 2, p = i16 & 3, krow = 32 * ks + 8 * fq + q, col = c0 + 4 * p;
    const s16x4 lo = __builtin_amdgcn_ds_read_tr16_b64_v4i16((LAS s16x4*)(img + img_off128(krow, col))), hi = __builtin_amdgcn_ds_read_tr16_b64_v4i16((LAS s16x4*)(img + img_off128(krow + 4, col)));
    return __builtin_shufflevector(lo, hi, 0, 1, 2, 3, 4, 5, 6, 7);
}
#define MFMA16(a, b, c) __builtin_amdgcn_mfma_f32_16x16x32_bf16((a), (b), (c), 0, 0, 0)
__device__ __forceinline__ void ssd_prompt_item(const Args& a, LAS unsigned char* lds, int b, int head) {
    const int tid = threadIdx.x, lane = tid & 63, w = __builtin_amdgcn_readfirstlane(tid >> 6), g = head >> 3;
    const bf16_t* XC = (const bf16_t*)(a.ws + W_XC); const float* DT = (const float*)(a.ws + W_DT); const bf16_t* ZS = (const bf16_t*)(a.ws + W_ZS);
    bf16_t* YG = (bf16_t*)(a.ws + W_A2); float* SSQ = (float*)(a.ws + W_SSQ);
    LAS unsigned char* Ci = lds + SL_C; LAS unsigned char* Bi = lds + SL_B; LAS unsigned char* Wi = lds + SL_W; LAS unsigned char* XDi = lds + SL_XD; LAS unsigned char* XEi = lds + SL_XE; LAS unsigned char* Hi = lds + SL_H;
    LAS float* acum_s = (LAS float*)(lds + SL_SM); LAS float* dt_s = acum_s + 128; LAS float* ea_s = acum_s + 256; LAS float* ee_s = acum_s + 384;
    const float Ah = -expf(a.in[I_ALOG][head]); const float Dh = a.in[I_DSKIP][head];
    f32x4 st[4];
#pragma unroll
    for (int pt = 0; pt < 4; ++pt) st[pt] = (f32x4){0.f, 0.f, 0.f, 0.f};
    u32x4 pc[4], pb[4], pr[2][4]; float pdt0 = 0.f, pdt1 = 0.f;
    const bf16_t* XBCr = (const bf16_t*)(a.ws + W_XBC);
    float cw[4][8], cbias[8];
    { const int c0 = head * 64 + 8 * (tid & 7);
#pragma unroll
      for (int k = 0; k < 4; ++k) { const f32x4 pv = *(const f32x4*)(a.in[I_CW] + k * CONVD + c0), qv = *(const f32x4*)(a.in[I_CW] + k * CONVD + c0 + 4);
          cw[k][0] = pv[0]; cw[k][1] = pv[1]; cw[k][2] = pv[2]; cw[k][3] = pv[3]; cw[k][4] = qv[0]; cw[k][5] = qv[1]; cw[k][6] = qv[2]; cw[k][7] = qv[3]; }
      const f32x4 pv = *(const f32x4*)(a.in[I_CB] + c0), qv = *(const f32x4*)(a.in[I_CB] + c0 + 4);
      cbias[0] = pv[0]; cbias[1] = pv[1]; cbias[2] = pv[2]; cbias[3] = pv[3]; cbias[4] = qv[0]; cbias[5] = qv[1]; cbias[6] = qv[2]; cbias[7] = qv[3]; }
    auto rowg = [&](int c, int i) -> int { return c == 0 ? ROW_M0 + i : b * 2048 + (c - 1) * 128 + i; };
    auto prefetch = [&](int c, int t) {
        const int valid = c == 0 ? META : 128;
#pragma unroll
        for (int k = 0; k < 4; ++k) { const int q = t + 512 * k, row = q >> 4, ch = q & 15;
            if (row < valid) { const bf16_t* base = XC + (size_t)rowg(c, row) * CONVD + g * 128 + ch * 8; pb[k] = *(const u32x4*)(base + DI); pc[k] = *(const u32x4*)(base + DI + 1024); }
            else { pb[k] = (u32x4){0u, 0u, 0u, 0u}; pc[k] = (u32x4){0u, 0u, 0u, 0u}; } }
#pragma unroll
        for (int k = 0; k < 2; ++k) { const int q = t + 512 * k, row = q >> 3, ch = q & 7;
            if (c == 0) { pr[k][0] = row < valid ? *(const u32x4*)(XC + (size_t)rowg(0, row) * CONVD + head * 64 + ch * 8) : (u32x4){0u, 0u, 0u, 0u}; }
            else {
#pragma unroll
                for (int d = 0; d < 4; ++d) { const int t = (c - 1) * 128 + row - d;
                    pr[k][d] = *(const u32x4*)(XBCr + (size_t)(t >= 0 ? b * 2048 + t : ROW_M0 + 16 + t) * CONVD + head * 64 + ch * 8); } } }
        if (w == 0) { const int r0 = 2 * (t & 63); pdt0 = r0 < valid ? DT[(size_t)rowg(c, r0) * 64 + head] : 0.f; pdt1 = r0 + 1 < valid ? DT[(size_t)rowg(c, r0 + 1) * 64 + head] : 0.f; }
    };
    prefetch(0, tid);
    for (int c = 0; c < 17; ++c) {
        int tq = tid; asm volatile("" : "+v"(tq));
        const int lq = tq & 63, fr = lq & 15, fq = lq >> 4;
        LDS_BARRIER();
        if (w == 0) {
            const float l0 = pdt0 * Ah, l1 = pdt1 * Ah; float sc = l0 + l1;
#pragma unroll
            for (int o = 1; o < 64; o <<= 1) { const float t = __shfl_up(sc, o); if (lane >= o) sc += t; }
            const float a1 = sc, a0 = sc - l1, alast = __shfl(sc, 63);
            acum_s[2 * lane] = a0; acum_s[2 * lane + 1] = a1; dt_s[2 * lane] = pdt0; dt_s[2 * lane + 1] = pdt1;
            ea_s[2 * lane] = __expf(a0); ea_s[2 * lane + 1] = __expf(a1); ee_s[2 * lane] = __expf(alast - a0); ee_s[2 * lane + 1] = __expf(alast - a1);
        }
#pragma unroll
        for (int k = 0; k < 4; ++k) { const int q = tq + 512 * k, row = q >> 4, ch = q & 15; const int o = row * 256 + (((ch ^ row) & 15) << 4);
            *(LAS u32x4*)(Ci + o) = pc[k]; *(LAS u32x4*)(Bi + o) = pb[k]; }
#pragma unroll
        for (int pt = 0; pt < 4; ++pt) { u32x2 hv; hv.x = cvt_pk_bf16(st[pt][0], st[pt][1]); hv.y = cvt_pk_bf16(st[pt][2], st[pt][3]); *(LAS u32x2*)(Hi + img_off(16 * pt + fr, 16 * w + 4 * fq)) = hv; }
        LDS_BARRIER();
#pragma unroll
        for (int k = 0; k < 2; ++k) { const int q = tq + 512 * k, row = q >> 3, ch = q & 7; float f[8], fd[8], fe[8]; const float dtj = dt_s[row], ej = ee_s[row] * dtj;
            if (c == 0) unpack8(pr[k][0], f);
            else { float x0[8], x1[8], x2[8], x3[8]; unpack8(pr[k][0], x0); unpack8(pr[k][1], x1); unpack8(pr[k][2], x2); unpack8(pr[k][3], x3);
#pragma unroll
                for (int e = 0; e < 8; ++e) f[e] = fsilu(cbias[e] + cw[0][e] * x3[e] + cw[1][e] * x2[e] + cw[2][e] * x1[e] + cw[3][e] * x0[e]); }
#pragma unroll
            for (int e = 0; e < 8; ++e) { fd[e] = f[e] * dtj; fe[e] = f[e] * ej; }
            const int o = row * 128 + (((ch ^ row) & 7) << 4);
            *(LAS u32x4*)(XDi + o) = pack8(fd); *(LAS u32x4*)(XEi + o) = pack8(fe); }
        LDS_BARRIER();
        if (c + 1 < 17) prefetch(c + 1, tq);
        const float dA = ea_s[127];
#pragma unroll
        for (int pt = 0; pt < 4; ++pt) st[pt] = st[pt] * dA;
#pragma unroll
        for (int kh = 0; kh < 2; ++kh) { bf16x8 bt[2], xe[2][4];
#pragma unroll
            for (int k2 = 0; k2 < 2; ++k2) { bt[k2] = trfrag256(Bi, 16 * w, 2 * kh + k2, lq);
#pragma unroll
                for (int pt = 0; pt < 4; ++pt) xe[k2][pt] = trfrag128(XEi, 16 * pt, 2 * kh + k2, lq); }
            __builtin_amdgcn_sched_barrier(0); LDS_WAIT(); __builtin_amdgcn_sched_barrier(0);
#pragma unroll
            for (int k2 = 0; k2 < 2; ++k2)
#pragma unroll
                for (int pt = 0; pt < 4; ++pt) st[pt] = MFMA16(bt[k2], xe[k2][pt], st[pt]);
            __builtin_amdgcn_sched_barrier(0); }
        if (c >= 1) {
        bf16x8 ca[4];
#pragma unroll
        for (int ks = 0; ks < 4; ++ks) ca[ks] = ldfrag(Ci, 16 * w, ks, fr, fq);
        const int irow = 16 * w + fr; const float aci = acum_s[irow];
#pragma unroll
        for (int j2 = 0; j2 < 4; ++j2) if (j2 <= (w >> 1)) { bf16x8 bf[2][4]; f32x4 acj[2];
#pragma unroll
            for (int h = 0; h < 2; ++h) {
#pragma unroll
                for (int ks = 0; ks < 4; ++ks) bf[h][ks] = ldfrag(Bi, 16 * (2 * j2 + h), ks, fr, fq);
                acj[h] = *(const LAS f32x4*)(acum_s + 16 * (2 * j2 + h) + 4 * fq); }
            __builtin_amdgcn_sched_barrier(0); LDS_WAIT(); __builtin_amdgcn_sched_barrier(0);
#pragma unroll
            for (int h = 0; h < 2; ++h) { const int jt = 2 * j2 + h; f32x4 G = (f32x4){0.f, 0.f, 0.f, 0.f};
#pragma unroll
                for (int ks = 0; ks < 4; ++ks) G = MFMA16(bf[h][ks], ca[ks], G);
                const int j0 = 16 * jt + 4 * fq; float wv[4];
#pragma unroll
                for (int r = 0; r < 4; ++r) wv[r] = (j0 + r <= irow) ? G[r] * __expf(aci - acj[h][r]) : 0.f;
                u32x2 o; o.x = cvt_pk_bf16(wv[0], wv[1]); o.y = cvt_pk_bf16(wv[2], wv[3]); *(LAS u32x2*)(Wi + img_off(irow, j0)) = o; }
            __builtin_amdgcn_sched_barrier(0); }
        u32x2 xo[4], zo[4]; const int rg = rowg(c, irow);
        {
#pragma unroll
            for (int pt = 0; pt < 4; ++pt) zo[pt] = *(const u32x2*)(ZS + (size_t)rg * DI + head * 64 + 16 * pt + 4 * fq); }
        f32x4 y[4];
#pragma unroll
        for (int pt = 0; pt < 4; ++pt) y[pt] = (f32x4){0.f, 0.f, 0.f, 0.f};
#pragma unroll
        for (int kh = 0; kh < 2; ++kh) { bf16x8 hb[2][4];
#pragma unroll
            for (int k2 = 0; k2 < 2; ++k2)
#pragma unroll
                for (int pt = 0; pt < 4; ++pt) hb[k2][pt] = ldfrag(Hi, 16 * pt, 2 * kh + k2, fr, fq);
            __builtin_amdgcn_sched_barrier(0); LDS_WAIT(); __builtin_amdgcn_sched_barrier(0);
#pragma unroll
            for (int k2 = 0; k2 < 2; ++k2)
#pragma unroll
                for (int pt = 0; pt < 4; ++pt) y[pt] = MFMA16(hb[k2][pt], ca[2 * kh + k2], y[pt]);
            __builtin_amdgcn_sched_barrier(0); }
        const float eai = ea_s[irow];
#pragma unroll
        for (int pt = 0; pt < 4; ++pt) y[pt] = y[pt] * eai;
        LDS_WAIT();
#pragma unroll
        for (int kh = 0; kh < 2; ++kh) if (2 * kh <= (w >> 1)) { bf16x8 wa[2], xb[2][4];
#pragma unroll
            for (int k2 = 0; k2 < 2; ++k2) { wa[k2] = ldfrag(Wi, 16 * w, 2 * kh + k2, fr, fq);
#pragma unroll
                for (int pt = 0; pt < 4; ++pt) xb[k2][pt] = trfrag128(XDi, 16 * pt, 2 * kh + k2, lq); }
            __builtin_amdgcn_sched_barrier(0); LDS_WAIT(); __builtin_amdgcn_sched_barrier(0);
#pragma unroll
            for (int k2 = 0; k2 < 2; ++k2) if (2 * kh + k2 <= (w >> 1))
#pragma unroll
                for (int pt = 0; pt < 4; ++pt) y[pt] = MFMA16(xb[k2][pt], wa[k2], y[pt]);
            __builtin_amdgcn_sched_barrier(0); }
        { float ssq = 0.f; const float dti = dt_s[irow], rdt = dti > 0.f ? 1.0f / dti : 0.f;
#pragma unroll
            for (int pt = 0; pt < 4; ++pt) xo[pt] = *(const LAS u32x2*)(XDi + irow * 128 + ((((2 * pt + (fq >> 1)) ^ irow) & 7) << 4) + ((fq & 1) << 3));
#pragma unroll
            for (int pt = 0; pt < 4; ++pt) { const float x4[4] = {bf_lo(xo[pt].x) * rdt, bf_hi(xo[pt].x) * rdt, bf_lo(xo[pt].y) * rdt, bf_hi(xo[pt].y) * rdt}, z4[4] = {bf_lo(zo[pt].x), bf_hi(zo[pt].x), bf_lo(zo[pt].y), bf_hi(zo[pt].y)}; float gv[4];
#pragma unroll
                for (int r = 0; r < 4; ++r) { gv[r] = (y[pt][r] + Dh * x4[r]) * z4[r]; ssq += gv[r] * gv[r]; }
                u32x2 o; o.x = cvt_pk_bf16(gv[0], gv[1]); o.y = cvt_pk_bf16(gv[2], gv[3]); *(u32x2*)(YG + (size_t)rg * K2 + head * 64 + 16 * pt + 4 * fq) = o; }
            ssq += __shfl_xor(ssq, 16); ssq += __shfl_xor(ssq, 32);
            if (fq == 0) SSQ[(size_t)rg * 64 + head] = ssq; }
        }
    }
    { const int fr = lane & 15, fq = lane >> 4; float* so = a.out + O_NSSMP + (size_t)(b * NH + head) * HP * NS;
#pragma unroll
    for (int pt = 0; pt < 4; ++pt) *(f32x4*)(so + (size_t)(16 * pt + fr) * NS + 16 * w + 4 * fq) = st[pt]; }
}

__device__ __forceinline__ void phase_ssd_sample(const Args& a, LAS unsigned char* lds, int G) {
    const int tid = threadIdx.x, u = tid >> 8, tt = tid & 255, pq = tt >> 3, nq = tid & 7, p0 = 2 * pq;
    const bf16_t* XC = (const bf16_t*)(a.ws + W_XC); const float* DT = (const float*)(a.ws + W_DT); bf16_t* Y = (bf16_t*)(a.ws + W_A2);
    const bf16_t* ZSp = (const bf16_t*)(a.ws + W_ZS); float* SSQp = (float*)(a.ws + W_SSQ);
    constexpr int BCR = 160;
    constexpr int BUF = 8 * 64 + 2 * 8 * BCR + 16 + 8 * 64;
    const int nit = (DECB * NH - (int)blockIdx.x + G - 1) / G;
    const float dsk_l = a.in[I_DSKIP][tid & 63], al_l = a.in[I_ALOG][tid & 63];
    const int pcA = tid, pcB = 512 + (tid & 127);
    f32x4 hs[8]; u32x4 pfA, pfB; float pdt; unsigned pzz;
    auto item_of = [&](int kk) -> int { return blockIdx.x + (kk < nit ? kk : nit - 1) * G; };
    auto piece_ptr = [&](int k, int pc) -> const bf16_t* { const int it = item_of(k + pc / 320), seq = it >> 6, head = it & 63, g = head >> 3, r = pc % 320, pi = r / 40, pq40 = r % 40;
        const int col = pq40 < 8 ? head * 64 + pq40 * 8 : (pq40 < 24 ? DI + g * 128 + (pq40 - 8) * 8 : DI + 1024 + g * 128 + (pq40 - 24) * 8); return XC + (size_t)(ROW_S0 + seq * 8 + pi) * CONVD + col; };
    auto issue = [&](int k) { const int it = item_of(k + u), seq = it >> 6, head = it & 63;
        const float* s0 = a.in[I_SSM] + ((size_t)it * HP + p0) * NS + nq * 16;
#pragma unroll
        for (int j = 0; j < 4; ++j) { hs[j] = *(const f32x4*)(s0 + 4 * j); hs[4 + j] = *(const f32x4*)(s0 + NS + 4 * j); }
        pfA = *(const u32x4*)piece_ptr(k, pcA); pfB = *(const u32x4*)piece_ptr(k, pcB);
        pdt = DT[(size_t)(ROW_S0 + seq * 8 + (tid & 7)) * 64 + head];
        pzz = *(const unsigned*)(ZSp + (size_t)(ROW_S0 + seq * 8 + ((tt >> 5) & 7)) * DI + head * 64 + (tt & 31) * 2); };
    auto stash = [&](int pc, const u32x4 v) { const int uu = pc / 320, r = pc % 320, pi = r / 40, q = r % 40; float f[8]; unpack8(v, f);
        LAS float* xs = (LAS float*)lds + uu * BUF; const int hb = q < 24 ? q - 8 : q - 24;
        LAS float* dst = q < 8 ? xs + pi * 64 + q * 8 : (q < 24 ? xs + 512 + pi * BCR + (hb >> 1) * 20 + (hb & 1) * 8 : xs + 512 + 8 * BCR + pi * BCR + (hb >> 1) * 20 + (hb & 1) * 8);
        *(LAS f32x4*)dst = (f32x4){f[0], f[1], f[2], f[3]}; *(LAS f32x4*)(dst + 4) = (f32x4){f[4], f[5], f[6], f[7]}; };
    issue(0);
    for (int k = 0; k < nit; k += 2) {
        const int it = item_of(k + u), seq = it >> 6, head = it & 63; const bool live = k + u < nit;
        LAS float* xs = (LAS float*)lds + u * BUF; LAS float* Bs = xs + 512; LAS float* Cs = Bs + 8 * BCR; LAS float* dts = Cs + 8 * BCR; LAS float* das = dts + 8; LAS float* ys = das + 8;
        f32x2 h2[2][8];
#pragma unroll
        for (int r = 0; r < 2; ++r)
#pragma unroll
            for (int j = 0; j < 4; ++j) { h2[r][2 * j] = (f32x2){hs[4 * r + j][0], hs[4 * r + j][1]}; h2[r][2 * j + 1] = (f32x2){hs[4 * r + j][2], hs[4 * r + j][3]}; }
        stash(pcA, pfA); if (tid < 128) stash(pcB, pfB);
        const float Dh = __shfl(dsk_l, head), alh = __shfl(al_l, head); const unsigned zz = pzz;
        if ((tid & 255) < 8) { dts[tid & 7] = pdt; das[tid & 7] = __expf(-pdt * __expf(alh)); }
        LDS_BARRIER();
        issue(k + 2);
        float ya[2][8];
#pragma unroll
        for (int i = 0; i < 8; ++i) {
            const f32x2 xv = *(const LAS f32x2*)(xs + i * 64 + p0); const float dtv = dts[i], av = das[i]; const float xd0 = xv[0] * dtv, xd1 = xv[1] * dtv; f32x2 y0 = (f32x2){0.f, 0.f}, y1 = y0;
#pragma unroll
            for (int j = 0; j < 4; ++j) { const f32x4 bb = *(const LAS f32x4*)(Bs + i * BCR + nq * 20 + 4 * j), cc = *(const LAS f32x4*)(Cs + i * BCR + nq * 20 + 4 * j);
                const f32x2 bl = (f32x2){bb[0], bb[1]}, bh = (f32x2){bb[2], bb[3]}, cl = (f32x2){cc[0], cc[1]}, ch = (f32x2){cc[2], cc[3]};
                h2[0][2 * j] = h2[0][2 * j] * av + bl * xd0; h2[0][2 * j + 1] = h2[0][2 * j + 1] * av + bh * xd0; y0 = y0 + cl * h2[0][2 * j]; y0 = y0 + ch * h2[0][2 * j + 1];
                h2[1][2 * j] = h2[1][2 * j] * av + bl * xd1; h2[1][2 * j + 1] = h2[1][2 * j + 1] * av + bh * xd1; y1 = y1 + cl * h2[1][2 * j]; y1 = y1 + ch * h2[1][2 * j + 1]; }
            ya[0][i] = y0[0] + y0[1]; ya[1][i] = y1[0] + y1[1];
        }
#pragma unroll
        for (int r = 0; r < 2; ++r) { float t4[4], t2[2], t1;
#pragma unroll
            for (int i = 0; i < 4; ++i) { const float keep = (nq & 4) ? ya[r][i + 4] : ya[r][i], send = (nq & 4) ? ya[r][i] : ya[r][i + 4]; t4[i] = keep + __shfl_xor(send, 4); }
#pragma unroll
            for (int i = 0; i < 2; ++i) { const float keep = (nq & 2) ? t4[i + 2] : t4[i], send = (nq & 2) ? t4[i] : t4[i + 2]; t2[i] = keep + __shfl_xor(send, 2); }
            { const float keep = (nq & 1) ? t2[1] : t2[0], send = (nq & 1) ? t2[0] : t2[1]; t1 = keep + __shfl_xor(send, 1); }
            ys[nq * 64 + p0 + r] = t1 + Dh * xs[nq * 64 + p0 + r]; }
        if (live) { float* so = a.out + O_NSSMS + ((size_t)it * HP + p0) * NS + nq * 16;
#pragma unroll
            for (int r = 0; r < 2; ++r)
#pragma unroll
                for (int j = 0; j < 4; ++j) *(f32x4*)(so + r * NS + 4 * j) = (f32x4){h2[r][2 * j][0], h2[r][2 * j][1], h2[r][2 * j + 1][0], h2[r][2 * j + 1][1]}; }
        LDS_BARRIER();
        if (live) { const int i = tt >> 5, pp = (tt & 31) * 2; const size_t ro = (size_t)(ROW_S0 + seq * 8 + i);
            const float g0 = ys[i * 64 + pp] * bf_lo(zz), g1 = ys[i * 64 + pp + 1] * bf_hi(zz); float sq = g0 * g0 + g1 * g1;
            *(unsigned*)(Y + ro * K2 + head * 64 + pp) = cvt_pk_bf16(g0, g1);
            sq += __shfl_xor(sq, 1); sq += __shfl_xor(sq, 2); sq += __shfl_xor(sq, 4); sq += __shfl_xor(sq, 8); sq += __shfl_xor(sq, 16);
            if ((tt & 31) == 0) SSQp[ro * 64 + head] = sq; }
        LDS_BARRIER();
    }
}
__device__ __forceinline__ void phase_ssd(const Args& a, LAS unsigned char* lds, int G) {
    for (int it = blockIdx.x; it < NB * NH; it += G) { const int v = (G == 256) ? (it & 7) * 32 + (it >> 3) : it; ssd_prompt_item(a, lds, v >> 6, v & 63); }
    __syncthreads();
    phase_ssd_sample(a, lds, G);
}

struct SmallAcc { f32x4 v[2][2]; };
template <class Off, class Hook, class Pre>
__device__ __forceinline__ void small_gemm_kloop(LAS unsigned char* lds, const bf16_t* A, const bf16_t* Bt, int ld, int nks, SmallAcc& acc, Off koff, Hook hook, Pre pre) {
    const int tid = threadIdx.x, lane = tid & 63, w = __builtin_amdgcn_readfirstlane(tid >> 6), wm = w >> 1, wn = w & 1, fr = lane & 15, fq = lane >> 4;
    constexpr int ABYTES = 128 * 256, BUFB = ABYTES + 64 * 256;
    const int lr = lane >> 4, lc = (lane & 15) ^ ((4 * w + lr) & 15);
    const bf16_t* ga = A + (size_t)(4 * w + lr) * ld + lc * 8; const bf16_t* gb = Bt + (size_t)(4 * w + lr) * ld + lc * 8; const size_t r32 = (size_t)32 * ld;
    const unsigned lw = (unsigned)w * 1024u;
#define SG_ISSUE(kt, bufi) do { const int _kt = (kt) < nks ? (kt) : nks - 1; LAS unsigned char* _b = lds + (bufi) * BUFB + lw; const int _ko = koff(_kt); \
        _Pragma("unroll") for (int _i = 0; _i < 4; ++_i) __builtin_amdgcn_global_load_lds((const unsigned*)(ga + _i * r32 + _ko), (LAS unsigned*)(_b + _i * 8192), 16, 0, 0); \
        _Pragma("unroll") for (int _i = 0; _i < 2; ++_i) __builtin_amdgcn_global_load_lds((const unsigned*)(gb + _i * r32 + _ko), (LAS unsigned*)(_b + ABYTES + _i * 8192), 16, 0, 0); } while (0)
#define SG_FRAGS(AF, BF, bufi) do { const LAS unsigned char* _c = lds + (bufi) * BUFB; \
        _Pragma("unroll") for (int hk = 0; hk < 2; ++hk) _Pragma("unroll") for (int ks = 0; ks < 2; ++ks) _Pragma("unroll") for (int i = 0; i < 2; ++i) { \
            const int ra = 32 * wm + 16 * i + fr, rbw = 32 * wn + 16 * i + fr, ch = 8 * hk + 4 * ks + fq; \
            AF[hk][ks][i] = *(const LAS bf16x8*)(_c + ra * 256 + (((ch ^ ra) & 15) << 4)); BF[hk][ks][i] = *(const LAS bf16x8*)(_c + ABYTES + rbw * 256 + (((ch ^ rbw) & 15) << 4)); } } while (0)
#define SG_MMA(AF, BF) do { _Pragma("unroll") for (int hk = 0; hk < 2; ++hk) _Pragma("unroll") for (int ks = 0; ks < 2; ++ks) _Pragma("unroll") for (int mb = 0; mb < 2; ++mb) _Pragma("unroll") for (int nb = 0; nb < 2; ++nb) \
        acc.v[mb][nb] = __builtin_amdgcn_mfma_f32_16x16x32_bf16(BF[hk][ks][nb], AF[hk][ks][mb], acc.v[mb][nb], 0, 0, 0); } while (0)
#define SG_STEP(k, AFC, BFC, AFN, BFN, bcur, bnext) do { \
        asm volatile("" ::: "memory"); __builtin_amdgcn_s_waitcnt(0x0076);   \
        __builtin_amdgcn_s_barrier(); asm volatile("" ::: "memory"); \
        SG_ISSUE((k) + 3, bcur); \
        __builtin_amdgcn_sched_barrier(0); \
        SG_FRAGS(AFN, BFN, bnext); \
        SG_MMA(AFC, BFC); \
        _Pragma("unroll") for (int _p = 0; _p < 16; ++_p) { __builtin_amdgcn_sched_group_barrier(0x100, 1, 0); __builtin_amdgcn_sched_group_barrier(0x008, 1, 0); } \
        __builtin_amdgcn_sched_barrier(0); \
        hook(k, acc); } while (0)
    SG_ISSUE(0, 0); SG_ISSUE(1, 1);
    pre();
    bf16x8 af0[2][2][2], bf0[2][2][2], af1[2][2][2], bf1[2][2][2];
    asm volatile("s_waitcnt vmcnt(6)" ::: "memory");
    __builtin_amdgcn_s_barrier(); asm volatile("" ::: "memory");
    SG_ISSUE(2, 2);
    SG_FRAGS(af0, bf0, 0);
    int k = 0;
    for (; k + 6 <= nks; k += 6) {
        SG_STEP(k, af0, bf0, af1, bf1, 0, 1); SG_STEP(k + 1, af1, bf1, af0, bf0, 1, 2); SG_STEP(k + 2, af0, bf0, af1, bf1, 2, 0);
        SG_STEP(k + 3, af1, bf1, af0, bf0, 0, 1); SG_STEP(k + 4, af0, bf0, af1, bf1, 1, 2); SG_STEP(k + 5, af1, bf1, af0, bf0, 2, 0);
    }
    if (k < nks) {
        SG_STEP(k, af0, bf0, af1, bf1, 0, 1); SG_STEP(k + 1, af1, bf1, af0, bf0, 1, 2); SG_STEP(k + 2, af0, bf0, af1, bf1, 2, 0); SG_STEP(k + 3, af1, bf1, af0, bf0, 0, 1);
    }
    asm volatile("s_waitcnt vmcnt(0) lgkmcnt(0)" ::: "memory");
    __builtin_amdgcn_s_barrier();
    asm volatile("" ::: "memory");
#undef SG_STEP
#undef SG_MMA
#undef SG_FRAGS
#undef SG_ISSUE
}
__device__ __forceinline__ void small_gemm2_tile(const Args& a, LAS unsigned char* lds, int tm, int tn) {
    const int tid = threadIdx.x, lane = tid & 63, w = __builtin_amdgcn_readfirstlane(tid >> 6), wm = w >> 1, wn = w & 1, fr = lane & 15, fq = lane >> 4;
    const bf16_t* A2 = (const bf16_t*)(a.ws + W_A2) + (size_t)(ROW_S0 + 128 * tm) * K2; const bf16_t* WT2 = (const bf16_t*)(a.ws + W_WT2) + (size_t)(64 * tn) * K2;
    const bf16_t* SGA = (const bf16_t*)(a.ws + W_SGA); const bf16_t* SGR = (const bf16_t*)(a.ws + W_SGR); bf16_t* MG = (bf16_t*)(a.ws + W_MERGED); const float* SSQ = (const float*)(a.ws + W_SSQ);
    float rs[2][8];
    u32x2 rr[2][2];
    SmallAcc acc;
#pragma unroll
    for (int mb = 0; mb < 2; ++mb)
#pragma unroll
        for (int nb = 0; nb < 2; ++nb) acc.v[mb][nb] = (f32x4){0.f, 0.f, 0.f, 0.f};
    small_gemm_kloop(lds, A2, WT2, K2, 48, acc,
        [](int k) { return k < 16 ? DI + 128 * k : 128 * (k - 16); },
        [&](int k, SmallAcc& ac) {
            if (k == 15) {
#pragma unroll
                for (int mb = 0; mb < 2; ++mb) { const float t0 = 1.0f / rs[mb][0];
#pragma unroll
                    for (int nb = 0; nb < 2; ++nb) { f32x4& v = ac.v[mb][nb]; const u32x2 r = rr[mb][nb]; v = (f32x4){v[0] * bf_lo(r.x) * t0, v[1] * bf_hi(r.x) * t0, v[2] * bf_lo(r.y) * t0, v[3] * bf_hi(r.y) * t0}; } } }
            else if (k >= 19 && k < 47 && ((k - 19) & 3) == 0) { const int g = (k - 19) >> 2;
#pragma unroll
                for (int mb = 0; mb < 2; ++mb) { float tf = 0.f;
#pragma unroll
                    for (int gg = 0; gg < 7; ++gg) tf = (g == gg) ? rs[mb][gg] / rs[mb][gg + 1] : tf;
#pragma unroll
                    for (int nb = 0; nb < 2; ++nb) ac.v[mb][nb] = ac.v[mb][nb] * tf; } } },
        [&]() {
#pragma unroll
    for (int mb = 0; mb < 2; ++mb) { const float* sp = SSQ + (size_t)(ROW_S0 + 128 * tm + 32 * wm + 16 * mb + fr) * 64;
#pragma unroll
        for (int g = 0; g < 8; ++g) { const f32x4 q0 = *(const f32x4*)(sp + 8 * g), q1 = *(const f32x4*)(sp + 8 * g + 4); const float sm = ((q0[0] + q0[1]) + (q0[2] + q0[3])) + ((q1[0] + q1[1]) + (q1[2] + q1[3])); rs[mb][g] = 1.0f / sqrtf(sm * (1.0f / 512.0f) + EPS); } }
#pragma unroll
    for (int mb = 0; mb < 2; ++mb)
#pragma unroll
        for (int nb = 0; nb < 2; ++nb) rr[mb][nb] = *(const u32x2*)(SGR + (size_t)(ROW_S0 + 128 * tm + 32 * wm + 16 * mb + fr) * D + 64 * tn + 32 * wn + 16 * nb + 4 * fq);
#pragma unroll
        for (int mb = 0; mb < 2; ++mb)
#pragma unroll
            for (int nb = 0; nb < 2; ++nb) asm volatile("" : "+v"(rr[mb][nb].x), "+v"(rr[mb][nb].y));
        });
#pragma unroll
    for (int mb = 0; mb < 2; ++mb)
#pragma unroll
        for (int nb = 0; nb < 2; ++nb) { const size_t off = (size_t)(ROW_S0 + 128 * tm + 32 * wm + 16 * mb + fr) * D + 64 * tn + 32 * wn + 16 * nb + 4 * fq; const u32x2 g = *(const u32x2*)(SGA + off); const float t8 = rs[mb][7];
            const f32x4 v = acc.v[mb][nb]; u32x2 o; o.x = cvt_pk_bf16(v[0] * bf_lo(g.x) * t8, v[1] * bf_hi(g.x) * t8); o.y = cvt_pk_bf16(v[2] * bf_lo(g.y) * t8, v[3] * bf_hi(g.y) * t8); *(u32x2*)(MG + off) = o; }
}
__device__ __forceinline__ void small_gemm3_tile(const Args& a, LAS unsigned char* lds, int tm, int tn) {
    const int tid = threadIdx.x, lane = tid & 63, w = __builtin_amdgcn_readfirstlane(tid >> 6), wm = w >> 1, wn = w & 1, fr = lane & 15, fq = lane >> 4;
    const bf16_t* MG = (const bf16_t*)(a.ws + W_MERGED) + (size_t)(ROW_S0 + 128 * tm) * D; const bf16_t* WT3 = (const bf16_t*)(a.ws + W_WT3) + (size_t)(64 * tn) * D;
    float* PS2 = (float*)(a.ws + W_PS2); unsigned* cnt = (unsigned*)(a.ws + W_CTL + CTL_PANEL2) + 64 * tm;
    LDS_BARRIER();
    SmallAcc acc;
#pragma unroll
    for (int mb = 0; mb < 2; ++mb)
#pragma unroll
        for (int nb = 0; nb < 2; ++nb) acc.v[mb][nb] = (f32x4){0.f, 0.f, 0.f, 0.f};
    f32x4 xv[2][2], fw[2];
#pragma unroll
    for (int mb = 0; mb < 2; ++mb)
#pragma unroll
        for (int nb = 0; nb < 2; ++nb) xv[mb][nb] = *(const f32x4*)(a.in[I_XS] + (size_t)(128 * tm + 32 * wm + 16 * mb + fr) * D + 64 * tn + 32 * wn + 16 * nb + 4 * fq);
#pragma unroll
    for (int nb = 0; nb < 2; ++nb) fw[nb] = *(const f32x4*)(a.in[I_FNW] + 64 * tn + 32 * wn + 16 * nb + 4 * fq);
    small_gemm_kloop(lds, MG, WT3, D, D / 128, acc, [](int k) { return 128 * k; }, [](int, SmallAcc&) {}, []() {});
    LAS float* P = (LAS float*)lds;
    LAS float* Sc = P + 256;
#pragma unroll
    for (int mb = 0; mb < 2; ++mb) { const int rl = 32 * wm + 16 * mb + fr; float sq = 0.f;
#pragma unroll
        for (int nb = 0; nb < 2; ++nb) { f32x4& v = acc.v[mb][nb]; v = v + xv[mb][nb]; sq += (v[0] * v[0] + v[1] * v[1]) + (v[2] * v[2] + v[3] * v[3]); }
        sq += __shfl_xor(sq, 16); sq += __shfl_xor(sq, 32);
        if (fq == 0) P[rl * 2 + wn] = sq; }
    LDS_BARRIER();
    if (tid < 128) __hip_atomic_store(PS2 + (size_t)(128 * tm + tid) * 32 + tn, P[tid * 2] + P[tid * 2 + 1], __ATOMIC_RELAXED, __HIP_MEMORY_SCOPE_AGENT);
    asm volatile("s_waitcnt vmcnt(0)" ::: "memory");
    if (tid < 128 && (tid & 63) == 0) __hip_atomic_fetch_add(cnt, 1u, __ATOMIC_RELAXED, __HIP_MEMORY_SCOPE_AGENT);
    if (w == 0) { unsigned spins = 0;
        while ((unsigned)__builtin_amdgcn_readfirstlane(__hip_atomic_load(cnt, __ATOMIC_RELAXED, __HIP_MEMORY_SCOPE_AGENT)) < 64u) { __builtin_amdgcn_s_sleep(2); if (++spins > (1u << 22)) break; }
        __builtin_amdgcn_fence(__ATOMIC_ACQUIRE, "agent");
        asm volatile("s_waitcnt vmcnt(0)" ::: "memory"); }
    LDS_BARRIER();
    if (tid < 128) { const float* pp = PS2 + (size_t)(128 * tm + tid) * 32; float sm = 0.f;
#pragma unroll
        for (int t = 0; t < 32; ++t) sm += __hip_atomic_load(pp + t, __ATOMIC_RELAXED, __HIP_MEMORY_SCOPE_AGENT);
        Sc[tid] = 1.0f / sqrtf(sm * (1.0f / D) + EPS); }
    LDS_BARRIER();
#pragma unroll
    for (int mb = 0; mb < 2; ++mb) { const int rl = 32 * wm + 16 * mb + fr; const float rs = Sc[rl];
#pragma unroll
        for (int nb = 0; nb < 2; ++nb) { const int col = 64 * tn + 32 * wn + 16 * nb + 4 * fq;
            *(f32x4*)(a.out + O_YS + (size_t)(128 * tm + rl) * D + col) = acc.v[mb][nb] * rs * fw[nb]; } }
    LDS_BARRIER();
}

constexpr int N_PHASES = 6;
__global__ void __launch_bounds__(512, 2) fwd_kernel(Args a) {
    extern __shared__ __attribute__((aligned(16))) unsigned char lds_raw[];
    LAS unsigned char* lds = (LAS unsigned char*)lds_raw;
    const int G = gridDim.x; const int lo = a.ph_lo, hi = a.ph_hi;
#define IN(k) (lo <= (k) && (k) < hi)
    volatile LAS unsigned* misc = (volatile LAS unsigned*)(lds + LDS_MISC);
    if (threadIdx.x < 16) misc[threadIdx.x] = 0u;
    __syncthreads();
    XcdBarrier bar; bar.bar = (unsigned*)(a.ws + W_CTL); bar.x = 0; bar.st = misc;
    if (hi - lo > 1) bar = xcd_barrier_post((unsigned*)(a.ws + W_CTL), misc);
#define SEAM(k) do { if (IN(k) && IN((k) + 1)) xcd_barrier(bar); } while (0)
    if (IN(0)) phase_prep(a, lds, G);
    SEAM(0);
    if (IN(1)) {
        if (G == 256) { const int x = blockIdx.x & 7, j = blockIdx.x >> 3, wv = __builtin_amdgcn_readfirstlane(threadIdx.x >> 6); constexpr int PX = PREP_I23 / 8;
            const int off = (PX * (j * (j - 1) / 2)) / 496, nj = (PX * (j * (j + 1) / 2)) / 496 - off;
            transpose_range(a, lds, PREP_I1 + x * PX + off + wv, 8, PREP_I1 + x * PX + off + nj); }
        else if ((G & 7) == 0) { const int x = blockIdx.x & 7, wpx = (G >> 3) * 8, wi = (blockIdx.x >> 3) * 8 + __builtin_amdgcn_readfirstlane(threadIdx.x >> 6);
            const int off = (PREP_I23 * (x * (x - 1) / 2)) / 28, nx = (PREP_I23 * (x * (x + 1) / 2)) / 28 - off;
            transpose_range(a, lds, PREP_I1 + off + wi, wpx, PREP_I1 + off + nx); }
        else transpose_range(a, lds, PREP_I1 + blockIdx.x * 8 + __builtin_amdgcn_readfirstlane(threadIdx.x >> 6), G * 8, PREP_I1 + PREP_I23);
        asm volatile("s_waitcnt vmcnt(0)" ::: "memory"); __syncthreads();
        pg8::Gemm g{(const bf16_t*)(a.ws + W_H), (const bf16_t*)(a.ws + W_WT1), D, 0, D / 64, 0, 0}; pg8::StaticOrder S; S.init(MP, NP1, G, (int)blockIdx.x);
        Epi1 E{(bf16_t*)(a.ws + W_ZS), (bf16_t*)(a.ws + W_XBC), (bf16_t*)(a.ws + W_U), (bf16_t*)(a.ws + W_GB), (bf16_t*)(a.ws + W_SGA), (bf16_t*)(a.ws + W_SGR), (float*)(a.ws + W_DT), a.in[I_DTB], a.out};
        pg8::gemm_phase<Epi1, pg8::StaticOrder, true, true>(lds, g, S, E);
    }
    SEAM(1);
    if (IN(2)) phase_conv(a, G);
    SEAM(2);
    if (IN(3)) phase_ssd(a, lds, G);
    SEAM(3);
    if (IN(4)) {
        pg8::Gemm g{(const bf16_t*)(a.ws + W_A2), (const bf16_t*)(a.ws + W_WT2), K2, DI, D / 64, 512, 8}; pg8::SegOrder<9> S; S.init(ROW_S0, D, G, (int)blockIdx.x);
        Epi2 E{(const bf16_t*)(a.ws + W_SGA), (const bf16_t*)(a.ws + W_SGR), (bf16_t*)(a.ws + W_MERGED), lds};
        { pg8::Unit u0; if (S.next(0, u0)) build_rs_table(lds, (const float*)(a.ws + W_SSQ), u0.pm); }
        __syncthreads();
        pg8::gemm_phase<Epi2, pg8::SegOrder<9>, true, true>(lds, g, S, E);
        for (int t = blockIdx.x; t < 256; t += G) small_gemm2_tile(a, lds, t >> 5, t & 31);
    }
    SEAM(4);
    if (IN(5)) {
        pg8::Gemm g{(const bf16_t*)(a.ws + W_MERGED), (const bf16_t*)(a.ws + W_WT3), D, 0, D / 64, 0, 0}; pg8::StaticOrder S; S.init(ROW_S0, D, G, (int)blockIdx.x);
        EpiOutNorm E{a.in[I_XP], a.in[I_FNW], a.out, (float*)(a.ws + W_PS), (unsigned*)(a.ws + W_CTL + CTL_PANEL)};
        pg8::gemm_phase<EpiOutNorm, pg8::StaticOrder, true, true>(lds, g, S, E);
        for (int t = blockIdx.x; t < 256; t += G) small_gemm3_tile(a, lds, t >> 5, t & 31);
    }
#undef IN
}

extern "C" void kernel_launch(void* const* d_in, const int* in_sizes, int n_in, void* d_out, int out_size, void* d_ws, size_t ws_size, hipStream_t stream) {
    static int grid = 0;
    if (grid == 0) {
        int dev = 0, cus = 0;
        if (n_in != 19 || ws_size < W_END) { fprintf(stderr, "kernel_launch: unexpected n_in %d or ws_size %zu (< %zu)\n", n_in, ws_size, (size_t)W_END); grid = -1; return; }
        if (hipGetDevice(&dev) != hipSuccess || hipDeviceGetAttribute(&cus, hipDeviceAttributeMultiprocessorCount, dev) != hipSuccess) { grid = -1; return; }
        if (hipFuncSetAttribute((const void*)fwd_kernel, hipFuncAttributeMaxDynamicSharedMemorySize, LDS_BYTES) != hipSuccess) { fprintf(stderr, "kernel_launch: hipFuncSetAttribute failed\n"); grid = -1; return; }
        int per_cu = 0; (void)hipOccupancyMaxActiveBlocksPerMultiprocessor(&per_cu, (const void*)fwd_kernel, 512, LDS_BYTES); (void)hipGetLastError();
        if (per_cu < 1) fprintf(stderr, "kernel_launch: occupancy query says %d blocks per CU\n", per_cu);
        grid = cus;
    }
    if (grid < 0) return;
    Args a{};
    for (int i = 0; i < 19; ++i) a.in[i] = (const float*)d_in[i];
    a.out = (float*)d_out; a.ws = (unsigned char*)d_ws;
    a.ph_lo = 0; a.ph_hi = N_PHASES;
    (void)hipMemsetAsync((unsigned char*)d_ws + W_CTL, 0, CTL_BYTES, stream);
    hipLaunchKernelGGL(fwd_kernel, dim3(grid), dim3(512), LDS_BYTES, stream, a);
}
```
